# Optimizing an MI355X kernel written in HIP

```python
import jax
import jax.numpy as jnp
from jax import lax
import numpy as np

D_MODEL = 1024
BATCH = 16
SEQ = 2048
DEPTH = 1

GRID_W = 64
CTX_LEN = 256
NA_HEADS = 8
NA_HEAD_DIM = 64
NA_WIDTH = NA_HEADS * NA_HEAD_DIM
NA_WIN_H = 8
NA_WIN_W = 16
NA_QBLOCK = 16
NA_KBLOCK = NA_QBLOCK + NA_WIN_W
GLA_HEADS = 4
GLA_DK = D_MODEL // 2
GLA_DV = D_MODEL
GLA_HK = GLA_DK // GLA_HEADS
GLA_HV = GLA_DV // GLA_HEADS
GLA_GATE_RANK = 16
GLA_GATE_NORM = 16.0
GLA_CHUNK = 64
ROPE_BASE = 10000.0
N_GROUPS = 4
EXPERTS_PER_GROUP = 8
N_EXPERTS = N_GROUPS * EXPERTS_PER_GROUP
TOP_K = 2
D_EXPERT = D_MODEL // 2
MOE_BLOCK = 128
D_IN = 3 * NA_WIDTH + 2 * GLA_DK + 2 * GLA_DV + 2 * GLA_GATE_RANK + 2 * D_MODEL
EPS = 1e-6
NEG_INF = -1e30

kernel_name = "hybrid_na_gla_hmoe_dit_block"


def rmsnorm(x, g):
    xf = x.astype(jnp.float32)
    xf = xf * lax.rsqrt(jnp.mean(xf * xf, axis=-1, keepdims=True) + EPS)
    return xf.astype(x.dtype) * g


def split_proj(p):
    sizes = (NA_WIDTH, NA_WIDTH, NA_WIDTH, GLA_DK, GLA_DK, GLA_DV, GLA_DV, 2 * GLA_GATE_RANK, D_MODEL, D_MODEL)
    return jnp.split(p, np.cumsum(sizes)[:-1].tolist(), axis=-1)


def heads(t, n):
    return t.reshape(t.shape[0], t.shape[1], n, t.shape[-1] // n)


def _rotate_half(x, ang):
    m = x.shape[-1] // 2
    cos = jnp.cos(ang)[:, None, :].astype(x.dtype)
    sin = jnp.sin(ang)[:, None, :].astype(x.dtype)
    x1, x2 = x[..., :m], x[..., m:]
    return jnp.concatenate([x1 * cos - x2 * sin, x1 * sin + x2 * cos], axis=-1)


def rope_2d(x, pos_r, pos_c):
    half = x.shape[-1] // 2
    nf = half // 2
    inv = ROPE_BASE ** (-jnp.arange(nf, dtype=jnp.float32) / nf)
    return jnp.concatenate([_rotate_half(x[..., :half], pos_r[:, None] * inv),
                            _rotate_half(x[..., half:], pos_c[:, None] * inv)], axis=-1)


def na_latent(q, k, v, k_ctx, v_ctx, rpb):
    B_, S, H, dh = q.shape
    rows = S // GRID_W
    kh = min(NA_WIN_H, rows)
    nb = GRID_W // NA_QBLOCK
    kc0 = [min(max(j * NA_QBLOCK - NA_WIN_W // 2, 0), GRID_W - NA_KBLOCK) for j in range(nb)]
    qcol = np.arange(GRID_W).reshape(nb, NA_QBLOCK)
    kcol = np.array(kc0)[:, None] + np.arange(NA_KBLOCK)[None, :]
    cstart = np.clip(qcol - NA_WIN_W // 2, 0, GRID_W - NA_WIN_W)
    col_valid = (kcol[:, None, :] >= cstart[:, :, None]) & (kcol[:, None, :] < cstart[:, :, None] + NA_WIN_W)
    col_idx = np.clip(kcol[:, None, :] - qcol[:, :, None] + NA_WIN_W - 1, 0, 2 * NA_WIN_W - 2)
    col_valid = jnp.asarray(col_valid)[:, :, None, :]
    scale = dh ** -0.5
    k_grid = k.reshape(B_, rows, GRID_W, H, dh)
    v_grid = v.reshape(B_, rows, GRID_W, H, dh)
    q_rows = q.reshape(B_, rows, nb, NA_QBLOCK, H, dh).transpose(1, 0, 2, 3, 4, 5)

    def row_block(inp):
        r, q_r = inp
        rs = jnp.clip(r - kh // 2, 0, rows - kh)
        k_r = lax.dynamic_slice_in_dim(k_grid, rs, kh, axis=1)
        v_r = lax.dynamic_slice_in_dim(v_grid, rs, kh, axis=1)
        k_blk = jnp.stack([k_r[:, :, c0:c0 + NA_KBLOCK] for c0 in kc0], axis=1)
        v_blk = jnp.stack([v_r[:, :, c0:c0 + NA_KBLOCK] for c0 in kc0], axis=1)
        row_idx = rs + jnp.arange(kh) - r + NA_WIN_H - 1
        bias = rpb[:, row_idx][:, :, col_idx].transpose(0, 2, 3, 1, 4)
        s_win = jnp.einsum('bjqhd,bjikhd->bhjqik', q_r, k_blk).astype(jnp.float32) * scale
        s_win = jnp.where(col_valid, s_win + bias.astype(jnp.float32), NEG_INF)
        s_win = s_win.reshape(B_, H, nb, NA_QBLOCK, kh * NA_KBLOCK)
        s_ctx = jnp.einsum('bjqhd,bkhd->bhjqk', q_r, k_ctx).astype(jnp.float32) * scale
        p = jax.nn.softmax(jnp.concatenate([s_win, s_ctx], axis=-1), axis=-1).astype(v.dtype)
        p_win = p[..., :kh * NA_KBLOCK].reshape(B_, H, nb, NA_QBLOCK, kh, NA_KBLOCK)
        p_ctx = p[..., kh * NA_KBLOCK:]
        return (jnp.einsum('bhjqik,bjikhd->bjqhd', p_win, v_blk)
                + jnp.einsum('bhjqk,bkhd->bjqhd', p_ctx, v_ctx))

    o = lax.map(row_block, (jnp.arange(rows), q_rows))
    return o.transpose(1, 0, 2, 3, 4, 5).reshape(B_, S, H * dh)


def na_context(q, k, v):
    B_, T, H, dh = q.shape
    s = jnp.einsum('bqhd,bkhd->bhqk', q, k).astype(jnp.float32) * dh ** -0.5
    p = jax.nn.softmax(s, axis=-1).astype(v.dtype)
    return jnp.einsum('bhqk,bkhd->bqhd', p, v).reshape(B_, T, H * dh)


def gla_chunked(q, k, v, g, s0):
    B_, T, H, _ = q.shape
    dv = v.shape[-1]
    n = T // GLA_CHUNK

    def to_chunks(a):
        return a.astype(jnp.float32).reshape(B_, n, GLA_CHUNK, H, a.shape[-1]).transpose(1, 0, 3, 2, 4)

    tril = jnp.tril(jnp.ones((GLA_CHUNK, GLA_CHUNK), dtype=bool))

    def step(s, inp):
        qc, kc, vc, gc = inp
        b = jnp.cumsum(gc, axis=-2)
        b_last = b[..., -1:, :]
        qe = qc * jnp.exp(b)
        ke = kc * jnp.exp(-b)
        att = jnp.where(tril, jnp.einsum('bhtd,bhsd->bhts', qe, ke), 0.0)
        o = jnp.einsum('bhts,bhse->bhte', att, vc) + jnp.einsum('bhtd,bhde->bhte', qe, s)
        s = (jnp.exp(b_last[..., 0, :])[..., None] * s
             + jnp.einsum('bhsd,bhse->bhde', kc * jnp.exp(b_last - b), vc))
        return s, o

    s_fin, o = lax.scan(step, s0, (to_chunks(q), to_chunks(k), to_chunks(v), to_chunks(g)))
    return o.transpose(1, 0, 3, 2, 4).reshape(B_, T, H, dv), s_fin


def gla_bidir(q, k, v, g_f, g_b, s_f0, s_b0):
    o_f, s_f = gla_chunked(q, k, v, g_f, s_f0)
    o_b, s_b = gla_chunked(q[:, ::-1], k[:, ::-1], v[:, ::-1], g_b[:, ::-1], s_b0)
    return o_f + o_b[:, ::-1], s_f, s_b


def hybrid_mixer(a_lat, a_ctx, pos_r, pos_c, w_in, w_gla_a2, b_gla_a2, gla_norm_g, na_rpb,
                 w_na_o, w_gla_o, w_out, need_ctx_out):
    B_ = a_lat.shape[0]
    P_lat = split_proj(a_lat @ w_in)
    P_ctx = split_proj(a_ctx @ w_in)

    def gla_streams(P, rotary):
        q = heads(P[3], GLA_HEADS) * (GLA_HK ** -0.5)
        k = heads(P[4], GLA_HEADS)
        if rotary:
            q = rope_2d(q, pos_r, pos_c)
            k = rope_2d(k, pos_r, pos_c)
        v = heads(P[5], GLA_HEADS)
        a = P[7]
        z_f = (a[..., :GLA_GATE_RANK] @ w_gla_a2[0] + b_gla_a2[0]).astype(jnp.float32)
        z_b = (a[..., GLA_GATE_RANK:] @ w_gla_a2[1] + b_gla_a2[1]).astype(jnp.float32)
        g_f = heads(jax.nn.log_sigmoid(z_f) / GLA_GATE_NORM, GLA_HEADS)
        g_b = heads(jax.nn.log_sigmoid(z_b) / GLA_GATE_NORM, GLA_HEADS)
        return q, k, v, g_f, g_b

    def gla_readout(o, P):
        o = rmsnorm(o.astype(P[6].dtype), gla_norm_g) * jax.nn.silu(heads(P[6], GLA_HEADS))
        return o.reshape(o.shape[0], o.shape[1], GLA_DV)

    def merge(P, o_na, o_gla):
        y = jax.nn.sigmoid(P[8]) * (o_na @ w_na_o) + jax.nn.sigmoid(P[9]) * (o_gla @ w_gla_o)
        return y @ w_out

    q_na, k_na, v_na = [heads(t, NA_HEADS) for t in P_lat[:3]]
    qc_na, kc_na, vc_na = [heads(t, NA_HEADS) for t in P_ctx[:3]]
    o_na = na_latent(q_na, k_na, v_na, kc_na, vc_na, na_rpb)

    s0 = jnp.zeros((B_, GLA_HEADS, GLA_HK, GLA_HV), jnp.float32)
    oc_gla, s_f, s_b = gla_bidir(*gla_streams(P_ctx, False), s0, s0)
    o_gla, _, _ = gla_bidir(*gla_streams(P_lat, True), s_f, s_b)

    y_lat = merge(P_lat, o_na, gla_readout(o_gla, P_lat))
    y_ctx = None
    if need_ctx_out:
        y_ctx = merge(P_ctx, na_context(qc_na, kc_na, vc_na), gla_readout(oc_gla, P_ctx))
    return y_lat, y_ctx


def hier_moe(x2d, w_group, b_group, w_expert, b_expert, w_gate, w_up, w_down):
    T, D = x2d.shape
    lg = (x2d @ w_group).astype(jnp.float32) + b_group
    grp = jnp.argmax(lg, axis=-1)
    p_grp = jnp.take_along_axis(jax.nn.softmax(lg, axis=-1), grp[:, None], axis=-1)
    le = ((x2d @ w_expert).astype(jnp.float32) + b_expert).reshape(T, N_GROUPS, EXPERTS_PER_GROUP)
    le_g = jnp.take_along_axis(le, grp[:, None, None], axis=1)[:, 0]
    top_p, top_i = lax.top_k(jax.nn.softmax(le_g, axis=-1), TOP_K)
    weights = p_grp * top_p / jnp.sum(top_p, axis=-1, keepdims=True)
    expert_id = grp[:, None] * EXPERTS_PER_GROUP + top_i

    ids = expert_id.reshape(-1).astype(jnp.int32)
    wts = weights.reshape(-1)
    tok = jnp.repeat(jnp.arange(T, dtype=jnp.int32), TOP_K)
    order = jnp.argsort(ids)
    ids_s, tok_s, w_s = ids[order], tok[order], wts[order]
    counts = jax.ops.segment_sum(jnp.ones_like(ids), ids, num_segments=N_EXPERTS)
    padded = (counts + MOE_BLOCK - 1) // MOE_BLOCK * MOE_BLOCK
    start = jnp.cumsum(counts) - counts
    pend = jnp.cumsum(padded)
    pstart = pend - padded
    dest = pstart[ids_s] + (jnp.arange(T * TOP_K, dtype=jnp.int32) - start[ids_s])
    n_pad = (T * TOP_K + N_EXPERTS * (MOE_BLOCK - 1) + MOE_BLOCK - 1) // MOE_BLOCK * MOE_BLOCK
    n_blk = n_pad // MOE_BLOCK
    tok_buf = jnp.full((n_pad,), T, jnp.int32).at[dest].set(tok_s)
    w_buf = jnp.zeros((n_pad,), jnp.float32).at[dest].set(w_s)
    blk_start = jnp.arange(n_blk, dtype=jnp.int32) * MOE_BLOCK
    blk_expert = jnp.clip(jnp.searchsorted(pend, blk_start, side='right'), 0, N_EXPERTS - 1)
    x_pad = jnp.concatenate([x2d, jnp.zeros((1, D), x2d.dtype)], axis=0)
    xb = x_pad[tok_buf].reshape(n_blk, MOE_BLOCK, D)

    def expert_block(inp):
        xe, e = inp
        hdn = jax.nn.silu(xe @ w_gate[e]) * (xe @ w_up[e])
        return hdn @ w_down[e]

    yb = lax.map(expert_block, (xb, blk_expert)).reshape(n_pad, D)
    y = jax.ops.segment_sum(yb * w_buf[:, None].astype(yb.dtype), tok_buf, num_segments=T + 1)
    return y[:T]


def setup_inputs(seed: int = 0) -> dict:
    key = jax.random.key(seed)
    ks = jax.random.split(key, 24)
    f32 = jnp.float32
    L = DEPTH

    def nrm(k, shape, scale):
        return jax.random.normal(k, shape, f32) * scale

    return {
        "x": nrm(ks[0], (BATCH, SEQ, D_MODEL), 1.0),
        "c": nrm(ks[1], (BATCH, D_MODEL), 1.0),
        "ctx": nrm(ks[2], (BATCH, CTX_LEN, D_MODEL), 1.0),
        "c_ctx": nrm(ks[3], (D_MODEL,), 1.0),
        "w_mod": nrm(ks[4], (L, D_MODEL, 6 * D_MODEL), 0.5 * D_MODEL ** -0.5),
        "b_mod": nrm(ks[5], (L, 6 * D_MODEL), 0.02),
        "norm_attn_g": 1.0 + nrm(ks[6], (L, D_MODEL), 0.02),
        "norm_ffn_g": 1.0 + nrm(ks[7], (L, D_MODEL), 0.02),
        "w_in": nrm(ks[8], (L, D_MODEL, D_IN), D_MODEL ** -0.5),
        "w_gla_a2": nrm(ks[9], (L, 2, GLA_GATE_RANK, GLA_DK), GLA_GATE_RANK ** -0.5),
        "b_gla_a2": nrm(ks[10], (L, 2, GLA_DK), 0.1),
        "gla_norm_g": 1.0 + nrm(ks[11], (L, GLA_HV), 0.02),
        "na_rpb": nrm(ks[12], (L, NA_HEADS, 2 * NA_WIN_H - 1, 2 * NA_WIN_W - 1), 0.1),
        "w_na_o": nrm(ks[13], (L, NA_WIDTH, D_MODEL), NA_WIDTH ** -0.5),
        "w_gla_o": nrm(ks[14], (L, GLA_DV, D_MODEL), GLA_DV ** -0.5),
        "w_out": nrm(ks[15], (L, D_MODEL, D_MODEL), D_MODEL ** -0.5),
        "w_group": nrm(ks[16], (L, D_MODEL, N_GROUPS), D_MODEL ** -0.5),
        "b_group": nrm(ks[17], (L, N_GROUPS), 0.01),
        "w_expert": nrm(ks[18], (L, D_MODEL, N_EXPERTS), D_MODEL ** -0.5),
        "b_expert": nrm(ks[19], (L, N_EXPERTS), 0.01),
        "w_exp_gate": nrm(ks[20], (L, N_EXPERTS, D_MODEL, D_EXPERT), D_MODEL ** -0.5),
        "w_exp_up": nrm(ks[21], (L, N_EXPERTS, D_MODEL, D_EXPERT), D_MODEL ** -0.5),
        "w_exp_down": nrm(ks[22], (L, N_EXPERTS, D_EXPERT, D_MODEL), D_EXPERT ** -0.5),
        "final_norm_g": 1.0 + nrm(ks[23], (D_MODEL,), 0.02),
    }


def reference(x, c, ctx, c_ctx, w_mod, b_mod, norm_attn_g, norm_ffn_g, w_in, w_gla_a2, b_gla_a2,
              gla_norm_g, na_rpb, w_na_o, w_gla_o, w_out, w_group, b_group, w_expert, b_expert,
              w_exp_gate, w_exp_up, w_exp_down, final_norm_g):
    B_, S, D = x.shape
    t = jnp.arange(S)
    pos_r = (t // GRID_W).astype(jnp.float32)
    pos_c = (t % GRID_W).astype(jnp.float32)
    h, hc = x, ctx
    for l in range(DEPTH):
        ctx_continues = l < DEPTH - 1
        mod = jax.nn.silu(c) @ w_mod[l] + b_mod[l]
        sh1, sc1, g1, sh2, sc2, g2 = jnp.split(mod[:, None, :], 6, axis=-1)
        csh1, csc1, cg1, csh2, csc2, cg2 = jnp.split(jax.nn.silu(c_ctx) @ w_mod[l] + b_mod[l], 6, axis=-1)
        a_lat = rmsnorm(h, norm_attn_g[l]) * (1 + sc1) + sh1
        a_ctx = rmsnorm(hc, norm_attn_g[l]) * (1 + csc1) + csh1
        y_lat, y_ctx = hybrid_mixer(a_lat, a_ctx, pos_r, pos_c, w_in[l], w_gla_a2[l], b_gla_a2[l],
                                    gla_norm_g[l], na_rpb[l], w_na_o[l], w_gla_o[l], w_out[l],
                                    ctx_continues)
        h = h + g1 * y_lat
        f_lat = rmsnorm(h, norm_ffn_g[l]) * (1 + sc2) + sh2
        h = h + g2 * hier_moe(f_lat.reshape(-1, D), w_group[l], b_group[l], w_expert[l], b_expert[l],
                              w_exp_gate[l], w_exp_up[l], w_exp_down[l]).reshape(B_, S, D)
        if ctx_continues:
            hc = hc + cg1 * y_ctx
            f_ctx = rmsnorm(hc, norm_ffn_g[l]) * (1 + csc2) + csh2
            hc = hc + cg2 * hier_moe(f_ctx.reshape(-1, D), w_group[l], b_group[l], w_expert[l], b_expert[l],
                                     w_exp_gate[l], w_exp_up[l], w_exp_down[l]).reshape(hc.shape)
    return rmsnorm(h, final_norm_g)
```

```cpp
#include <hip/hip_runtime.h>
#include <hip/hip_cooperative_groups.h>
#include <cstdint>
#include <cstdio>
namespace cg = cooperative_groups;

#ifndef MEGA
#define MEGA 0
#endif

typedef unsigned short bf16_t;
typedef short bf16x8 __attribute__((ext_vector_type(8)));
typedef float f32x4 __attribute__((ext_vector_type(4)));
typedef float f32x2 __attribute__((ext_vector_type(2)));
typedef unsigned u32x4 __attribute__((ext_vector_type(4)));
typedef unsigned u32x2 __attribute__((ext_vector_type(2)));

constexpr int NB = 16, SEQ = 2048, DM = 1024, CTX = 256, GW = 64;
constexpr int TL = NB * SEQ;
constexpr int TC = NB * CTX;
constexpr int TA = TL + TC;
constexpr int NEXP = 32, DEXP = 512;
constexpr int NT = 512;
constexpr float EPS = 1e-6f;
constexpr int MAXROWS = 73728;

constexpr size_t MiB = 1u << 20;
constexpr size_t WS_CTL = 0;
constexpr size_t WS_MOD = 1 * MiB;
constexpr size_t WS_ROPE = 1 * MiB + 512 * 1024;
constexpr size_t WS_ROUTE = 2 * MiB;
constexpr size_t WS_ROWTOK = 3 * MiB;
constexpr size_t WS_ROWW = 3 * MiB + 512 * 1024;
constexpr size_t WS_WIN = 4 * MiB;
constexpr size_t WS_WNAO = WS_WIN + (size_t)6912 * 1024 * 2;
constexpr size_t WS_WGLAO = WS_WNAO + 1 * MiB;
constexpr size_t WS_WOUT = WS_WGLAO + 2 * MiB;
constexpr size_t WS_ALR = WS_WOUT + 2 * MiB;
constexpr size_t WS_QN = 28 * MiB;
constexpr size_t WS_KN = 60 * MiB;
constexpr size_t WS_VN = 96 * MiB;
constexpr size_t WS_QG = 132 * MiB;
constexpr size_t WS_KG = 164 * MiB;
constexpr size_t WS_VG = 200 * MiB;
constexpr size_t WS_ONA = 272 * MiB;
constexpr size_t WS_GG = 304 * MiB;
constexpr size_t WS_M8 = 368 * MiB;
constexpr size_t WS_M9 = 432 * MiB;
constexpr size_t WS_END = 496 * MiB;
constexpr size_t WS_HMID = 28 * MiB;
constexpr size_t WS_FL = 200 * MiB;
constexpr size_t WS_H = 200 * MiB;
constexpr size_t WS_XG = 304 * MiB;
constexpr size_t WS_YS = 304 * MiB;
static_assert(WS_ALR + (size_t)TA * 32 * 4 <= WS_QN, "ws map");
constexpr size_t OUT_WGU = 0;
constexpr size_t OUT_WD = 64 * MiB;

constexpr int CW_CNT = 0;

__device__ __forceinline__ unsigned f2bf(float f) { unsigned u = __builtin_bit_cast(unsigned, f); return (u + 0x7fffu + ((u >> 16) & 1u)) >> 16; }
__device__ __forceinline__ unsigned pk2(float lo, float hi) { return f2bf(lo) | (f2bf(hi) << 16); }
__device__ __forceinline__ float bf2f(unsigned short h) { return __builtin_bit_cast(float, (unsigned)h << 16); }
__device__ __forceinline__ float bflo(unsigned u) { return __builtin_bit_cast(float, u << 16); }
__device__ __forceinline__ float bfhi(unsigned u) { return __builtin_bit_cast(float, u & 0xffff0000u); }
__device__ __forceinline__ float wave_sum(float v) {
#pragma unroll
    for (int o = 1; o < 64; o <<= 1) v += __shfl_xor(v, o);
    return v;
}
__device__ __forceinline__ float sigmoidf_(float x) { return 1.f / (1.f + __expf(-x)); }
__device__ __forceinline__ float siluf_(float x) { return x / (1.f + __expf(-x)); }

struct Params {
    const float* in[24];
    float* out;
    unsigned char* ws;
};
enum { I_X = 0, I_C, I_CTX, I_CCTX, I_WMOD, I_BMOD, I_NAG, I_NFG, I_WIN, I_WA2, I_BA2, I_GNG, I_RPB, I_WNAO, I_WGLAO, I_WOUT,
       I_WGRP, I_BGRP, I_WEXP, I_BEXP, I_WG, I_WU, I_WD, I_FNG };

__device__ void p0_mod(const Params& p, float* lds, int blk) {
    const int tid = threadIdx.x;
    float* sc = lds;
    for (int i = tid; i < 17 * 1024; i += NT) {
        const int r = i >> 10, k = i & 1023;
        const float v = r < 16 ? p.in[I_C][r * 1024 + k] : p.in[I_CCTX][k];
        sc[i] = siluf_(v);
    }
    __syncthreads();
    const int cg4 = tid & 7, kr = tid >> 3;
    const int n0 = blk * 32 + cg4 * 4;
    float acc[17][4];
#pragma unroll
    for (int r = 0; r < 17; ++r) { acc[r][0] = 0.f; acc[r][1] = 0.f; acc[r][2] = 0.f; acc[r][3] = 0.f; }
    const float* W = p.in[I_WMOD];
#pragma unroll 2
    for (int kb = 0; kb < 1024; kb += 64) {
        const int k = kb + kr;
        const f32x4 w = *(const f32x4*)(W + (size_t)k * 6144 + n0);
#pragma unroll
        for (int r = 0; r < 17; ++r) { const float s = sc[r * 1024 + k]; acc[r][0] += s * w[0]; acc[r][1] += s * w[1]; acc[r][2] += s * w[2]; acc[r][3] += s * w[3]; }
    }
#pragma unroll
    for (int r = 0; r < 17; ++r)
#pragma unroll
        for (int j = 0; j < 4; ++j) { float v = acc[r][j]; v += __shfl_xor(v, 8); v += __shfl_xor(v, 16); v += __shfl_xor(v, 32); acc[r][j] = v; }
    __syncthreads();
    float* red = lds;
    const int wave = tid >> 6, lane = tid & 63;
    if (lane < 8) {
#pragma unroll
        for (int r = 0; r < 17; ++r)
#pragma unroll
            for (int j = 0; j < 4; ++j) red[(wave * 8 + lane) * 68 + r * 4 + j] = acc[r][j];
    }
    __syncthreads();
    float* MOD = (float*)(p.ws + WS_MOD);
    for (int i = tid; i < 8 * 68; i += NT) {
        const int c = i / 68, q = i % 68, r = q >> 2, j = q & 3;
        float s = 0.f;
#pragma unroll
        for (int w = 0; w < 8; ++w) s += red[(w * 8 + c) * 68 + q];
        const int n = blk * 32 + c * 4 + j;
        MOD[r * 6144 + n] = s + p.in[I_BMOD][n];
    }
    __syncthreads();
}

template <class ColMap>
__device__ __forceinline__ void transpose_item(const float* W, int ld, bf16_t* WT, int K, int k0, int n0, float* scr, int lane, const ColMap& cm) {
    const int sc = cm(n0 + (lane & 31));
#pragma unroll 8
    for (int i = 0; i < 32; ++i) { const int kk = 2 * i + (lane >> 5); scr[kk * 33 + (lane & 31)] = sc >= 0 ? W[(size_t)(k0 + kk) * ld + sc] : 0.f; }
    asm volatile("s_waitcnt lgkmcnt(0)" ::: "memory");
    __builtin_amdgcn_wave_barrier();
    const int c = lane & 7;
#pragma unroll
    for (int j = 0; j < 4; ++j) { const int n = (lane >> 3) + 8 * j; const float* s = scr + (8 * c) * 33 + n;
        u32x4 o; o.x = pk2(s[0 * 33], s[1 * 33]); o.y = pk2(s[2 * 33], s[3 * 33]); o.z = pk2(s[4 * 33], s[5 * 33]); o.w = pk2(s[6 * 33], s[7 * 33]);
        *(u32x4*)(WT + (size_t)(n0 + n) * K + k0 + 8 * c) = o; }
    asm volatile("s_waitcnt lgkmcnt(0)" ::: "memory");
    __builtin_amdgcn_wave_barrier();
}
__device__ __forceinline__ int rope_perm(int pp) { const int wc = pp >> 5, n = (pp >> 4) & 1, r = pp & 15; return 64 * (wc >> 1) + 32 * n + 16 * (wc & 1) + r; }
struct CmIn { __device__ int operator()(int n) const {
    if (n < 1536) return n;
    if (n < 2560) return (n & ~127) + rope_perm(n & 127);
    if (n < 4608) return n;
    if (n < 6656) return n + 32;
    if (n < 6688) return n - 6656 + 4608;
    return -1; } };
struct CmId { __device__ int operator()(int n) const { return n; } };
struct CmGU { int which; __device__ int operator()(int n) const { const int t = n >> 8, q = n & 255; return ((q >> 7) == which) ? (128 * t + (q & 127)) : -2; } };

__device__ void p0_prep_small(const Params& p, float* lds, int gw, int ngw) {
    const int lane = threadIdx.x & 63, wave = threadIdx.x >> 6;
    float* scr = lds + wave * (64 * 33);
    constexpr int I_IN = 16 * 216, I_NAO = 8 * 32, I_GLAO = 16 * 32, I_OUT = 16 * 32;
    for (int it = gw; it < I_IN + I_NAO + I_GLAO + I_OUT; it += ngw) {
        int r = it;
        if (r < I_IN) { transpose_item(p.in[I_WIN], 6688, (bf16_t*)(p.ws + WS_WIN), 1024, 64 * (r / 216), 32 * (r % 216), scr, lane, CmIn()); continue; } r -= I_IN;
        if (r < I_NAO) { transpose_item(p.in[I_WNAO], 1024, (bf16_t*)(p.ws + WS_WNAO), 512, 64 * (r / 32), 32 * (r % 32), scr, lane, CmId()); continue; } r -= I_NAO;
        if (r < I_GLAO) { transpose_item(p.in[I_WGLAO], 1024, (bf16_t*)(p.ws + WS_WGLAO), 1024, 64 * (r / 32), 32 * (r % 32), scr, lane, CmId()); continue; } r -= I_GLAO;
        transpose_item(p.in[I_WOUT], 1024, (bf16_t*)(p.ws + WS_WOUT), 1024, 64 * (r / 32), 32 * (r % 32), scr, lane, CmId());
    }
}
__device__ void prep_experts(const Params& p, float* lds, int gw, int ngw) {
    const int lane = threadIdx.x & 63, wave = threadIdx.x >> 6;
    float* scr = lds + wave * (64 * 33);
    bf16_t* WGU = (bf16_t*)((unsigned char*)p.out + OUT_WGU);
    bf16_t* WDt = (bf16_t*)((unsigned char*)p.out + OUT_WD);
    constexpr int PER_GU = 16 * 32, PER_D = 8 * 32;
    for (int it = gw; it < NEXP * (PER_GU + PER_D); it += ngw) {
        const int e = it / (PER_GU + PER_D); int r = it % (PER_GU + PER_D);
        if (r < PER_GU) {
            const int k0 = 64 * (r / 32), n0 = 32 * (r % 32);
            const int t = n0 >> 8, q = n0 & 255, which = q >> 7;
            const float* src = (which == 0 ? p.in[I_WG] : p.in[I_WU]) + (size_t)e * 1024 * 512;
            struct Cm { int base, n0; __device__ int operator()(int n) const { return base + (n - n0); } } cm{128 * t + (q & 127), n0};
            transpose_item(src, 512, WGU + (size_t)e * 1024 * 1024, 1024, k0, n0, scr, lane, cm);
        } else {
            r -= PER_GU;
            transpose_item(p.in[I_WD] + (size_t)e * 512 * 1024, 1024, WDt + (size_t)e * 1024 * 512, 512, 64 * (r / 32), 32 * (r % 32), scr, lane, CmId());
        }
    }
}

__device__ void phase0(const Params& p, float* lds, int bid, int nb) {
    const int tid = threadIdx.x;
    if (bid == 0) {
        if (tid < 64) ((int*)(p.ws + WS_CTL))[tid] = 0;
        f32x2* RT = (f32x2*)(p.ws + WS_ROPE);
        for (int i = tid; i < 64 * 32; i += NT) {
            const int pos = i >> 5, j = i & 31;
            const float inv = exp2f(-(float)j * 0.41524101186092029f);
            const float ang = (float)pos * inv;
            double rev = (double)ang * 0.15915494309189535; rev -= floor(rev);
            const float fr = (float)rev;
            RT[i] = (f32x2){__builtin_amdgcn_cosf(fr), __builtin_amdgcn_sinf(fr)};
        }
    }
    for (int b = bid; b < 192; b += nb) p0_mod(p, lds, b);
    p0_prep_small(p, lds, bid * 8 + (tid >> 6), nb * 8);
}

__device__ void phase1(const Params& p, int bid, int nb) {
    const int lane = threadIdx.x & 63;
    const int gw = bid * 8 + (threadIdx.x >> 6), ngw = nb * 8;
    const float* MOD = (const float*)(p.ws + WS_MOD);
    bf16_t* A1 = (bf16_t*)p.out;
    const float* G = p.in[I_NAG];
    for (int row = gw; row < TA; row += ngw) {
        const float* xr; int mr;
        if (row < TL) { xr = p.in[I_X] + (size_t)row * DM; mr = row >> 11; } else { xr = p.in[I_CTX] + (size_t)(row - TL) * DM; mr = 16; }
        f32x4 v[4]; float s = 0.f;
#pragma unroll
        for (int j = 0; j < 4; ++j) { v[j] = *(const f32x4*)(xr + 4 * lane + 256 * j); s += v[j][0] * v[j][0] + v[j][1] * v[j][1] + v[j][2] * v[j][2] + v[j][3] * v[j][3]; }
        const float rstd = rsqrtf(wave_sum(s) * (1.f / DM) + EPS);
#pragma unroll
        for (int j = 0; j < 4; ++j) {
            const int c = 4 * lane + 256 * j;
            const f32x4 g = *(const f32x4*)(G + c), sh = *(const f32x4*)(MOD + mr * 6144 + c), sc = *(const f32x4*)(MOD + mr * 6144 + 1024 + c);
            f32x4 o;
#pragma unroll
            for (int i = 0; i < 4; ++i) o[i] = (v[j][i] * rstd) * g[i] * (1.f + sc[i]) + sh[i];
            u32x2 w; w.x = pk2(o[0], o[1]); w.y = pk2(o[2], o[3]);
            *(u32x2*)(A1 + (size_t)row * DM + c) = w;
        }
    }
}

struct Unit { int pm, pn; const bf16_t* a; const bf16_t* b; int aux; };
template <class Sched, class Epi>
__device__ void gemm_simple(unsigned char* lds, int K, const Sched& S, const Epi& E) {
    const int tid = threadIdx.x, wid = tid >> 6, lane = tid & 63, wr = wid >> 2, wc = wid & 3, fr = lane & 15, fq = lane >> 4;
    bf16_t* As = (bf16_t*)lds; bf16_t* Bs = As + 256 * 72;
    Unit u;
    for (int it = 0; S.next(it, u); ++it) {
        f32x4 acc[2][2][4][2];
#pragma unroll
        for (int a = 0; a < 2; ++a)
#pragma unroll
            for (int b = 0; b < 2; ++b)
#pragma unroll
                for (int m = 0; m < 4; ++m)
#pragma unroll
                    for (int n = 0; n < 2; ++n) acc[a][b][m][n] = (f32x4){0.f, 0.f, 0.f, 0.f};
        for (int k0 = 0; k0 < K; k0 += 64) {
            __syncthreads();
#pragma unroll
            for (int j = 0; j < 4; ++j) {
                const int c = tid + NT * j, row = c >> 3, c8 = c & 7;
                const u32x4 va = *(const u32x4*)(u.a + (size_t)row * K + k0 + c8 * 8);
                const u32x4 vb = *(const u32x4*)(u.b + (size_t)row * K + k0 + c8 * 8);
                *(u32x4*)(As + row * 72 + c8 * 8) = va;
                *(u32x4*)(Bs + row * 72 + c8 * 8) = vb;
            }
            __syncthreads();
#pragma unroll
            for (int kk = 0; kk < 2; ++kk) {
                bf16x8 af[2][4], bfg[2][2];
#pragma unroll
                for (int a = 0; a < 2; ++a)
#pragma unroll
                    for (int m = 0; m < 4; ++m) af[a][m] = *(const bf16x8*)(As + (128 * a + 64 * wr + 16 * m + fr) * 72 + kk * 32 + fq * 8);
#pragma unroll
                for (int b = 0; b < 2; ++b)
#pragma unroll
                    for (int n = 0; n < 2; ++n) bfg[b][n] = *(const bf16x8*)(Bs + (128 * b + 32 * wc + 16 * n + fr) * 72 + kk * 32 + fq * 8);
#pragma unroll
                for (int a = 0; a < 2; ++a)
#pragma unroll
                    for (int b = 0; b < 2; ++b)
#pragma unroll
                        for (int m = 0; m < 4; ++m)
#pragma unroll
                            for (int n = 0; n < 2; ++n) acc[a][b][m][n] = __builtin_amdgcn_mfma_f32_16x16x32_bf16(bfg[b][n], af[a][m], acc[a][b][m][n], 0, 0, 0);
            }
        }
        E(acc, u, wr, wc, fr, fq);
    }
}

struct SchedIn {
    const bf16_t* A; const bf16_t* Bt; int G, c;
    __device__ bool next(int i, Unit& u) const {
        const int L = i * G + c;
        constexpr int NLAT = 128 * 27, NCTX = 16 * 11;
        if (L >= NLAT + NCTX) return false;
        if (L < NLAT) { u.pm = L / 27; u.pn = L % 27; }
        else { const int q = L - NLAT; const int j = q % 11; u.pm = 128 + q / 11; u.pn = j < 4 ? 2 + j : (j < 10 ? 8 + (j - 4) : 26); }
        u.a = A + (size_t)u.pm * 256 * 1024; u.b = Bt + (size_t)u.pn * 256 * 1024; u.aux = 0;
        return true;
    }
};
struct EpiIn {
    unsigned char* ws;
    __device__ __forceinline__ void operator()(const f32x4 (&acc)[2][2][4][2], const Unit& u, int wr, int wc, int fr, int fq) const {
        const int pn = u.pn;
        const int row0 = u.pm * 256 + wr * 64 + fr;
        if (pn == 26) {
            float* ALR = (float*)(ws + WS_ALR);
            if (wc == 0) {
#pragma unroll
                for (int ai = 0; ai < 2; ++ai)
#pragma unroll
                    for (int m = 0; m < 4; ++m) { const int row = row0 + ai * 128 + m * 16;
#pragma unroll
                        for (int n = 0; n < 2; ++n) *(f32x4*)(ALR + (size_t)row * 32 + 16 * n + 4 * fq) = acc[ai][0][m][n]; }
            }
            return;
        }
        if (pn >= 6 && pn < 10) {
            const bool isq = pn < 8;
            bf16_t* dst = (bf16_t*)(ws + (isq ? WS_QG : WS_KG));
            const float scale = isq ? 0.08838834764831845f : 1.0f;
            const f32x2* RT = (const f32x2*)(ws + WS_ROPE);
            const int half = wc >> 1, j0 = 16 * (wc & 1) + 4 * fq;
#pragma unroll
            for (int ai = 0; ai < 2; ++ai)
#pragma unroll
                for (int m = 0; m < 4; ++m) { const int row = row0 + ai * 128 + m * 16;
                    const bool lat = row < TL; const int t = row & 2047; const int pos = half == 0 ? (t >> 6) : (t & 63);
                    float cs[4], sn[4];
#pragma unroll
                    for (int i = 0; i < 4; ++i) { if (lat) { const f32x2 v = RT[pos * 32 + j0 + i]; cs[i] = v.x; sn[i] = v.y; } else { cs[i] = 1.f; sn[i] = 0.f; } }
#pragma unroll
                    for (int bj = 0; bj < 2; ++bj) {
                        const int head = (pn & 1) * 2 + bj;
                        const f32x4 x1 = acc[ai][bj][m][0] * scale, x2 = acc[ai][bj][m][1] * scale;
                        float o1[4], o2[4];
#pragma unroll
                        for (int i = 0; i < 4; ++i) { o1[i] = x1[i] * cs[i] - x2[i] * sn[i]; o2[i] = x1[i] * sn[i] + x2[i] * cs[i]; }
                        bf16_t* rp = dst + (size_t)row * 512 + head * 128 + 64 * half + j0;
                        u32x2 w1, w2; w1.x = pk2(o1[0], o1[1]); w1.y = pk2(o1[2], o1[3]); w2.x = pk2(o2[0], o2[1]); w2.y = pk2(o2[2], o2[3]);
                        *(u32x2*)rp = w1; *(u32x2*)(rp + 32) = w2;
                    } }
            return;
        }
        bf16_t* dst; int ld, cbase; float scale = 1.f;
        if (pn < 2) { dst = (bf16_t*)(ws + WS_QN); ld = 512; cbase = pn * 256; scale = 0.125f; }
        else if (pn < 4) { dst = (bf16_t*)(ws + WS_KN); ld = 512; cbase = (pn - 2) * 256; }
        else if (pn < 6) { dst = (bf16_t*)(ws + WS_VN); ld = 512; cbase = (pn - 4) * 256; }
        else if (pn < 14) { dst = (bf16_t*)(ws + WS_VG); ld = 1024; cbase = (pn - 10) * 256; }
        else if (pn < 18) { dst = (bf16_t*)(ws + WS_GG); ld = 1024; cbase = (pn - 14) * 256; }
        else if (pn < 22) { dst = (bf16_t*)(ws + WS_M8); ld = 1024; cbase = (pn - 18) * 256; }
        else { dst = (bf16_t*)(ws + WS_M9); ld = 1024; cbase = (pn - 22) * 256; }
#pragma unroll
        for (int ai = 0; ai < 2; ++ai)
#pragma unroll
            for (int m = 0; m < 4; ++m) { bf16_t* rp = dst + (size_t)(row0 + ai * 128 + m * 16) * ld + cbase + wc * 32 + 4 * fq;
#pragma unroll
                for (int bj = 0; bj < 2; ++bj)
#pragma unroll
                    for (int n = 0; n < 2; ++n) { const f32x4 v = acc[ai][bj][m][n] * scale; u32x2 w; w.x = pk2(v[0], v[1]); w.y = pk2(v[2], v[3]);
                        *(u32x2*)(rp + bj * 128 + n * 16) = w; } }
    }
};

__device__ void na_naive(const Params& p, int item) {
    const int lane = threadIdx.x & 63;
    const int h = item & 7, r = (item >> 3) & 31, b = item >> 8;
    const bf16_t* QN = (const bf16_t*)(p.ws + WS_QN); const bf16_t* KN = (const bf16_t*)(p.ws + WS_KN); const bf16_t* VN = (const bf16_t*)(p.ws + WS_VN);
    const int tok = b * SEQ + r * GW + lane;
    float q[64], o[64];
    { const u32x4* qp = (const u32x4*)(QN + (size_t)tok * 512 + h * 64);
#pragma unroll
      for (int j = 0; j < 8; ++j) { const u32x4 v = qp[j]; q[8 * j] = bflo(v.x); q[8 * j + 1] = bfhi(v.x); q[8 * j + 2] = bflo(v.y); q[8 * j + 3] = bfhi(v.y); q[8 * j + 4] = bflo(v.z); q[8 * j + 5] = bfhi(v.z); q[8 * j + 6] = bflo(v.w); q[8 * j + 7] = bfhi(v.w); } }
#pragma unroll
    for (int d = 0; d < 64; ++d) o[d] = 0.f;
    float mx = -1e30f, l = 0.f;
    const int rs = min(max(r - 4, 0), 24), cs = min(max(lane - 8, 0), 48);
    const float* rpb = p.in[I_RPB] + h * 15 * 31;
    for (int kk = 0; kk < 128 + 256; ++kk) {
        size_t krow; float bias = 0.f;
        if (kk < 128) { const int i = kk >> 4, kc = cs + (kk & 15); krow = (size_t)b * SEQ + (rs + i) * GW + kc; bias = rpb[(rs + i - r + 7) * 31 + (kc - lane + 15)]; }
        else krow = (size_t)TL + b * CTX + (kk - 128);
        const u32x4* kp = (const u32x4*)(KN + krow * 512 + h * 64);
        float s = 0.f;
#pragma unroll
        for (int j = 0; j < 8; ++j) { const u32x4 v = kp[j];
            s += q[8 * j] * bflo(v.x) + q[8 * j + 1] * bfhi(v.x) + q[8 * j + 2] * bflo(v.y) + q[8 * j + 3] * bfhi(v.y) + q[8 * j + 4] * bflo(v.z) + q[8 * j + 5] * bfhi(v.z) + q[8 * j + 6] * bflo(v.w) + q[8 * j + 7] * bfhi(v.w); }
        s += bias;
        const float mn = fmaxf(mx, s), al = __expf(mx - mn), pe = __expf(s - mn);
        l = l * al + pe; mx = mn;
        const u32x4* vp = (const u32x4*)(VN + krow * 512 + h * 64);
#pragma unroll
        for (int j = 0; j < 8; ++j) { const u32x4 v = vp[j];
            o[8 * j] = o[8 * j] * al + pe * bflo(v.x); o[8 * j + 1] = o[8 * j + 1] * al + pe * bfhi(v.x); o[8 * j + 2] = o[8 * j + 2] * al + pe * bflo(v.y); o[8 * j + 3] = o[8 * j + 3] * al + pe * bfhi(v.y);
            o[8 * j + 4] = o[8 * j + 4] * al + pe * bflo(v.z); o[8 * j + 5] = o[8 * j + 5] * al + pe * bfhi(v.z); o[8 * j + 6] = o[8 * j + 6] * al + pe * bflo(v.w); o[8 * j + 7] = o[8 * j + 7] * al + pe * bfhi(v.w); }
    }
    const float il = 1.f / l;
    bf16_t* ONA = (bf16_t*)(p.ws + WS_ONA);
    u32x4* op = (u32x4*)(ONA + (size_t)tok * 512 + h * 64);
#pragma unroll
    for (int j = 0; j < 8; ++j) { u32x4 w; w.x = pk2(o[8 * j] * il, o[8 * j + 1] * il); w.y = pk2(o[8 * j + 2] * il, o[8 * j + 3] * il); w.z = pk2(o[8 * j + 4] * il, o[8 * j + 5] * il); w.w = pk2(o[8 * j + 6] * il, o[8 * j + 7] * il); op[j] = w; }
}

__device__ void gla_naive(const Params& p, float* lds, int item) {
    const int tid = threadIdx.x;
    const int h = item & 3, b = item >> 2;
    float* sdec = lds;
    float* sk = lds + 2048;
    float* sq = lds + 4096;
    const bf16_t* QG = (const bf16_t*)(p.ws + WS_QG); const bf16_t* KG = (const bf16_t*)(p.ws + WS_KG); const bf16_t* VG = (const bf16_t*)(p.ws + WS_VG);
    const float* ALR = (const float*)(p.ws + WS_ALR);
    float* OG = (float*)p.out;
    for (int dir = 0; dir < 2; ++dir) {
        float S[128];
#pragma unroll
        for (int d = 0; d < 128; ++d) S[d] = 0.f;
        const int d_ = tid & 127;
        float w2[16];
#pragma unroll
        for (int r = 0; r < 16; ++r) w2[r] = p.in[I_WA2][(dir * 16 + r) * 512 + h * 128 + d_];
        const float b2 = p.in[I_BA2][dir * 512 + h * 128 + d_];
        for (int c0 = 0; c0 < CTX + SEQ; c0 += 16) {
            __syncthreads();
#pragma unroll
            for (int q4 = 0; q4 < 4; ++q4) {
                const int tt = (tid >> 7) + 4 * q4;
                const int sp = c0 + tt;
                int row; bool lat;
                if (sp < CTX) { lat = false; const int t = dir == 0 ? sp : CTX - 1 - sp; row = TL + b * CTX + t; }
                else { lat = true; const int t = dir == 0 ? sp - CTX : SEQ - 1 - (sp - CTX); row = b * SEQ + t; }
                float z = b2;
                const float* al = ALR + (size_t)row * 32 + dir * 16;
#pragma unroll
                for (int r = 0; r < 16; ++r) z += al[r] * w2[r];
                const float ls = fminf(z, 0.f) - log1pf(__expf(-fabsf(z)));
                sdec[tt * 128 + d_] = __expf(ls * (1.f / 16.f));
                sk[tt * 128 + d_] = bf2f(KG[(size_t)row * 512 + h * 128 + d_]);
                sq[tt * 128 + d_] = lat ? bf2f(QG[(size_t)row * 512 + h * 128 + d_]) : 0.f;
            }
            __syncthreads();
            if (tid < 256) {
                for (int tt = 0; tt < 16; ++tt) {
                    const int sp = c0 + tt;
                    int row; bool lat;
                    if (sp < CTX) { lat = false; const int t = dir == 0 ? sp : CTX - 1 - sp; row = TL + b * CTX + t; }
                    else { lat = true; const int t = dir == 0 ? sp - CTX : SEQ - 1 - (sp - CTX); row = b * SEQ + t; }
                    const float v = bf2f(VG[(size_t)row * 1024 + h * 256 + tid]);
                    float o = 0.f;
#pragma unroll
                    for (int d4 = 0; d4 < 32; ++d4) {
                        const f32x4 dc = *(const f32x4*)(sdec + tt * 128 + 4 * d4), kk = *(const f32x4*)(sk + tt * 128 + 4 * d4), qq = *(const f32x4*)(sq + tt * 128 + 4 * d4);
#pragma unroll
                        for (int i = 0; i < 4; ++i) { S[4 * d4 + i] = dc[i] * S[4 * d4 + i] + kk[i] * v; o += qq[i] * S[4 * d4 + i]; }
                    }
                    if (lat) { float* op = OG + (size_t)row * 1024 + h * 256 + tid; if (dir == 0) *op = o; else *op += o; }
                }
            }
        }
    }
    __syncthreads();
}

__device__ void phase3(const Params& p, float* lds, int bid, int nb) {
    const int ngla = nb >= 128 ? 64 : 0;
    if (bid < ngla) { gla_naive(p, lds, bid); }
    else {
        if (ngla == 0) for (int it = bid; it < 64; it += nb) gla_naive(p, lds, it);
        const int gw = (bid - ngla) * 8 + (threadIdx.x >> 6), ngw = (nb - ngla) * 8;
        for (int it = gw; it < 4096; it += ngw) na_naive(p, it);
    }
}

__device__ void phase4r(const Params& p, int bid, int nb) {
    const int lane = threadIdx.x & 63;
    const int gw = bid * 8 + (threadIdx.x >> 6), ngw = nb * 8;
    const float* OG = (const float*)p.out; bf16_t* GG = (bf16_t*)(p.ws + WS_GG);
    const float* gng = p.in[I_GNG];
    for (int row = gw; row < TL; row += ngw) {
        f32x4 v[4]; float s = 0.f;
#pragma unroll
        for (int j = 0; j < 4; ++j) { v[j] = *(const f32x4*)(OG + (size_t)row * 1024 + 16 * lane + 4 * j); s += v[j][0] * v[j][0] + v[j][1] * v[j][1] + v[j][2] * v[j][2] + v[j][3] * v[j][3]; }
        s += __shfl_xor(s, 1); s += __shfl_xor(s, 2); s += __shfl_xor(s, 4); s += __shfl_xor(s, 8);
        const float rstd = rsqrtf(s * (1.f / 256.f) + EPS);
        u32x4* gp = (u32x4*)(GG + (size_t)row * 1024 + 16 * lane);
        const u32x4 g0 = gp[0], g1 = gp[1];
        const unsigned gu[8] = {g0.x, g0.y, g0.z, g0.w, g1.x, g1.y, g1.z, g1.w};
        unsigned ou[8];
#pragma unroll
        for (int j = 0; j < 8; ++j) {
            const int c = (16 * lane + 2 * j) & 255;
            const float a0 = v[j >> 1][(2 * j) & 3] * rstd * gng[c] * siluf_(bflo(gu[j]));
            const float a1 = v[j >> 1][(2 * j + 1) & 3] * rstd * gng[c + 1] * siluf_(bfhi(gu[j]));
            ou[j] = pk2(a0, a1);
        }
        gp[0] = (u32x4){ou[0], ou[1], ou[2], ou[3]}; gp[1] = (u32x4){ou[4], ou[5], ou[6], ou[7]};
    }
}

struct SchedSq {
    const bf16_t* A0; const bf16_t* B0; int K0; const bf16_t* A1; const bf16_t* B1; int K1; int passes; int G, c;
    __device__ bool next(int i, Unit& u) const {
        const int L = (i / passes) * G + c; if (L >= 512) return false;
        const int s = i % passes;
        u.pm = L >> 2; u.pn = L & 3; u.aux = s;
        if (s == 0) { u.a = A0 + (size_t)u.pm * 256 * K0; u.b = B0 + (size_t)u.pn * 256 * K0; }
        else { u.a = A1 + (size_t)u.pm * 256 * K1; u.b = B1 + (size_t)u.pn * 256 * K1; }
        return true;
    }
};
struct EpiMerge {
    unsigned char* ws; int pass;
    __device__ __forceinline__ void operator()(const f32x4 (&acc)[2][2][4][2], const Unit& u, int wr, int wc, int fr, int fq) const {
        bf16_t* M8 = (bf16_t*)(ws + WS_M8); const bf16_t* M9 = (const bf16_t*)(ws + WS_M9);
        const int row0 = u.pm * 256 + wr * 64 + fr, col0 = u.pn * 256 + wc * 32 + 4 * fq;
#pragma unroll
        for (int ai = 0; ai < 2; ++ai)
#pragma unroll
            for (int m = 0; m < 4; ++m)
#pragma unroll
                for (int bj = 0; bj < 2; ++bj)
#pragma unroll
                    for (int n = 0; n < 2; ++n) {
                        const size_t off = (size_t)(row0 + ai * 128 + m * 16) * 1024 + col0 + bj * 128 + n * 16;
                        const f32x4 v = acc[ai][bj][m][n];
                        const u32x2 g = *(const u32x2*)(M8 + off);
                        u32x2 w;
                        if (pass == 0) {
                            w.x = pk2(v[0] * sigmoidf_(bflo(g.x)), v[1] * sigmoidf_(bfhi(g.x))); w.y = pk2(v[2] * sigmoidf_(bflo(g.y)), v[3] * sigmoidf_(bfhi(g.y)));
                        } else {
                            const u32x2 g9 = *(const u32x2*)(M9 + off);
                            w.x = pk2(bflo(g.x) + v[0] * sigmoidf_(bflo(g9.x)), bfhi(g.x) + v[1] * sigmoidf_(bfhi(g9.x)));
                            w.y = pk2(bflo(g.y) + v[2] * sigmoidf_(bflo(g9.y)), bfhi(g.y) + v[3] * sigmoidf_(bfhi(g9.y)));
                        }
                        *(u32x2*)(M8 + off) = w;
                    }
    }
};
struct EpiOut {
    const float* x; const float* MOD; float* HMID;
    __device__ __forceinline__ void operator()(const f32x4 (&acc)[2][2][4][2], const Unit& u, int wr, int wc, int fr, int fq) const {
        const int row0 = u.pm * 256 + wr * 64 + fr, col0 = u.pn * 256 + wc * 32 + 4 * fq;
        const int b = (u.pm * 256) >> 11;
#pragma unroll
        for (int bj = 0; bj < 2; ++bj)
#pragma unroll
            for (int n = 0; n < 2; ++n) {
                const int c = col0 + bj * 128 + n * 16;
                const f32x4 g1 = *(const f32x4*)(MOD + b * 6144 + 2048 + c);
#pragma unroll
                for (int ai = 0; ai < 2; ++ai)
#pragma unroll
                    for (int m = 0; m < 4; ++m) { const size_t off = (size_t)(row0 + ai * 128 + m * 16) * 1024 + c;
                        const f32x4 xv = *(const f32x4*)(x + off);
                        *(f32x4*)(HMID + off) = xv + g1 * acc[ai][bj][m][n]; }
            }
    }
};

__device__ void phase5(const Params& p, int bid, int nb) {
    const int lane = threadIdx.x & 63;
    const int gw = bid * 8 + (threadIdx.x >> 6), ngw = nb * 8;
    const float* MOD = (const float*)(p.ws + WS_MOD); const float* HMID = (const float*)(p.ws + WS_HMID);
    bf16_t* FL = (bf16_t*)(p.ws + WS_FL);
    const float* G = p.in[I_NFG]; const float* WGR = p.in[I_WGRP]; const float* WEX = p.in[I_WEXP];
    int* cnt = (int*)(p.ws + WS_CTL) + CW_CNT;
    int* ROUTE = (int*)(p.ws + WS_ROUTE);
    int* rowtok = (int*)(p.ws + WS_ROWTOK);
    for (int i = bid * NT + threadIdx.x; i < MAXROWS; i += nb * NT) rowtok[i] = -1;
    for (int row = gw; row < TL; row += ngw) {
        const int b = row >> 11;
        f32x4 v[4]; float s = 0.f;
#pragma unroll
        for (int j = 0; j < 4; ++j) { v[j] = *(const f32x4*)(HMID + (size_t)row * DM + 4 * lane + 256 * j); s += v[j][0] * v[j][0] + v[j][1] * v[j][1] + v[j][2] * v[j][2] + v[j][3] * v[j][3]; }
        const float rstd = rsqrtf(wave_sum(s) * (1.f / DM) + EPS);
        float lg[4] = {0.f, 0.f, 0.f, 0.f}; float le[32];
#pragma unroll
        for (int e = 0; e < 32; ++e) le[e] = 0.f;
#pragma unroll
        for (int j = 0; j < 4; ++j) {
            const int c = 4 * lane + 256 * j;
            const f32x4 g = *(const f32x4*)(G + c), sh = *(const f32x4*)(MOD + b * 6144 + 3072 + c), sc = *(const f32x4*)(MOD + b * 6144 + 4096 + c);
            f32x4 o;
#pragma unroll
            for (int i = 0; i < 4; ++i) o[i] = (v[j][i] * rstd) * g[i] * (1.f + sc[i]) + sh[i];
            u32x2 w; w.x = pk2(o[0], o[1]); w.y = pk2(o[2], o[3]);
            *(u32x2*)(FL + (size_t)row * DM + c) = w;
#pragma unroll
            for (int i = 0; i < 4; ++i) {
                const f32x4 wg = *(const f32x4*)(WGR + (size_t)(c + i) * 4);
                lg[0] += o[i] * wg[0]; lg[1] += o[i] * wg[1]; lg[2] += o[i] * wg[2]; lg[3] += o[i] * wg[3];
#pragma unroll
                for (int e4 = 0; e4 < 8; ++e4) { const f32x4 we = *(const f32x4*)(WEX + (size_t)(c + i) * 32 + 4 * e4);
                    le[4 * e4] += o[i] * we[0]; le[4 * e4 + 1] += o[i] * we[1]; le[4 * e4 + 2] += o[i] * we[2]; le[4 * e4 + 3] += o[i] * we[3]; }
            }
        }
#pragma unroll
        for (int e = 0; e < 4; ++e) lg[e] = wave_sum(lg[e]) + p.in[I_BGRP][e];
#pragma unroll
        for (int e = 0; e < 32; ++e) le[e] = wave_sum(le[e]) + p.in[I_BEXP][e];
        int grp = 0; float gm = lg[0];
#pragma unroll
        for (int e = 1; e < 4; ++e) if (lg[e] > gm) { gm = lg[e]; grp = e; }
        float gs = 0.f;
#pragma unroll
        for (int e = 0; e < 4; ++e) gs += __expf(lg[e] - gm);
        const float pgrp = 1.f / gs;
        float l8[8];
#pragma unroll
        for (int e = 0; e < 8; ++e) l8[e] = grp == 0 ? le[e] : (grp == 1 ? le[8 + e] : (grp == 2 ? le[16 + e] : le[24 + e]));
        int i1 = 0; float m1 = l8[0];
#pragma unroll
        for (int e = 1; e < 8; ++e) if (l8[e] > m1) { m1 = l8[e]; i1 = e; }
        int i2 = -1; float m2 = -3.0e38f;
#pragma unroll
        for (int e = 0; e < 8; ++e) if (e != i1 && l8[e] > m2) { m2 = l8[e]; i2 = e; }
        const float e2 = __expf(m2 - m1);
        const float w1 = pgrp / (1.f + e2), w2 = pgrp * e2 / (1.f + e2);
        if (lane == 0) {
            const int x1 = grp * 8 + i1, x2 = grp * 8 + i2;
            const int r1 = atomicAdd(&cnt[x1], 1), r2 = atomicAdd(&cnt[x2], 1);
            int* R = ROUTE + (size_t)row * 8;
            R[0] = x1; R[1] = x2; R[2] = r1; R[3] = r2; ((float*)R)[4] = w1; ((float*)R)[5] = w2;
        }
    }
}

__device__ void phase5b(const Params& p, float* lds, int bid, int nb) {
    const int lane = threadIdx.x & 63;
    const int gw = bid * 8 + (threadIdx.x >> 6), ngw = nb * 8;
    int* sstart = (int*)lds;
    if (threadIdx.x == 0) { const int* cnt = (const int*)(p.ws + WS_CTL) + CW_CNT; int a = 0; for (int e = 0; e < 32; ++e) { sstart[e] = a; a += ((cnt[e] + 255) >> 8) << 8; } sstart[32] = a; }
    __syncthreads();
    const int* ROUTE = (const int*)(p.ws + WS_ROUTE);
    int* rowtok = (int*)(p.ws + WS_ROWTOK); float* roww = (float*)(p.ws + WS_ROWW);
    const bf16_t* FL = (const bf16_t*)(p.ws + WS_FL); bf16_t* XG = (bf16_t*)(p.ws + WS_XG);
    for (int it = gw; it < TL * 2; it += ngw) {
        const int tok = it >> 1, k = it & 1;
        const int* R = ROUTE + (size_t)tok * 8;
        const int e = R[k], rk = R[2 + k]; const float w = ((const float*)R)[4 + k];
        const int pos = sstart[e] + rk;
        if (lane == 0) { rowtok[pos] = it; roww[pos] = w; }
        const u32x4* src = (const u32x4*)(FL + (size_t)tok * DM); u32x4* dst = (u32x4*)(XG + (size_t)pos * DM);
        dst[lane] = src[lane]; dst[lane + 64] = src[lane + 64];
    }
    const int* cnt = (const int*)(p.ws + WS_CTL) + CW_CNT;
    for (int e = 0; e < 32; ++e) {
        const int c = cnt[e], padn = (((c + 255) >> 8) << 8) - c;
        for (int r = gw; r < padn; r += ngw) { u32x4* dst = (u32x4*)(XG + (size_t)(sstart[e] + c + r) * DM); dst[lane] = (u32x4){0, 0, 0, 0}; dst[lane + 64] = (u32x4){0, 0, 0, 0}; }
    }
    __syncthreads();
}

struct SchedMoe {
    const bf16_t* A; const bf16_t* B; int K; size_t bexp; const int* tstart;
    int G, c;
    __device__ bool next(int i, Unit& u) const {
        const int L = i * G + c; const int ntile = tstart[32];
        if (L >= ntile * 4) return false;
        u.pm = L >> 2; u.pn = L & 3;
        int e = 0;
        for (int j = 1; j < 32; ++j) if (tstart[j] <= u.pm) e = j;
        u.aux = e;
        u.a = A + (size_t)u.pm * 256 * K; u.b = B + (size_t)e * bexp + (size_t)u.pn * 256 * K;
        return true;
    }
};
struct EpiGU {
    bf16_t* H;
    __device__ __forceinline__ void operator()(const f32x4 (&acc)[2][2][4][2], const Unit& u, int wr, int wc, int fr, int fq) const {
        const int row0 = u.pm * 256 + wr * 64 + fr, col0 = u.pn * 128 + wc * 32 + 4 * fq;
#pragma unroll
        for (int ai = 0; ai < 2; ++ai)
#pragma unroll
            for (int m = 0; m < 4; ++m)
#pragma unroll
                for (int n = 0; n < 2; ++n) {
                    const f32x4 g = acc[ai][0][m][n], up = acc[ai][1][m][n];
                    u32x2 w; w.x = pk2(siluf_(g[0]) * up[0], siluf_(g[1]) * up[1]); w.y = pk2(siluf_(g[2]) * up[2], siluf_(g[3]) * up[3]);
                    *(u32x2*)(H + (size_t)(row0 + ai * 128 + m * 16) * 512 + col0 + n * 16) = w;
                }
    }
};
struct EpiDown {
    bf16_t* YS; const int* rowtok; const float* roww;
    __device__ __forceinline__ void operator()(const f32x4 (&acc)[2][2][4][2], const Unit& u, int wr, int wc, int fr, int fq) const {
        const int row0 = u.pm * 256 + wr * 64 + fr, col0 = u.pn * 256 + wc * 32 + 4 * fq;
#pragma unroll
        for (int ai = 0; ai < 2; ++ai)
#pragma unroll
            for (int m = 0; m < 4; ++m) {
                const int row = row0 + ai * 128 + m * 16;
                const int ts = rowtok[row]; const float w = roww[row];
                if (ts >= 0) {
                    bf16_t* rp = YS + ((size_t)(ts & 1) * TL + (ts >> 1)) * 1024 + col0;
#pragma unroll
                    for (int bj = 0; bj < 2; ++bj)
#pragma unroll
                        for (int n = 0; n < 2; ++n) { const f32x4 v = acc[ai][bj][m][n] * w; u32x2 o; o.x = pk2(v[0], v[1]); o.y = pk2(v[2], v[3]); *(u32x2*)(rp + bj * 128 + n * 16) = o; }
                }
            }
    }
};
__device__ void moe_tiles(const Params& p, int* tstart) {
    if (threadIdx.x == 0) { const int* cnt = (const int*)(p.ws + WS_CTL) + CW_CNT; int a = 0; for (int e = 0; e < 32; ++e) { tstart[e] = a; a += (cnt[e] + 255) >> 8; } tstart[32] = a; }
    __syncthreads();
}

__device__ void phase7(const Params& p, int bid, int nb) {
    const int lane = threadIdx.x & 63;
    const int gw = bid * 8 + (threadIdx.x >> 6), ngw = nb * 8;
    const float* MOD = (const float*)(p.ws + WS_MOD); const float* HMID = (const float*)(p.ws + WS_HMID);
    const bf16_t* YS = (const bf16_t*)(p.ws + WS_YS);
    const float* G = p.in[I_FNG];
    for (int row = gw; row < TL; row += ngw) {
        const int b = row >> 11;
        f32x4 v[4]; float s = 0.f;
#pragma unroll
        for (int j = 0; j < 4; ++j) {
            const int c = 4 * lane + 256 * j;
            const f32x4 hm = *(const f32x4*)(HMID + (size_t)row * DM + c);
            const f32x4 g2 = *(const f32x4*)(MOD + b * 6144 + 5120 + c);
            const u32x2 y0 = *(const u32x2*)(YS + (size_t)row * DM + c), y1 = *(const u32x2*)(YS + ((size_t)TL + row) * DM + c);
            f32x4 y; y[0] = bflo(y0.x) + bflo(y1.x); y[1] = bfhi(y0.x) + bfhi(y1.x); y[2] = bflo(y0.y) + bflo(y1.y); y[3] = bfhi(y0.y) + bfhi(y1.y);
            v[j] = hm + g2 * y;
            s += v[j][0] * v[j][0] + v[j][1] * v[j][1] + v[j][2] * v[j][2] + v[j][3] * v[j][3];
        }
        const float rstd = rsqrtf(wave_sum(s) * (1.f / DM) + EPS);
#pragma unroll
        for (int j = 0; j < 4; ++j) { const int c = 4 * lane + 256 * j; const f32x4 g = *(const f32x4*)(G + c);
            *(f32x4*)(p.out + (size_t)row * DM + c) = (v[j] * rstd) * g; }
    }
}

template <int PH>
__device__ __forceinline__ void run_phase(const Params& p, unsigned char* lds, int bid, int nb) {
    if constexpr (PH == 0) phase0(p, (float*)lds, bid, nb);
    if constexpr (PH == 1) phase1(p, bid, nb);
    if constexpr (PH == 2) { SchedIn S{(const bf16_t*)p.out, (const bf16_t*)(p.ws + WS_WIN), nb, bid}; EpiIn E{p.ws}; gemm_simple(lds, 1024, S, E); }
    if constexpr (PH == 3) phase3(p, (float*)lds, bid, nb);
    if constexpr (PH == 4) phase4r(p, bid, nb);
    if constexpr (PH == 5) {
        SchedSq S{(const bf16_t*)(p.ws + WS_ONA), (const bf16_t*)(p.ws + WS_WNAO), 512, (const bf16_t*)(p.ws + WS_GG), (const bf16_t*)(p.ws + WS_WGLAO), 1024, 1, nb, bid};
        { EpiMerge E{p.ws, 0}; gemm_simple(lds, 512, S, E); }
        { SchedSq S1{(const bf16_t*)(p.ws + WS_GG), (const bf16_t*)(p.ws + WS_WGLAO), 1024, nullptr, nullptr, 0, 1, nb, bid}; EpiMerge E{p.ws, 1}; gemm_simple(lds, 1024, S1, E); }
    }
    if constexpr (PH == 6) { SchedSq S{(const bf16_t*)(p.ws + WS_M8), (const bf16_t*)(p.ws + WS_WOUT), 1024, nullptr, nullptr, 0, 1, nb, bid};
        EpiOut E{p.in[I_X], (const float*)(p.ws + WS_MOD), (float*)(p.ws + WS_HMID)}; gemm_simple(lds, 1024, S, E); }
    if constexpr (PH == 7) { phase5(p, bid, nb); prep_experts(p, (float*)lds, bid * 8 + (threadIdx.x >> 6), nb * 8); }
    if constexpr (PH == 8) phase5b(p, (float*)lds, bid, nb);
    if constexpr (PH == 9) { int* tstart = (int*)(lds + 2 * 256 * 72 * 2); moe_tiles(p, tstart);
        SchedMoe S{(const bf16_t*)(p.ws + WS_XG), (const bf16_t*)((unsigned char*)p.out + OUT_WGU), 1024, (size_t)1024 * 1024, tstart, nb, bid};
        EpiGU E{(bf16_t*)(p.ws + WS_H)}; gemm_simple(lds, 1024, S, E); }
    if constexpr (PH == 10) { int* tstart = (int*)(lds + 2 * 256 * 72 * 2); moe_tiles(p, tstart);
        SchedMoe S{(const bf16_t*)(p.ws + WS_H), (const bf16_t*)((unsigned char*)p.out + OUT_WD), 512, (size_t)1024 * 512, tstart, nb, bid};
        EpiDown E{(bf16_t*)(p.ws + WS_YS), (const int*)(p.ws + WS_ROWTOK), (const float*)(p.ws + WS_ROWW)}; gemm_simple(lds, 512, S, E); }
    if constexpr (PH == 11) phase7(p, bid, nb);
}
constexpr int LDS_BYTES = 2 * 256 * 72 * 2 + 256;

template <int PH>
__global__ void __launch_bounds__(NT, 2) k_phase(Params p) {
    extern __shared__ __attribute__((aligned(16))) unsigned char lds[];
    run_phase<PH>(p, lds, blockIdx.x, gridDim.x);
}

template <int PH> static void launch_phase(const Params& p, int grid, hipStream_t stream) {
    static bool attr = false;
    if (!attr) { (void)hipFuncSetAttribute((const void*)k_phase<PH>, hipFuncAttributeMaxDynamicSharedMemorySize, LDS_BYTES); attr = true; }
    hipLaunchKernelGGL(k_phase<PH>, dim3(grid), dim3(NT), LDS_BYTES, stream, p);
}

extern "C" void kernel_launch(void* const* d_in, const int* in_sizes, int n_in, void* d_out, int out_size, void* d_ws, size_t ws_size, hipStream_t stream) {
    if (n_in != 24 || ws_size < WS_END) { fprintf(stderr, "kernel_launch: unexpected n_in %d / ws %zu\n", n_in, ws_size); return; }
    Params p{};
    for (int i = 0; i < 24; ++i) p.in[i] = (const float*)d_in[i];
    p.out = (float*)d_out; p.ws = (unsigned char*)d_ws;
    const int G = 256;
    launch_phase<0>(p, G, stream); launch_phase<1>(p, G, stream); launch_phase<2>(p, G, stream); launch_phase<3>(p, G, stream);
    launch_phase<4>(p, G, stream); launch_phase<5>(p, G, stream); launch_phase<6>(p, G, stream); launch_phase<7>(p, G, stream);
    launch_phase<8>(p, G, stream); launch_phase<9>(p, G, stream); launch_phase<10>(p, G, stream); launch_phase<11>(p, G, stream);
}
```

```cpp
#include <hip/hip_runtime.h>
#include <hip/hip_cooperative_groups.h>
#include <cstdint>
#include <cstdio>
namespace cg = cooperative_groups;

#ifndef MEGA
#define MEGA 1
#endif
#define PROBE_DUP -1

typedef unsigned short bf16_t;
typedef short bf16x8 __attribute__((ext_vector_type(8)));
typedef float f32x4 __attribute__((ext_vector_type(4)));
typedef float f32x2 __attribute__((ext_vector_type(2)));
typedef unsigned u32x4 __attribute__((ext_vector_type(4)));
typedef unsigned u32x2 __attribute__((ext_vector_type(2)));

constexpr int NB = 16, SEQ = 2048, DM = 1024, CTX = 256, GW = 64;
constexpr int TL = NB * SEQ;
constexpr int TC = NB * CTX;
constexpr int TA = TL + TC;
constexpr int NEXP = 32, DEXP = 512;
constexpr int NT = 512;
constexpr float EPS = 1e-6f;
constexpr int ECAP = 32768;
constexpr int MAXROWS = 73728;

constexpr size_t MiB = 1u << 20;
constexpr size_t WS_CTL = 0;
constexpr size_t WS_BAR = 64 * 1024;
constexpr size_t WS_MOD = 1 * MiB;
constexpr size_t WS_ROPE = 1 * MiB + 512 * 1024;
constexpr size_t WS_ROUTE = 2 * MiB;
constexpr size_t WS_ROWTOK = 3 * MiB;
constexpr size_t WS_ROWW = 3 * MiB + 512 * 1024;
constexpr size_t WS_WIN = 4 * MiB;
constexpr size_t WS_WNAO = WS_WIN + (size_t)6912 * 1024 * 2;
constexpr size_t WS_WGLAO = WS_WNAO + 1 * MiB;
constexpr size_t WS_WOUT = WS_WGLAO + 2 * MiB;
constexpr size_t WS_ALR = WS_WOUT + 2 * MiB;
constexpr size_t WS_QN = 28 * MiB;
constexpr size_t WS_KN = 60 * MiB;
constexpr size_t WS_VN = 96 * MiB;
constexpr size_t WS_QG = 132 * MiB;
constexpr size_t WS_KG = 164 * MiB;
constexpr size_t WS_VG = 200 * MiB;
constexpr size_t WS_ONA = 272 * MiB;
constexpr size_t WS_GG = 304 * MiB;
constexpr size_t WS_M8 = 368 * MiB;
constexpr size_t WS_M9 = 432 * MiB;
constexpr size_t WS_ROWSS = 496 * MiB;
constexpr size_t WS_ERT = 156 * MiB;
constexpr size_t WS_ERW = 160 * MiB;
constexpr size_t WS_END = 504 * MiB;
constexpr size_t WS_HMID = 28 * MiB;
constexpr size_t WS_FL = 200 * MiB;
constexpr size_t WS_H = 432 * MiB;
constexpr size_t WS_XG = 304 * MiB;
constexpr size_t WS_YS = 304 * MiB;
static_assert(WS_ALR + (size_t)TA * 32 * 4 <= WS_QN, "ws map");
constexpr size_t OUT_WGU = 0;
constexpr size_t OUT_WD = 64 * MiB;

constexpr int CW_CNT = 0;

__device__ __forceinline__ unsigned pk2(float lo, float hi);
__device__ __forceinline__ unsigned f2bf(float f);
typedef __bf16 bf16x2_hw __attribute__((ext_vector_type(2)));
__device__ __forceinline__ unsigned pk2(float lo, float hi) { const f32x2 v = {lo, hi}; return __builtin_bit_cast(unsigned, __builtin_convertvector(v, bf16x2_hw)); }
__device__ __forceinline__ unsigned f2bf(float f) { return pk2(f, 0.f) & 0xffffu; }
__device__ __forceinline__ float bf2f(unsigned short h) { return __builtin_bit_cast(float, (unsigned)h << 16); }
__device__ __forceinline__ float bflo(unsigned u) { return __builtin_bit_cast(float, u << 16); }
__device__ __forceinline__ float bfhi(unsigned u) { return __builtin_bit_cast(float, u & 0xffff0000u); }
__device__ __forceinline__ float wave_sum(float v) {
#pragma unroll
    for (int o = 1; o < 64; o <<= 1) v += __shfl_xor(v, o);
    return v;
}
__device__ __forceinline__ float sigmoidf_(float x) { return 1.f / (1.f + __expf(-x)); }
__device__ __forceinline__ float siluf_(float x) { return x / (1.f + __expf(-x)); }

struct Params {
    const float* in[24];
    float* out;
    unsigned char* ws;
};
enum { I_X = 0, I_C, I_CTX, I_CCTX, I_WMOD, I_BMOD, I_NAG, I_NFG, I_WIN, I_WA2, I_BA2, I_GNG, I_RPB, I_WNAO, I_WGLAO, I_WOUT,
       I_WGRP, I_BGRP, I_WEXP, I_BEXP, I_WG, I_WU, I_WD, I_FNG };

__device__ void p0_mod(const Params& p, float* lds, int blk) {
    const int tid = threadIdx.x;
    float* sc = lds;
    for (int i = tid; i < 17 * 1024; i += NT) {
        const int r = i >> 10, k = i & 1023;
        const float v = r < 16 ? p.in[I_C][r * 1024 + k] : p.in[I_CCTX][k];
        sc[i] = siluf_(v);
    }
    __syncthreads();
    const int cg4 = tid & 7, kr = tid >> 3;
    const int n0 = blk * 32 + cg4 * 4;
    float acc[17][4];
#pragma unroll
    for (int r = 0; r < 17; ++r) { acc[r][0] = 0.f; acc[r][1] = 0.f; acc[r][2] = 0.f; acc[r][3] = 0.f; }
    const float* W = p.in[I_WMOD];
#pragma unroll 4
    for (int kb = 0; kb < 1024; kb += 64) {
        const int k = kb + kr;
        const f32x4 w = *(const f32x4*)(W + (size_t)k * 6144 + n0);
#pragma unroll
        for (int r = 0; r < 17; ++r) { const float s = sc[r * 1024 + k]; acc[r][0] += s * w[0]; acc[r][1] += s * w[1]; acc[r][2] += s * w[2]; acc[r][3] += s * w[3]; }
    }
#pragma unroll
    for (int r = 0; r < 17; ++r)
#pragma unroll
        for (int j = 0; j < 4; ++j) { float v = acc[r][j]; v += __shfl_xor(v, 8); v += __shfl_xor(v, 16); v += __shfl_xor(v, 32); acc[r][j] = v; }
    __syncthreads();
    float* red = lds;
    const int wave = tid >> 6, lane = tid & 63;
    if (lane < 8) {
#pragma unroll
        for (int r = 0; r < 17; ++r)
#pragma unroll
            for (int j = 0; j < 4; ++j) red[(wave * 8 + lane) * 68 + r * 4 + j] = acc[r][j];
    }
    __syncthreads();
    float* MOD = (float*)(p.ws + WS_MOD);
    for (int i = tid; i < 8 * 68; i += NT) {
        const int c = i / 68, q = i % 68, r = q >> 2, j = q & 3;
        float s = 0.f;
#pragma unroll
        for (int w = 0; w < 8; ++w) s += red[(w * 8 + c) * 68 + q];
        const int n = blk * 32 + c * 4 + j;
        MOD[r * 6144 + n] = s + p.in[I_BMOD][n];
    }
    __syncthreads();
}

template <class ColMap>
__device__ __forceinline__ void transpose_item(const float* W, int ld, bf16_t* WT, int K, int k0, int n0, float* scr, int lane, const ColMap& cm) {
    const int sc = cm(n0 + (lane & 31));
    float tv[32];
    const float* wp = W + (size_t)(k0 + (lane >> 5)) * ld + (sc >= 0 ? sc : 0);
#pragma unroll
    for (int i = 0; i < 32; ++i) tv[i] = wp[(size_t)(2 * i) * ld];
#pragma unroll
    for (int i = 0; i < 32; ++i) { const int kk = 2 * i + (lane >> 5); scr[kk * 33 + (lane & 31)] = sc >= 0 ? tv[i] : 0.f; }
    asm volatile("s_waitcnt lgkmcnt(0)" ::: "memory");
    __builtin_amdgcn_wave_barrier();
    const int c = lane & 7;
#pragma unroll
    for (int j = 0; j < 4; ++j) { const int n = (lane >> 3) + 8 * j; const float* s = scr + (8 * c) * 33 + n;
        u32x4 o; o.x = pk2(s[0 * 33], s[1 * 33]); o.y = pk2(s[2 * 33], s[3 * 33]); o.z = pk2(s[4 * 33], s[5 * 33]); o.w = pk2(s[6 * 33], s[7 * 33]);
        *(u32x4*)(WT + (size_t)(n0 + n) * K + k0 + 8 * c) = o; }
    asm volatile("s_waitcnt lgkmcnt(0)" ::: "memory");
    __builtin_amdgcn_wave_barrier();
}
__device__ __forceinline__ int rope_perm(int pp) { const int wc = pp >> 5, n = (pp >> 4) & 1, r = pp & 15; return 64 * (wc >> 1) + 32 * n + 16 * (wc & 1) + r; }
struct CmIn { __device__ int operator()(int n) const {
    if (n < 1536) return n;
    if (n < 2560) return (n & ~127) + rope_perm(n & 127);
    if (n < 4608) return n;
    if (n < 6656) return n + 32;
    if (n < 6688) return n - 6656 + 4608;
    return -1; } };
struct CmId { __device__ int operator()(int n) const { return n; } };
struct CmGU { int which; __device__ int operator()(int n) const { const int t = n >> 8, q = n & 255; return ((q >> 7) == which) ? (128 * t + (q & 127)) : -2; } };

__device__ void p0_prep_small(const Params& p, float* lds, int gw, int ngw) {
    const int lane = threadIdx.x & 63, wave = threadIdx.x >> 6;
    float* scr = lds + wave * (64 * 33);
    constexpr int I_IN = 16 * 216, I_NAO = 8 * 32, I_GLAO = 16 * 32, I_OUT = 16 * 32;
    for (int it = gw; it < I_IN + I_NAO + I_GLAO + I_OUT; it += ngw) {
        int r = it;
        if (r < I_IN) { transpose_item(p.in[I_WIN], 6688, (bf16_t*)(p.ws + WS_WIN), 1024, 64 * (r / 216), 32 * (r % 216), scr, lane, CmIn()); continue; } r -= I_IN;
        if (r < I_NAO) { transpose_item(p.in[I_WNAO], 1024, (bf16_t*)(p.ws + WS_WNAO), 512, 64 * (r / 32), 32 * (r % 32), scr, lane, CmId()); continue; } r -= I_NAO;
        if (r < I_GLAO) { transpose_item(p.in[I_WGLAO], 1024, (bf16_t*)(p.ws + WS_WGLAO), 1024, 64 * (r / 32), 32 * (r % 32), scr, lane, CmId()); continue; } r -= I_GLAO;
        transpose_item(p.in[I_WOUT], 1024, (bf16_t*)(p.ws + WS_WOUT), 1024, 64 * (r / 32), 32 * (r % 32), scr, lane, CmId());
    }
}
__device__ void prep_experts(const Params& p, float* lds, int gw, int ngw) {
    const int lane = threadIdx.x & 63, wave = threadIdx.x >> 6;
    float* scr = lds + wave * (64 * 33);
    bf16_t* WGU = (bf16_t*)((unsigned char*)p.out + OUT_WGU);
    bf16_t* WDt = (bf16_t*)((unsigned char*)p.out + OUT_WD);
    constexpr int PER_GU = 16 * 32, PER_D = 8 * 32;
    for (int it = gw; it < NEXP * (PER_GU + PER_D); it += ngw) {
        const int e = it / (PER_GU + PER_D); int r = it % (PER_GU + PER_D);
        if (r < PER_GU) {
            const int k0 = 64 * (r / 32), n0 = 32 * (r % 32);
            const int t = n0 >> 8, q = n0 & 255, which = q >> 7;
            const float* src = (which == 0 ? p.in[I_WG] : p.in[I_WU]) + (size_t)e * 1024 * 512;
            struct Cm { int base, n0; __device__ int operator()(int n) const { return base + (n - n0); } } cm{128 * t + (q & 127), n0};
            transpose_item(src, 512, WGU + (size_t)e * 1024 * 1024, 1024, k0, n0, scr, lane, cm);
        } else {
            r -= PER_GU;
            transpose_item(p.in[I_WD] + (size_t)e * 512 * 1024, 1024, WDt + (size_t)e * 1024 * 512, 512, 64 * (r / 32), 32 * (r % 32), scr, lane, CmId());
        }
    }
}

__device__ void phase0(const Params& p, float* lds, int bid, int nb) {
    const int tid = threadIdx.x;
    if (bid == 0) {
        for (int i = tid; i < 32 * 64; i += NT) ((int*)(p.ws + WS_CTL))[i] = 0;
        f32x2* RT = (f32x2*)(p.ws + WS_ROPE);
        for (int i = tid; i < 64 * 32; i += NT) {
            const int pos = i >> 5, j = i & 31;
            const float inv = exp2f(-(float)j * 0.41524101186092029f);
            const float ang = (float)pos * inv;
            double rev = (double)ang * 0.15915494309189535; rev -= floor(rev);
            const float fr = (float)rev;
            RT[i] = (f32x2){__builtin_amdgcn_cosf(fr), __builtin_amdgcn_sinf(fr)};
        }
    }
    for (int b = bid; b < 192; b += nb) p0_mod(p, lds, b);
    p0_prep_small(p, lds, bid * 8 + (tid >> 6), nb * 8);
}

__device__ void phase1(const Params& p, int bid, int nb) {
    const int lane = threadIdx.x & 63;
    const int gw = bid * 8 + (threadIdx.x >> 6), ngw = nb * 8;
    const float* MOD = (const float*)(p.ws + WS_MOD);
    bf16_t* A1 = (bf16_t*)p.out;
    const float* G = p.in[I_NAG];
    for (int row = gw; row < TA; row += ngw) {
        const float* xr; int mr;
        if (row < TL) { xr = p.in[I_X] + (size_t)row * DM; mr = row >> 11; } else { xr = p.in[I_CTX] + (size_t)(row - TL) * DM; mr = 16; }
        f32x4 v[4]; float s = 0.f;
#pragma unroll
        for (int j = 0; j < 4; ++j) { v[j] = *(const f32x4*)(xr + 4 * lane + 256 * j); s += v[j][0] * v[j][0] + v[j][1] * v[j][1] + v[j][2] * v[j][2] + v[j][3] * v[j][3]; }
        const float rstd = rsqrtf(wave_sum(s) * (1.f / DM) + EPS);
#pragma unroll
        for (int j = 0; j < 4; ++j) {
            const int c = 4 * lane + 256 * j;
            const f32x4 g = *(const f32x4*)(G + c), sh = *(const f32x4*)(MOD + mr * 6144 + c), sc = *(const f32x4*)(MOD + mr * 6144 + 1024 + c);
            f32x4 o;
#pragma unroll
            for (int i = 0; i < 4; ++i) o[i] = (v[j][i] * rstd) * g[i] * (1.f + sc[i]) + sh[i];
            u32x2 w; w.x = pk2(o[0], o[1]); w.y = pk2(o[2], o[3]);
            *(u32x2*)(A1 + (size_t)row * DM + c) = w;
        }
    }
}


struct Unit { int pm, pn; const bf16_t* a; const bf16_t* b; int aux; int rbase, nvalid; };
namespace pg8 {
#define PG8_LAS __attribute__((address_space(3)))
constexpr int BM = 256, BK = 64, HALF = 128, HTB = HALF * BK * 2  , STAGE_BYTES = 8 * HTB;
__host__ __device__ __forceinline__ int lds_byte(int r, int c) { const int st = (r >> 4) * 2 + (c >> 5), rr = r & 15, cc = c & 31, ob = rr * 64 + cc * 2; return st * 1024 + (ob ^ (((ob >> 9) & 1) << 5)); }
__host__ __device__ __forceinline__ void stage_rc(int b, int& R, int& C) { const int st = b / 1024, sb = b % 1024, swz = sb ^ (((sb >> 9) & 1) << 5); R = (st >> 1) * 16 + swz / 64; C = (st & 1) * 32 + (swz % 64) / 2; }
__host__ __device__ __forceinline__ int perm32(int rho) { const int n = rho >> 4, i = rho & 15; return 8 * (i >> 2) + 4 * n + (i & 3); }
struct NoGather { const int* rowtok; int zero_row; };
template <class Epi, class Sched, bool ALIGN_EPI = false, bool SP2 = false, bool GATHER = false>
__device__ __forceinline__ void gemm_phase(PG8_LAS unsigned char* lds, const int Kdim, const Sched& S, const Epi& E, const NoGather G = NoGather{nullptr, 0}) {
    int tid_ = threadIdx.x; asm volatile("" : "+v"(tid_));
    const int tid = tid_, wid = __builtin_amdgcn_readfirstlane(tid >> 6), lane = tid & 63, wr = wid >> 2, wc = wid & 3, fr = lane & 15, fq = lane >> 4;
    const int K = Kdim, nt = K / BK;
    static_assert(!GATHER || SP2, "gathered A staging is wired into the two-super-phase loop only");
    unsigned voffA[2], voffB[2]; int gR[2], gC[2];
#pragma unroll
    for (int i = 0; i < 2; ++i) { int R, C; stage_rc(tid * 16 + i * 8192, R, C); const int Rb = Epi::PERM ? ((R & ~31) + perm32(R & 31)) : R;
        voffA[i] = (unsigned)(R * K + C) * 2u; voffB[i] = (unsigned)(Rb * K + C) * 2u; gR[i] = R; gC[i] = C; }
    const size_t kstep = (size_t)(BK * 2);
    const size_t hstep = (size_t)HALF * K * 2;
    const size_t tstep = 2 * hstep;
    const unsigned ldsw = (unsigned)wid * 1024u;
    const int aoff = lds_byte(wr * 64 + fr, fq * 8), boff = lds_byte(wc * 32 + fr, fq * 8);
#define PG8_SA(b, h) (((b) * 2 + (h)) * HTB)
#define PG8_SB(b, h) ((4 + (b) * 2 + (h)) * HTB)
#define PG8_STAGE(bufoff, gbase, voff) do { _Pragma("unroll") for (int _i = 0; _i < 2; ++_i) \
        __builtin_amdgcn_global_load_lds((const unsigned*)((const char*)(gbase) + (voff)[_i]), (PG8_LAS unsigned*)(lds + (bufoff) + ldsw + _i * 8192), 16, 0, 0); } while (0)
#define PG8_STAGE_A(bufoff, kbase, half, usenext) do { if constexpr (GATHER) { const bool un_ = (usenext); \
        const unsigned vs_[2] = {un_ ? aoffN[half][0] : aoffC[half][0], un_ ? aoffN[half][1] : aoffC[half][1]}; PG8_STAGE(bufoff, kbase, vs_); } \
    else { PG8_STAGE(bufoff, (kbase) + (half) * hstep, voffA); } } while (0)
#define PG8_GOFF(u_, o_) do { _Pragma("unroll") for (int h_ = 0; h_ < 2; ++h_) _Pragma("unroll") for (int i_ = 0; i_ < 2; ++i_) { \
        const int rl_ = 128 * h_ + gR[i_]; const int tk_ = rl_ < (u_).nvalid ? (G.rowtok[(u_).rbase + rl_] >> 1) : G.zero_row; \
        o_[h_][i_] = (unsigned)(tk_ * K + gC[i_]) * 2u; } } while (0)
#define PG8_LDA(dst, b, h) do { _Pragma("unroll") for (int m = 0; m < 4; ++m) _Pragma("unroll") for (int k = 0; k < 2; ++k) dst[m][k] = *(const PG8_LAS bf16x8*)(lds + PG8_SA(b, h) + aoff + m * 2048 + k * 1024); } while (0)
#define PG8_LDB(dst, b, h) do { _Pragma("unroll") for (int n = 0; n < 2; ++n) _Pragma("unroll") for (int k = 0; k < 2; ++k) dst[n][k] = *(const PG8_LAS bf16x8*)(lds + PG8_SB(b, h) + boff + n * 2048 + k * 1024); } while (0)
#define PG8_MMA(ai, bj, At, Bt) do { __builtin_amdgcn_s_setprio(1); _Pragma("unroll") for (int m = 0; m < 4; ++m) _Pragma("unroll") for (int n = 0; n < 2; ++n) _Pragma("unroll") for (int k = 0; k < 2; ++k) \
        acc[ai][bj][m][n] = __builtin_amdgcn_mfma_f32_16x16x32_bf16(Bt[n][k], At[m][k], acc[ai][bj][m][n], 0, 0, 0); __builtin_amdgcn_s_setprio(0); } while (0)
#define PG8_WAIT_V(n) asm volatile("s_waitcnt vmcnt(" #n ")" ::: "memory")
#define PG8_WAIT_L(n) asm volatile("s_waitcnt lgkmcnt(" #n ")" ::: "memory")
#define PG8_BAR __builtin_amdgcn_s_barrier()
#define PG8_SCHED __builtin_amdgcn_sched_barrier(0)
    Unit cur, nxt; int ui = 0;
    if (!S.next(0, cur)) return;
    f32x4 acc[2][2][4][2];
#pragma unroll
    for (int a = 0; a < 2; ++a)
#pragma unroll
        for (int b = 0; b < 2; ++b)
#pragma unroll
            for (int m = 0; m < 4; ++m)
#pragma unroll
                for (int n = 0; n < 2; ++n) acc[a][b][m][n] = (f32x4){0.f, 0.f, 0.f, 0.f};
    bf16x8 At[4][2], B0[2][2], B1[2][2];
    const char* cA = (const char*)cur.a; const char* cB = (const char*)cur.b;
    unsigned aoffC[2][2] = {{0u, 0u}, {0u, 0u}}, aoffN[2][2] = {{0u, 0u}, {0u, 0u}};
    if constexpr (GATHER) {
        PG8_GOFF(cur, aoffC); { Unit n1; if (S.next(1, n1)) PG8_GOFF(n1, aoffN); }
        asm volatile("s_waitcnt vmcnt(0)" ::: "memory");
    }
    S.a_ready(cur);
    if constexpr (SP2) {
        PG8_STAGE(PG8_SB(0, 0), cB, voffB); PG8_STAGE(PG8_SB(0, 1), cB + hstep, voffB); PG8_STAGE_A(PG8_SA(0, 0), cA, 0, false); PG8_STAGE_A(PG8_SA(0, 1), cA, 1, false);
        if (wr == 1) PG8_BAR;
        PG8_WAIT_V(2); PG8_BAR;
        PG8_STAGE(PG8_SB(1, 0), cB + kstep, voffB); PG8_STAGE_A(PG8_SA(1, 0), cA + kstep, 0, false); PG8_STAGE(PG8_SB(1, 1), cB + hstep + kstep, voffB);
        PG8_WAIT_V(6); PG8_BAR;
    } else {
        PG8_STAGE(PG8_SB(0, 0), cB, voffB); PG8_STAGE(PG8_SA(0, 0), cA, voffA); PG8_STAGE(PG8_SB(0, 1), cB + hstep, voffB); PG8_STAGE(PG8_SA(0, 1), cA + hstep, voffA);
        if (wr == 1) PG8_BAR;
        PG8_WAIT_V(4); PG8_BAR;
        PG8_STAGE(PG8_SB(1, 0), cB + kstep, voffB); PG8_STAGE(PG8_SA(1, 0), cA + kstep, voffA); PG8_STAGE(PG8_SB(1, 1), cB + hstep + kstep, voffB);
        PG8_WAIT_V(6); PG8_BAR;
    }
    for (;;) {
        const bool has_next = S.next(ui + 1, nxt);
        const char* nA = has_next ? (const char*)nxt.a : cA; const char* nB = has_next ? (const char*)nxt.b : cB;
        for (int t = 0; t < nt; t += 2) {
            const bool last = (t == nt - 2);
            const char* a1 = cA + (size_t)(t + 1) * kstep;
            const char* a2 = last ? nA : cA + (size_t)(t + 2) * kstep; const char* b2 = last ? nB : cB + (size_t)(t + 2) * kstep;
            const char* a3 = a2 + kstep; const char* b3 = b2 + kstep;
            if (last && has_next) S.a_ready(nxt);
            if constexpr (SP2) {
            PG8_LDB(B0, 0, 0); PG8_LDB(B1, 0, 1); PG8_SCHED; PG8_LDA(At, 0, 0); PG8_STAGE_A(PG8_SA(1, 1), a1, 1, false);
            PG8_WAIT_V(8); PG8_WAIT_L(0); PG8_BAR; PG8_MMA(0, 0, At, B0); PG8_MMA(0, 1, At, B1); PG8_BAR; PG8_SCHED;
            PG8_LDA(At, 0, 1); PG8_STAGE(PG8_SB(0, 0), b2, voffB); PG8_STAGE(PG8_SB(0, 1), b2 + hstep, voffB); PG8_STAGE_A(PG8_SA(0, 0), a2, 0, last && has_next);
            PG8_WAIT_V(8); PG8_WAIT_L(0); PG8_BAR; PG8_MMA(1, 0, At, B0); PG8_MMA(1, 1, At, B1); PG8_BAR; PG8_SCHED;
            PG8_LDB(B0, 1, 0); PG8_LDB(B1, 1, 1); PG8_SCHED; PG8_LDA(At, 1, 0); PG8_STAGE_A(PG8_SA(0, 1), a2, 1, last && has_next);
            PG8_WAIT_V(8); PG8_WAIT_L(0); PG8_BAR; PG8_MMA(0, 0, At, B0); PG8_MMA(0, 1, At, B1); PG8_BAR; PG8_SCHED;
            PG8_LDA(At, 1, 1); PG8_STAGE(PG8_SB(1, 0), b3, voffB); PG8_STAGE(PG8_SB(1, 1), b3 + hstep, voffB); PG8_STAGE_A(PG8_SA(1, 0), a3, 0, last && has_next);
            PG8_WAIT_V(8); PG8_WAIT_L(0); PG8_BAR; PG8_MMA(1, 0, At, B0); PG8_MMA(1, 1, At, B1); PG8_BAR; PG8_SCHED;
            } else {
            PG8_LDB(B0, 0, 0); PG8_SCHED; PG8_LDA(At, 0, 0); PG8_STAGE(PG8_SA(1, 1), a1 + hstep, voffA);
            PG8_WAIT_L(8); PG8_BAR; PG8_WAIT_L(0); PG8_MMA(0, 0, At, B0); PG8_BAR; PG8_SCHED;
            PG8_LDB(B1, 0, 1); PG8_STAGE(PG8_SB(0, 0), b2, voffB);
            PG8_BAR; PG8_WAIT_L(0); PG8_MMA(0, 1, At, B1); PG8_BAR;
            PG8_LDA(At, 0, 1); PG8_STAGE(PG8_SA(0, 0), a2, voffA);
            PG8_BAR; PG8_WAIT_L(0); PG8_MMA(1, 0, At, B0); PG8_BAR; PG8_SCHED;
            PG8_STAGE(PG8_SB(0, 1), b2 + hstep, voffB);
            PG8_WAIT_V(6); PG8_BAR; PG8_MMA(1, 1, At, B1); PG8_BAR;
            PG8_LDB(B0, 1, 0); PG8_SCHED; PG8_LDA(At, 1, 0); PG8_STAGE(PG8_SA(0, 1), a2 + hstep, voffA);
            PG8_WAIT_L(8); PG8_BAR; PG8_WAIT_L(0); PG8_MMA(0, 0, At, B0); PG8_BAR; PG8_SCHED;
            PG8_LDB(B1, 1, 1); PG8_STAGE(PG8_SB(1, 0), b3, voffB);
            PG8_BAR; PG8_WAIT_L(0); PG8_MMA(0, 1, At, B1); PG8_BAR;
            PG8_LDA(At, 1, 1); PG8_STAGE(PG8_SA(1, 0), a3, voffA);
            PG8_BAR; PG8_WAIT_L(0); PG8_MMA(1, 0, At, B0); PG8_BAR; PG8_SCHED;
            PG8_STAGE(PG8_SB(1, 1), b3 + hstep, voffB);
            PG8_WAIT_V(6); PG8_BAR; PG8_MMA(1, 1, At, B1); PG8_BAR;
            }
        }
        if constexpr (ALIGN_EPI) { if (wr == 0) PG8_BAR; }
        if constexpr (!Epi::AFTER_DRAIN) { E(acc, cur, wr, wc, fr, fq); S.done(cur); }
        if (!has_next) break;
#pragma unroll
        for (int a = 0; a < 2; ++a)
#pragma unroll
            for (int b = 0; b < 2; ++b)
#pragma unroll
                for (int m = 0; m < 4; ++m)
#pragma unroll
                    for (int n = 0; n < 2; ++n) acc[a][b][m][n] = (f32x4){0.f, 0.f, 0.f, 0.f};
        cur = nxt; cA = nA; cB = nB; ++ui;
        if constexpr (GATHER) {
#pragma unroll
            for (int h_ = 0; h_ < 2; ++h_) { aoffC[h_][0] = aoffN[h_][0]; aoffC[h_][1] = aoffN[h_][1]; }
            { Unit n2; if (S.next(ui + 1, n2)) PG8_GOFF(n2, aoffN); }
            asm volatile("s_waitcnt vmcnt(0)" ::: "memory");
        }
        if constexpr (ALIGN_EPI) { if (wr == 1) PG8_BAR; }
    }
    PG8_WAIT_V(0);
    if constexpr (!ALIGN_EPI) { if (wr == 0) PG8_BAR; }
    PG8_BAR;
    if constexpr (Epi::AFTER_DRAIN) { E.fused(acc, cur, wr, wc, fr, fq, lds, wid, lane); S.done(cur); }
#undef PG8_SA
#undef PG8_SB
#undef PG8_STAGE
#undef PG8_LDA
#undef PG8_STAGE_A
#undef PG8_GOFF
#undef PG8_LDB
#undef PG8_MMA
#undef PG8_WAIT_V
#undef PG8_WAIT_L
#undef PG8_BAR
#undef PG8_SCHED
}

}

struct SchedIn {
    __device__ __forceinline__ void a_ready(const Unit&) const {}
    __device__ __forceinline__ void done(const Unit&) const {}
    const bf16_t* A; const bf16_t* Bt; int G, c;
    __device__ bool next(int i, Unit& u) const {
        const int L = i * G + c;
        constexpr int NLAT = 128 * 27, NCTX = 16 * 11;
        if (L >= NLAT + NCTX) return false;
        if (L < NLAT) {
            const int w = (L & 7) * (NLAT / 8) + (L >> 3), gid = w / 216, rem = w % 216;
            u.pm = gid * 8 + (rem & 7); u.pn = rem >> 3; }
        else { const int q = L - NLAT; const int j = q % 11; u.pm = 128 + q / 11; u.pn = j < 4 ? 2 + j : (j < 10 ? 8 + (j - 4) : 26); }
        u.a = A + (size_t)u.pm * 256 * 1024; u.b = Bt + (size_t)u.pn * 256 * 1024; u.aux = 0; u.rbase = 0; u.nvalid = 0;
        return true;
    }
};
struct EpiIn {
    static constexpr bool PERM = false, AFTER_DRAIN = false;
    unsigned char* ws_;
    __device__ __forceinline__ void operator()(const f32x4 (&acc)[2][2][4][2], const Unit& u, int wr, int wc, int fr, int fq) const {
        unsigned zoff = 0; asm volatile("" : "+s"(zoff)); unsigned char* ws = ws_ + zoff;
        const int pn = u.pn;
        const int row0 = u.pm * 256 + wr * 64 + fr;
        if (pn == 26) {
            float* ALR = (float*)(ws + WS_ALR);
            if (wc == 0) {
#pragma unroll
                for (int ai = 0; ai < 2; ++ai)
#pragma unroll
                    for (int m = 0; m < 4; ++m) { const int row = row0 + ai * 128 + m * 16;
#pragma unroll
                        for (int n = 0; n < 2; ++n) *(f32x4*)(ALR + (size_t)row * 32 + 16 * n + 4 * fq) = acc[ai][0][m][n]; }
            }
            return;
        }
        if (pn >= 6 && pn < 10) {
            const bool isq = pn < 8;
            bf16_t* dst = (bf16_t*)(ws + (isq ? WS_QG : WS_KG));
            const float scale = isq ? 0.08838834764831845f : 1.0f;
            const f32x2* RT = (const f32x2*)(ws + WS_ROPE);
            const int half = wc >> 1, j0 = 16 * (wc & 1) + 4 * fq;
#pragma unroll
            for (int ai = 0; ai < 2; ++ai)
#pragma unroll
                for (int m = 0; m < 4; ++m) { const int row = row0 + ai * 128 + m * 16;
                    const bool lat = row < TL; const int t = row & 2047; const int pos = lat ? (half == 0 ? (t >> 6) : (t & 63)) : 0;
                    float cs[4], sn[4];
                    { const f32x4 va = *(const f32x4*)(RT + pos * 32 + j0), vb = *(const f32x4*)(RT + pos * 32 + j0 + 2);
                      cs[0] = va[0]; sn[0] = va[1]; cs[1] = va[2]; sn[1] = va[3]; cs[2] = vb[0]; sn[2] = vb[1]; cs[3] = vb[2]; sn[3] = vb[3]; }
#pragma unroll
                    for (int bj = 0; bj < 2; ++bj) {
                        const int head = (pn & 1) * 2 + bj;
                        const f32x4 x1 = acc[ai][bj][m][0] * scale, x2 = acc[ai][bj][m][1] * scale;
                        float o1[4], o2[4];
#pragma unroll
                        for (int i = 0; i < 4; ++i) { o1[i] = x1[i] * cs[i] - x2[i] * sn[i]; o2[i] = x1[i] * sn[i] + x2[i] * cs[i]; }
                        bf16_t* rp = dst + (size_t)row * 512 + head * 128 + 64 * half + j0;
                        u32x2 w1, w2; w1.x = pk2(o1[0], o1[1]); w1.y = pk2(o1[2], o1[3]); w2.x = pk2(o2[0], o2[1]); w2.y = pk2(o2[2], o2[3]);
                        *(u32x2*)rp = w1; *(u32x2*)(rp + 32) = w2;
                    }
                    asm volatile("" ::: "memory"); }
            return;
        }
        if (pn == 4 || pn == 5) {
            bf16_t* VT = (bf16_t*)(ws + WS_VN);
#pragma unroll
            for (int ai = 0; ai < 2; ++ai)
#pragma unroll
                for (int m = 0; m < 4; ++m) { const int row = row0 + ai * 128 + m * 16;
                    size_t base; int ldt;
                    if (row < TL) { base = (size_t)(row >> 11) * 512 * 2048 + (row & 2047); ldt = 2048; }
                    else { const int rc = row - TL; base = (size_t)32 * MiB / 2 + (size_t)(rc >> 8) * 512 * 256 + (rc & 255); ldt = 256; }
#pragma unroll
                    for (int bj = 0; bj < 2; ++bj)
#pragma unroll
                        for (int n = 0; n < 2; ++n) { const int c = (pn - 4) * 256 + bj * 128 + wc * 32 + n * 16 + 4 * fq;
#pragma unroll
                            for (int i = 0; i < 4; ++i) VT[base + (size_t)(c + i) * ldt] = (bf16_t)f2bf(acc[ai][bj][m][n][i]); }
                    asm volatile("" ::: "memory"); }
            return;
        }
        bf16_t* dst; int ld, cbase; float scale = 1.f;
        if (pn < 2) { dst = (bf16_t*)(ws + WS_QN); ld = 512; cbase = pn * 256; scale = 0.125f; }
        else if (pn < 4) { dst = (bf16_t*)(ws + WS_KN); ld = 512; cbase = (pn - 2) * 256; }
        else if (pn < 14) { dst = (bf16_t*)(ws + WS_VG); ld = 1024; cbase = (pn - 10) * 256; }
        else if (pn < 18) { dst = (bf16_t*)(ws + WS_GG); ld = 1024; cbase = (pn - 14) * 256; }
        else if (pn < 22) { dst = (bf16_t*)(ws + WS_M8); ld = 1024; cbase = (pn - 18) * 256; }
        else { dst = (bf16_t*)(ws + WS_M9); ld = 1024; cbase = (pn - 22) * 256; }
#pragma unroll
        for (int ai = 0; ai < 2; ++ai)
#pragma unroll
            for (int m = 0; m < 4; ++m) { bf16_t* rp = dst + (size_t)(row0 + ai * 128 + m * 16) * ld + cbase + wc * 32 + 4 * fq;
#pragma unroll
                for (int bj = 0; bj < 2; ++bj)
#pragma unroll
                    for (int n = 0; n < 2; ++n) { const f32x4 v = acc[ai][bj][m][n] * scale; u32x2 w; w.x = pk2(v[0], v[1]); w.y = pk2(v[2], v[3]);
                        *(u32x2*)(rp + bj * 128 + n * 16) = w; } }
    }
};

constexpr int NL_K = 0;
constexpr int NL_VT = 36864;
constexpr int NL_RPB = 70656;
__device__ void na_item(const Params& p, unsigned char* ldsg, int b, int r, int j, int h) {
    const int lane = threadIdx.x & 63, l15 = lane & 15, q4 = lane >> 4;
    unsigned lzo = 0; asm volatile("" : "+v"(lzo));
    const unsigned char __attribute__((address_space(3)))* lds = (const unsigned char __attribute__((address_space(3)))*)ldsg + lzo;
    b = __builtin_amdgcn_readfirstlane(b); r = __builtin_amdgcn_readfirstlane(r); j = __builtin_amdgcn_readfirstlane(j); h = __builtin_amdgcn_readfirstlane(h);
    const bf16_t* QN = (const bf16_t*)(p.ws + WS_QN); const bf16_t* KN = (const bf16_t*)(p.ws + WS_KN);
    const bf16_t* VT = (const bf16_t*)(p.ws + WS_VN);
    const int rs = min(max(r - 4, 0), 24), kc0 = min(max(16 * j - 8, 0), 32);
    const int qc = 16 * j + l15, cs = min(max(qc - 8, 0), 48);
    const int qtok = b * SEQ + r * GW + qc;
    bf16x8 qf[2];
    qf[0] = *(const bf16x8*)(QN + (size_t)qtok * 512 + h * 64 + 8 * q4);
    qf[1] = *(const bf16x8*)(QN + (size_t)qtok * 512 + h * 64 + 32 + 8 * q4);
    const float __attribute__((address_space(3)))* rp = (const float __attribute__((address_space(3)))*)(lds + NL_RPB);
    const int kid = 8 * (l15 >> 2) + (l15 & 3);
    const auto krs = __builtin_amdgcn_make_buffer_rsrc((void*)KN, 0, TA * 512 * 2, 0x00020000);
    const auto vrs = __builtin_amdgcn_make_buffer_rsrc((void*)VT, 0, TA * 512 * 2, 0x00020000);
    const unsigned kwin = (unsigned)((b * SEQ + rs * GW + kc0) * 512 + h * 64) * 2u;
    const unsigned klane = (unsigned)(kid * 512 + 8 * q4) * 2u;
    const unsigned vth = (unsigned)(((b * 8 + h) * 64) * 2048 + rs * GW + kc0) * 2u;
    const unsigned vlw = (unsigned)(l15 * 2048 + 8 * q4) * 2u;
    bf16x8 fb[2][8];
    f32x4 sc[16];
    f32x4 o[4];
#pragma unroll
    for (int dt = 0; dt < 4; ++dt) o[dt] = (f32x4){0.f, 0.f, 0.f, 0.f};
#define NA_LOAD(n_) do { constexpr int n = (n_); constexpr int bq = n & 3; constexpr bool isv = (n & 4) != 0, isc = n >= 8; \
        if (!isv) { _Pragma("unroll") for (int u = 0; u < 4; ++u) { const int ti = bq * 4 + u, g = ti >> 1, T = ti & 1; \
            if (isc) { fb[n & 1][2 * u] = *(const __attribute__((address_space(3))) bf16x8*)(lds + NL_K + (32 * g + 4 * T + kid) * 144 + q4 * 16); \
                       fb[n & 1][2 * u + 1] = *(const __attribute__((address_space(3))) bf16x8*)(lds + NL_K + (32 * g + 4 * T + kid) * 144 + q4 * 16 + 64); } \
            else { const unsigned so = kwin + (unsigned)(g * GW + 4 * T) * 1024u; \
                fb[n & 1][2 * u] = __builtin_bit_cast(bf16x8, __builtin_amdgcn_raw_buffer_load_b128(krs, klane, so, 0)); \
                fb[n & 1][2 * u + 1] = __builtin_bit_cast(bf16x8, __builtin_amdgcn_raw_buffer_load_b128(krs, klane, so + 64u, 0)); } } } \
        else { _Pragma("unroll") for (int u = 0; u < 2; ++u) { const int ks = bq * 2 + u; _Pragma("unroll") for (int dt = 0; dt < 4; ++dt) \
            { if (isc) fb[n & 1][4 * u + dt] = *(const __attribute__((address_space(3))) bf16x8*)(lds + NL_VT + (16 * dt + l15) * 528 + (32 * ks + 8 * q4) * 2); \
              else fb[n & 1][4 * u + dt] = __builtin_bit_cast(bf16x8, __builtin_amdgcn_raw_buffer_load_b128(vrs, vlw, vth + (unsigned)((16 * dt) * 2048 + ks * GW) * 2u, 0)); } } } } while (0)
#define NA_QK(n_) do { constexpr int n = (n_); constexpr int bq = n & 3; constexpr bool isc = n >= 8; \
        _Pragma("unroll") for (int u = 0; u < 4; ++u) { const int ti = bq * 4 + u; \
            f32x4 acc = (f32x4){0.f, 0.f, 0.f, 0.f}; \
            acc = __builtin_amdgcn_mfma_f32_16x16x32_bf16(fb[n & 1][2 * u], qf[0], acc, 0, 0, 0); \
            acc = __builtin_amdgcn_mfma_f32_16x16x32_bf16(fb[n & 1][2 * u + 1], qf[1], acc, 0, 0, 0); \
            if (!isc) { const int i = ti >> 1, T = ti & 1, ri = rs + i - r + 7; \
                _Pragma("unroll") for (int e = 0; e < 4; ++e) { const int kcol = kc0 + 8 * q4 + 4 * T + e; const bool valid = kcol >= cs && kcol < cs + 16; \
                    const int ci = min(max(kcol - qc + 15, 0), 30); acc[e] = valid ? acc[e] + rp[ri * 31 + ci] : -1e30f; } } \
            sc[ti] = acc; } } while (0)
#define NA_PV(n_) do { constexpr int n = (n_); constexpr int bq = n & 3; \
        _Pragma("unroll") for (int u = 0; u < 2; ++u) { const int ks = bq * 2 + u; \
            u32x4 bw; bw.x = pk2(sc[2 * ks][0], sc[2 * ks][1]); bw.y = pk2(sc[2 * ks][2], sc[2 * ks][3]); bw.z = pk2(sc[2 * ks + 1][0], sc[2 * ks + 1][1]); bw.w = pk2(sc[2 * ks + 1][2], sc[2 * ks + 1][3]); \
            const bf16x8 B = __builtin_bit_cast(bf16x8, bw); \
            _Pragma("unroll") for (int dt = 0; dt < 4; ++dt) o[dt] = __builtin_amdgcn_mfma_f32_16x16x32_bf16(fb[n & 1][4 * u + dt], B, o[dt], 0, 0, 0); } } while (0)
    NA_LOAD(0);
    NA_LOAD(1); NA_QK(0);
    NA_LOAD(2); NA_QK(1);
    NA_LOAD(3); NA_QK(2);
    NA_LOAD(4); NA_QK(3);
    float m1 = -1e30f;
#pragma unroll
    for (int ti = 0; ti < 16; ++ti) m1 = fmaxf(fmaxf(fmaxf(m1, sc[ti][0]), fmaxf(sc[ti][1], sc[ti][2])), sc[ti][3]);
    m1 = fmaxf(m1, __shfl_xor(m1, 16)); m1 = fmaxf(m1, __shfl_xor(m1, 32));
    float l = 0.f;
#pragma unroll
    for (int ti = 0; ti < 16; ++ti) {
#pragma unroll
        for (int e = 0; e < 4; ++e) { const float pe = __expf(sc[ti][e] - m1); sc[ti][e] = pe; l += pe; }
    }
    NA_LOAD(5); NA_PV(4);
    NA_LOAD(6); NA_PV(5);
    NA_LOAD(7); NA_PV(6);
    NA_LOAD(8); NA_PV(7);
    NA_LOAD(9); NA_QK(8);
    NA_LOAD(10); NA_QK(9);
    NA_LOAD(11); NA_QK(10);
    NA_LOAD(12); NA_QK(11);
    float m2 = -1e30f;
#pragma unroll
    for (int ti = 0; ti < 16; ++ti) m2 = fmaxf(fmaxf(fmaxf(m2, sc[ti][0]), fmaxf(sc[ti][1], sc[ti][2])), sc[ti][3]);
    m2 = fmaxf(m2, __shfl_xor(m2, 16)); m2 = fmaxf(m2, __shfl_xor(m2, 32));
    const float mm = fmaxf(m1, m2), al = __expf(m1 - mm);
    l *= al;
#pragma unroll
    for (int dt = 0; dt < 4; ++dt) o[dt] = o[dt] * al;
#pragma unroll
    for (int ti = 0; ti < 16; ++ti) {
#pragma unroll
        for (int e = 0; e < 4; ++e) { const float pe = __expf(sc[ti][e] - mm); sc[ti][e] = pe; l += pe; }
    }
    NA_LOAD(13); NA_PV(12);
    NA_LOAD(14); NA_PV(13);
    NA_LOAD(15); NA_PV(14);
    NA_PV(15);
#undef NA_LOAD
#undef NA_QK
#undef NA_PV
    l += __shfl_xor(l, 16); l += __shfl_xor(l, 32);
    const float il = 1.f / l;
    bf16_t* ONA = (bf16_t*)(p.ws + WS_ONA);
#pragma unroll
    for (int dt = 0; dt < 4; ++dt) { u32x2 w; w.x = pk2(o[dt][0] * il, o[dt][1] * il); w.y = pk2(o[dt][2] * il, o[dt][3] * il);
        *(u32x2*)(ONA + (size_t)qtok * 512 + h * 64 + 16 * dt + 4 * q4) = w; }
}

#ifndef LAS
#define LAS __attribute__((address_space(3)))
#endif
constexpr int GL_Q = 0;
constexpr int GL_K = 17408;
constexpr int GL_KT = 34816;
constexpr int GL_VR = 53248;
constexpr int GL_VT = 69632;
constexpr int GL_ATT = 88064;
constexpr int GL_O = 97280;
constexpr int GL_ALR = 114688;
constexpr int GL_SEG = 118784;
constexpr int GL_D = 120832;
__device__ __forceinline__ int gla_row0(int b, int dir, int n) {
    if (n < 4) return TL + b * CTX + (dir == 0 ? n : 3 - n) * 64;
    return b * SEQ + (dir == 0 ? n - 4 : 35 - n) * 64;
}
__device__ void gla_chain(const Params& p, unsigned char* ldsg, int item) {
    LAS unsigned char* lds = (LAS unsigned char*)ldsg;
    const int tid = threadIdx.x, lane = tid & 63, wave = tid >> 6;
    const int slice = item & 1, dir = (item >> 1) & 1, h = (item >> 2) & 3, b = item >> 4;
    const int d_ = tid & 127, seg = tid >> 7, l15 = lane & 15, q4 = lane >> 4;
    const bf16_t* QG = (const bf16_t*)(p.ws + WS_QG); const bf16_t* KG = (const bf16_t*)(p.ws + WS_KG); const bf16_t* VG = (const bf16_t*)(p.ws + WS_VG);
    const float* ALR = (const float*)(p.ws + WS_ALR);
    bf16_t* OX = (bf16_t*)((unsigned char*)p.out + (dir == 0 ? 0 : (size_t)64 * MiB));
    float w2[16];
#pragma unroll
    for (int r = 0; r < 16; ++r) w2[r] = p.in[I_WA2][(dir * 16 + r) * 512 + h * 128 + d_];
    const float b2 = p.in[I_BA2][dir * 512 + h * 128 + d_];
    f32x4 S[8];
#pragma unroll
    for (int i = 0; i < 8; ++i) S[i] = (f32x4){0.f, 0.f, 0.f, 0.f};
    u32x4 pq[2], pk[2], pv[2], pa;
    {
        const int r0 = gla_row0(b, dir, 0);
#pragma unroll
        for (int j = 0; j < 2; ++j) { const int c = tid + 512 * j, row = c >> 4, c16 = c & 15;
            pq[j] = (u32x4){0u, 0u, 0u, 0u};
            pk[j] = *(const u32x4*)(KG + (size_t)(r0 + row) * 512 + h * 128 + c16 * 8);
            pv[j] = *(const u32x4*)(VG + (size_t)(r0 + row) * 1024 + h * 256 + slice * 128 + c16 * 8); }
        pa = (u32x4){0u, 0u, 0u, 0u};
        if (tid < 256) pa = *(const u32x4*)(ALR + (size_t)(r0 + (tid >> 2)) * 32 + dir * 16 + (tid & 3) * 4);
    }
    for (int n = 0; n < 36; ++n) {
        const bool lat = n >= 4;
        const int r0 = gla_row0(b, dir, n);
#pragma unroll
        for (int j = 0; j < 2; ++j) { const int c = tid + 512 * j, row = c >> 4, c16 = c & 15;
            *(LAS u32x4*)(lds + GL_Q + row * 272 + c16 * 16) = pq[j];
            *(LAS u32x4*)(lds + GL_K + row * 272 + c16 * 16) = pk[j];
            *(LAS u32x4*)(lds + GL_VR + row * 256 + c16 * 16) = pv[j]; }
        if (tid < 256) *(LAS u32x4*)(lds + GL_ALR + (tid >> 2) * 64 + (tid & 3) * 16) = pa;
        if (n + 1 < 36) {
            const int r1 = gla_row0(b, dir, n + 1); const bool lat1 = n + 1 >= 4;
#pragma unroll
            for (int j = 0; j < 2; ++j) { const int c = tid + 512 * j, row = c >> 4, c16 = c & 15;
                if (lat1) pq[j] = *(const u32x4*)(QG + (size_t)(r1 + row) * 512 + h * 128 + c16 * 8);
                pk[j] = *(const u32x4*)(KG + (size_t)(r1 + row) * 512 + h * 128 + c16 * 8);
                pv[j] = *(const u32x4*)(VG + (size_t)(r1 + row) * 1024 + h * 256 + slice * 128 + c16 * 8); }
            if (tid < 256) pa = *(const u32x4*)(ALR + (size_t)(r1 + (tid >> 2)) * 32 + dir * 16 + (tid & 3) * 4);
        }
        __syncthreads();
        float g[16];
#pragma unroll
        for (int i = 0; i < 16; ++i) {
            const int t = 16 * seg + i;
            float z = b2;
#pragma unroll
            for (int r4 = 0; r4 < 4; ++r4) { const f32x4 a = *(const LAS f32x4*)(lds + GL_ALR + t * 64 + r4 * 16);
                z += a[0] * w2[4 * r4] + a[1] * w2[4 * r4 + 1] + a[2] * w2[4 * r4 + 2] + a[3] * w2[4 * r4 + 3]; }
            const float ls = fminf(z, 0.f) - __logf(1.f + __expf(-fabsf(z)));
            g[i] = ls * (1.f / 16.f);
        }
        if (dir == 0) {
#pragma unroll
            for (int i = 1; i < 16; ++i) g[i] += g[i - 1];
        } else {
#pragma unroll
            for (int i = 14; i >= 0; --i) g[i] += g[i + 1];
        }
        *(LAS float*)(lds + GL_SEG + (seg * 128 + d_) * 4) = dir == 0 ? g[15] : g[0];
        __syncthreads();
        {
            const float s0 = *(const LAS float*)(lds + GL_SEG + (0 * 128 + d_) * 4), s1 = *(const LAS float*)(lds + GL_SEG + (1 * 128 + d_) * 4),
                        s2 = *(const LAS float*)(lds + GL_SEG + (2 * 128 + d_) * 4), s3 = *(const LAS float*)(lds + GL_SEG + (3 * 128 + d_) * 4);
            float off;
            if (dir == 0) off = (seg > 0 ? s0 : 0.f) + (seg > 1 ? s1 : 0.f) + (seg > 2 ? s2 : 0.f);
            else off = (seg < 1 ? s1 : 0.f) + (seg < 2 ? s2 : 0.f) + (seg < 3 ? s3 : 0.f);
            if (seg == 0) *(LAS float*)(lds + GL_D + d_ * 4) = __expf((s0 + s1) + (s2 + s3));
            unsigned kt[8], vt[8];
#pragma unroll
            for (int i = 0; i < 16; ++i) {
                const int t = 16 * seg + i;
                const float bb = g[i] + off, e1 = __expf(bb), e2 = __builtin_amdgcn_rcpf(e1);
                if (lat) { LAS unsigned short* qp = (LAS unsigned short*)(lds + GL_Q + t * 272 + d_ * 2); *qp = (unsigned short)f2bf(bf2f(*qp) * e1); }
                LAS unsigned short* kp = (LAS unsigned short*)(lds + GL_K + t * 272 + d_ * 2);
                const unsigned kb = f2bf(bf2f(*kp) * e2);
                if (lat) *kp = (unsigned short)kb;
                const unsigned vb = *(const LAS unsigned short*)(lds + GL_VR + t * 256 + d_ * 2);
                if (i & 1) { kt[i >> 1] |= kb << 16; vt[i >> 1] |= vb << 16; } else { kt[i >> 1] = kb; vt[i >> 1] = vb; }
            }
            *(LAS u32x4*)(lds + GL_KT + d_ * 144 + seg * 32) = (u32x4){kt[0], kt[1], kt[2], kt[3]};
            *(LAS u32x4*)(lds + GL_KT + d_ * 144 + seg * 32 + 16) = (u32x4){kt[4], kt[5], kt[6], kt[7]};
            *(LAS u32x4*)(lds + GL_VT + d_ * 144 + seg * 32) = (u32x4){vt[0], vt[1], vt[2], vt[3]};
            *(LAS u32x4*)(lds + GL_VT + d_ * 144 + seg * 32 + 16) = (u32x4){vt[4], vt[5], vt[6], vt[7]};
        }
        __syncthreads();
        if (lat) {
            const int tt = wave >> 1, ss0 = (wave & 1) * 2;
            f32x4 a0 = (f32x4){0.f, 0.f, 0.f, 0.f}, a1 = (f32x4){0.f, 0.f, 0.f, 0.f};
#pragma unroll
            for (int kk = 0; kk < 4; ++kk) {
                const bf16x8 A = *(const LAS bf16x8*)(lds + GL_Q + (16 * tt + l15) * 272 + (32 * kk + 8 * q4) * 2);
                const bf16x8 B0 = *(const LAS bf16x8*)(lds + GL_K + (16 * ss0 + l15) * 272 + (32 * kk + 8 * q4) * 2);
                const bf16x8 B1 = *(const LAS bf16x8*)(lds + GL_K + (16 * (ss0 + 1) + l15) * 272 + (32 * kk + 8 * q4) * 2);
                a0 = __builtin_amdgcn_mfma_f32_16x16x32_bf16(A, B0, a0, 0, 0, 0);
                a1 = __builtin_amdgcn_mfma_f32_16x16x32_bf16(A, B1, a1, 0, 0, 0);
            }
#pragma unroll
            for (int r = 0; r < 4; ++r) {
                const int t = 16 * tt + 4 * q4 + r, sA = 16 * ss0 + l15, sB = sA + 16;
                const bool kA = dir == 0 ? (sA <= t) : (sA >= t), kB = dir == 0 ? (sB <= t) : (sB >= t);
                *(LAS unsigned short*)(lds + GL_ATT + t * 144 + sA * 2) = (unsigned short)f2bf(kA ? a0[r] : 0.f);
                *(LAS unsigned short*)(lds + GL_ATT + t * 144 + sB * 2) = (unsigned short)f2bf(kB ? a1[r] : 0.f);
            }
        }
        __syncthreads();
        {
            bf16x8 vB[2];
#pragma unroll
            for (int kk = 0; kk < 2; ++kk) vB[kk] = *(const LAS bf16x8*)(lds + GL_VT + (16 * wave + l15) * 144 + (32 * kk + 8 * q4) * 2);
            if (lat) {
                f32x4 o[4];
#pragma unroll
                for (int tt = 0; tt < 4; ++tt) o[tt] = (f32x4){0.f, 0.f, 0.f, 0.f};
#pragma unroll
                for (int tt = 0; tt < 4; ++tt)
#pragma unroll
                    for (int kk = 0; kk < 2; ++kk) { const bf16x8 A = *(const LAS bf16x8*)(lds + GL_ATT + (16 * tt + l15) * 144 + (32 * kk + 8 * q4) * 2);
                        o[tt] = __builtin_amdgcn_mfma_f32_16x16x32_bf16(A, vB[kk], o[tt], 0, 0, 0); }
#pragma unroll
                for (int kk = 0; kk < 4; ++kk) {
                    const f32x4 sa = S[2 * kk], sb = S[2 * kk + 1];
                    u32x4 bw; bw.x = pk2(sa[0], sa[1]); bw.y = pk2(sa[2], sa[3]); bw.z = pk2(sb[0], sb[1]); bw.w = pk2(sb[2], sb[3]);
                    const bf16x8 Bs = __builtin_bit_cast(bf16x8, bw);
#pragma unroll
                    for (int tt = 0; tt < 4; ++tt) {
                        const u32x2 lo = *(const LAS u32x2*)(lds + GL_Q + (16 * tt + l15) * 272 + (32 * kk + 4 * q4) * 2);
                        const u32x2 hi = *(const LAS u32x2*)(lds + GL_Q + (16 * tt + l15) * 272 + (32 * kk + 16 + 4 * q4) * 2);
                        const bf16x8 A = __builtin_bit_cast(bf16x8, (u32x4){lo.x, lo.y, hi.x, hi.y});
                        o[tt] = __builtin_amdgcn_mfma_f32_16x16x32_bf16(A, Bs, o[tt], 0, 0, 0);
                    }
                }
#pragma unroll
                for (int tt = 0; tt < 4; ++tt)
#pragma unroll
                    for (int r = 0; r < 4; ++r) *(LAS unsigned short*)(lds + GL_O + (16 * tt + 4 * q4 + r) * 272 + (16 * wave + l15) * 2) = (unsigned short)f2bf(o[tt][r]);
            }
#pragma unroll
            for (int dt = 0; dt < 8; ++dt) {
#pragma unroll
                for (int kk = 0; kk < 2; ++kk) { const bf16x8 A = *(const LAS bf16x8*)(lds + GL_KT + (16 * dt + l15) * 144 + (32 * kk + 8 * q4) * 2);
                    S[dt] = __builtin_amdgcn_mfma_f32_16x16x32_bf16(A, vB[kk], S[dt], 0, 0, 0); }
                const f32x4 Dv = *(const LAS f32x4*)(lds + GL_D + (16 * dt + 4 * q4) * 4);
                S[dt] = S[dt] * Dv;
            }
        }
        __syncthreads();
        if (lat) {
#pragma unroll
            for (int j = 0; j < 2; ++j) { const int c = tid + 512 * j, row = c >> 4, c16 = c & 15;
                const u32x4 v = *(const LAS u32x4*)(lds + GL_O + row * 272 + c16 * 16);
                *(u32x4*)(OX + (size_t)(r0 + row) * 1024 + h * 256 + slice * 128 + c16 * 8) = v; }
        }
    }
    __syncthreads();
}

__device__ void phase3(const Params& p, unsigned char* lds, int bid, int nb) {
    for (int it = bid; it < 256; it += nb) gla_chain(p, lds, it);
    {
        const bool xm = (nb & 7) == 0;
        const int wv = __builtin_amdgcn_readfirstlane(threadIdx.x >> 6), tid = threadIdx.x;
        const int s0 = xm ? (bid >> 3) : bid, ds = xm ? (nb >> 3) : nb, smax = xm ? 32 : 256;
        const bf16_t* KN = (const bf16_t*)(p.ws + WS_KN); const bf16_t* VTC = (const bf16_t*)(p.ws + WS_VN) + (size_t)32 * MiB / 2;
        const float* RPB = p.in[I_RPB];
        for (int sl = s0; sl < smax; sl += ds) {
            const int slab = xm ? ((((bid & 7) + 8 * (sl >> 4)) << 4) | (sl & 15)) : sl;
            const int b = slab >> 4, h = (slab >> 1) & 7, half = slab & 1;
            __syncthreads();
            int tl = tid; asm volatile("" : "+v"(tl));
#pragma unroll
            for (int q = 0; q < 4; ++q) { const int c = tl + NT * q;
                const u32x4 kv = *(const u32x4*)(KN + ((size_t)TL + b * CTX + (c >> 3)) * 512 + h * 64 + (c & 7) * 8);
                const u32x4 vv = *(const u32x4*)(VTC + ((size_t)(b * 8 + h) * 64 + (c >> 5)) * 256 + (c & 31) * 8);
                *(u32x4*)(lds + NL_K + (c >> 3) * 144 + (c & 7) * 16) = kv;
                *(u32x4*)(lds + NL_VT + (c >> 5) * 528 + (c & 31) * 16) = vv; }
            for (int i = tl; i < 465; i += NT) ((float*)(lds + NL_RPB))[i] = RPB[h * 465 + i];
            __syncthreads();
            _Pragma("nounroll") for (int it = 0; it < 8; ++it) { const int idx = it * 8 + wv; na_item(p, lds, b, 16 * half + (idx >> 2), idx & 3, h); }
        }
    }
    __syncthreads();
}

__device__ void phase4r(const Params& p, int bid, int nb) {
    const int lane = threadIdx.x & 63;
    const int gw = bid * 8 + (threadIdx.x >> 6), ngw = nb * 8;
    const bf16_t* OF = (const bf16_t*)p.out; const bf16_t* OB = (const bf16_t*)((const unsigned char*)p.out + (size_t)64 * MiB); bf16_t* GG = (bf16_t*)(p.ws + WS_GG);
    const float* gng = p.in[I_GNG];
    for (int row = gw; row < TL; row += ngw) {
        f32x4 v[4]; float s = 0.f;
        {
            const u32x4* fp = (const u32x4*)(OF + (size_t)row * 1024 + 16 * lane); const u32x4* bp = (const u32x4*)(OB + (size_t)row * 1024 + 16 * lane);
            const u32x4 f0 = fp[0], f1 = fp[1], b0 = bp[0], b1 = bp[1];
            v[0] = (f32x4){bflo(f0.x) + bflo(b0.x), bfhi(f0.x) + bfhi(b0.x), bflo(f0.y) + bflo(b0.y), bfhi(f0.y) + bfhi(b0.y)};
            v[1] = (f32x4){bflo(f0.z) + bflo(b0.z), bfhi(f0.z) + bfhi(b0.z), bflo(f0.w) + bflo(b0.w), bfhi(f0.w) + bfhi(b0.w)};
            v[2] = (f32x4){bflo(f1.x) + bflo(b1.x), bfhi(f1.x) + bfhi(b1.x), bflo(f1.y) + bflo(b1.y), bfhi(f1.y) + bfhi(b1.y)};
            v[3] = (f32x4){bflo(f1.z) + bflo(b1.z), bfhi(f1.z) + bfhi(b1.z), bflo(f1.w) + bflo(b1.w), bfhi(f1.w) + bfhi(b1.w)};
#pragma unroll
            for (int j = 0; j < 4; ++j) s += v[j][0] * v[j][0] + v[j][1] * v[j][1] + v[j][2] * v[j][2] + v[j][3] * v[j][3];
        }
        s += __shfl_xor(s, 1); s += __shfl_xor(s, 2); s += __shfl_xor(s, 4); s += __shfl_xor(s, 8);
        const float rstd = rsqrtf(s * (1.f / 256.f) + EPS);
        u32x4* gp = (u32x4*)(GG + (size_t)row * 1024 + 16 * lane);
        const u32x4 g0 = gp[0], g1 = gp[1];
        const unsigned gu[8] = {g0.x, g0.y, g0.z, g0.w, g1.x, g1.y, g1.z, g1.w};
        unsigned ou[8];
#pragma unroll
        for (int j = 0; j < 8; ++j) {
            const int c = (16 * lane + 2 * j) & 255;
            const float a0 = v[j >> 1][(2 * j) & 3] * rstd * gng[c] * siluf_(bflo(gu[j]));
            const float a1 = v[j >> 1][(2 * j + 1) & 3] * rstd * gng[c + 1] * siluf_(bfhi(gu[j]));
            ou[j] = pk2(a0, a1);
        }
        gp[0] = (u32x4){ou[0], ou[1], ou[2], ou[3]}; gp[1] = (u32x4){ou[4], ou[5], ou[6], ou[7]};
    }
}

struct SchedSq {
    __device__ __forceinline__ void a_ready(const Unit&) const {}
    __device__ __forceinline__ void done(const Unit&) const {}
    const bf16_t* A0; const bf16_t* B0; int K0; const bf16_t* A1; const bf16_t* B1; int K1; int passes; int G, c;
    __device__ bool next(int i, Unit& u) const {
        const int s = i % passes;
        if ((G & 7) == 0) {
            const int t = (i / passes) * (G >> 3) + (c >> 3); if (t >= 64) return false;
            u.pm = 16 * (c & 7) + (t >> 2); u.pn = t & 3;
        } else { const int L = (i / passes) * G + c; if (L >= 512) return false; u.pm = L >> 2; u.pn = L & 3; }
        u.aux = s; u.rbase = 0; u.nvalid = 0;
        if (s == 0) { u.a = A0 + (size_t)u.pm * 256 * K0; u.b = B0 + (size_t)u.pn * 256 * K0; }
        else { u.a = A1 + (size_t)u.pm * 256 * K1; u.b = B1 + (size_t)u.pn * 256 * K1; }
        return true;
    }
};
struct EpiMerge {
    static constexpr bool PERM = false, AFTER_DRAIN = false;
    unsigned char* ws; int pass;
    __device__ __forceinline__ void operator()(const f32x4 (&acc)[2][2][4][2], const Unit& u, int wr, int wc, int fr, int fq) const {
        bf16_t* M8 = (bf16_t*)(ws + WS_M8); const bf16_t* M9 = (const bf16_t*)(ws + WS_M9);
        const int row0 = u.pm * 256 + wr * 64 + fr, col0 = u.pn * 256 + wc * 32 + 4 * fq;
        u32x2 g8[2][2][2], g9[2][2][2];
#define EM_LOAD(k_, buf_) do { _Pragma("unroll") for (int bj = 0; bj < 2; ++bj) _Pragma("unroll") for (int n = 0; n < 2; ++n) { \
            const size_t off = (size_t)(row0 + ((k_) >> 2) * 128 + ((k_) & 3) * 16) * 1024 + col0 + bj * 128 + n * 16; \
            g8[buf_][bj][n] = *(const u32x2*)(M8 + off); if (pass != 0) g9[buf_][bj][n] = *(const u32x2*)(M9 + off); } } while (0)
#define EM_STORE(k_, buf_) do { _Pragma("unroll") for (int bj = 0; bj < 2; ++bj) _Pragma("unroll") for (int n = 0; n < 2; ++n) { \
            const int ai = (k_) >> 2, m = (k_) & 3; \
            const size_t off = (size_t)(row0 + ai * 128 + m * 16) * 1024 + col0 + bj * 128 + n * 16; \
            const f32x4 v = acc[ai][bj][m][n]; const u32x2 g = g8[buf_][bj][n]; u32x2 w; \
            if (pass == 0) { w.x = pk2(v[0] * sigmoidf_(bflo(g.x)), v[1] * sigmoidf_(bfhi(g.x))); w.y = pk2(v[2] * sigmoidf_(bflo(g.y)), v[3] * sigmoidf_(bfhi(g.y))); } \
            else { const u32x2 q9 = g9[buf_][bj][n]; \
                w.x = pk2(bflo(g.x) + v[0] * sigmoidf_(bflo(q9.x)), bfhi(g.x) + v[1] * sigmoidf_(bfhi(q9.x))); \
                w.y = pk2(bflo(g.y) + v[2] * sigmoidf_(bflo(q9.y)), bfhi(g.y) + v[3] * sigmoidf_(bfhi(q9.y))); } \
            *(u32x2*)(M8 + off) = w; } } while (0)
        EM_LOAD(0, 0); EM_LOAD(1, 1);
        EM_STORE(0, 0); EM_LOAD(2, 0);
        EM_STORE(1, 1); EM_LOAD(3, 1);
        EM_STORE(2, 0); EM_LOAD(4, 0);
        EM_STORE(3, 1); EM_LOAD(5, 1);
        EM_STORE(4, 0); EM_LOAD(6, 0);
        EM_STORE(5, 1); EM_LOAD(7, 1);
        EM_STORE(6, 0);
        EM_STORE(7, 1);
#undef EM_LOAD
#undef EM_STORE
    }
};
struct EpiOut {
    static constexpr bool PERM = false, AFTER_DRAIN = false;
    const float* x; const float* MOD; float* HMID; float* ROWSS;
    __device__ __forceinline__ void operator()(const f32x4 (&acc)[2][2][4][2], const Unit& u, int wr, int wc, int fr, int fq) const {
        const int row0 = u.pm * 256 + wr * 64 + fr, col0 = u.pn * 256 + wc * 32 + 4 * fq;
        const int b = (u.pm * 256) >> 11;
        float ss[2][4];
#pragma unroll
        for (int ai = 0; ai < 2; ++ai)
#pragma unroll
            for (int m = 0; m < 4; ++m) ss[ai][m] = 0.f;
#pragma unroll
        for (int bj = 0; bj < 2; ++bj)
#pragma unroll
            for (int n = 0; n < 2; ++n) {
                const int c = col0 + bj * 128 + n * 16;
                const f32x4 g1 = *(const f32x4*)(MOD + b * 6144 + 2048 + c);
                f32x4 xin[2][4];
#pragma unroll
                for (int ai = 0; ai < 2; ++ai)
#pragma unroll
                    for (int m = 0; m < 4; ++m) xin[ai][m] = *(const f32x4*)(x + (size_t)(row0 + ai * 128 + m * 16) * 1024 + c);
#pragma unroll
                for (int ai = 0; ai < 2; ++ai)
#pragma unroll
                    for (int m = 0; m < 4; ++m) { const size_t off = (size_t)(row0 + ai * 128 + m * 16) * 1024 + c;
                        const f32x4 hv = xin[ai][m] + g1 * acc[ai][bj][m][n];
                        *(f32x4*)(HMID + off) = hv;
                        ss[ai][m] += (hv[0] * hv[0] + hv[1] * hv[1]) + (hv[2] * hv[2] + hv[3] * hv[3]); }
            }
#pragma unroll
        for (int ai = 0; ai < 2; ++ai)
#pragma unroll
            for (int m = 0; m < 4; ++m) { float v = ss[ai][m]; v += __shfl_xor(v, 16); v += __shfl_xor(v, 32);
                if (fq == 0) ROWSS[(size_t)(row0 + ai * 128 + m * 16) * 16 + u.pn * 4 + wc] = v; }
    }
};

constexpr int P5_WG = 131072;
__device__ void phase5(const Params& p, unsigned char* ldsg, int bid, int nb) {
    LAS unsigned char* lds = (LAS unsigned char*)ldsg;
    const int tid = threadIdx.x, lane = tid & 63, wave = tid >> 6, l15 = lane & 15, q4 = lane >> 4;
    const float* MOD = (const float*)(p.ws + WS_MOD); const float* HMID = (const float*)(p.ws + WS_HMID); const float* ROWSS = (const float*)(p.ws + WS_ROWSS);
    bf16_t* FL = (bf16_t*)(p.ws + WS_FL);
    const float* G = p.in[I_NFG]; const float* WGR = p.in[I_WGRP]; const float* WEX = p.in[I_WEXP]; const float* BGR = p.in[I_BGRP]; const float* BEX = p.in[I_BEXP];
    int* cnt = (int*)(p.ws + WS_CTL) + CW_CNT;
    if (bid == 0 && tid < 128) *(u32x4*)(FL + (size_t)TL * DM + tid * 8) = (u32x4){0u, 0u, 0u, 0u};
    for (int c = tid; c < 8192; c += NT) {
        const int k = c >> 3, o4 = c & 7;
        const f32x4 w = *(const f32x4*)(WEX + (size_t)k * 32 + 4 * o4);
#pragma unroll
        for (int i = 0; i < 4; ++i) *(LAS float*)(lds + ((((k >> 2) * 32 + 4 * o4 + i) * 4 + (k & 3)) * 4)) = w[i];
    }
    for (int c = tid; c < 1024; c += NT) *(LAS f32x4*)(lds + P5_WG + c * 16) = *(const f32x4*)(WGR + (size_t)c * 4);
    __syncthreads();
    for (int tile0 = bid * 8; tile0 < TL / 16; tile0 += nb * 8) {
        const int tile = tile0 + wave;
        const int tok = tile * 16 + l15, b = (tile * 16) >> 11;
        float rstd;
        { const f32x4 r4 = *(const f32x4*)(ROWSS + (size_t)tok * 16 + 4 * q4); float v = (r4[0] + r4[1]) + (r4[2] + r4[3]); v += __shfl_xor(v, 16); v += __shfl_xor(v, 32);
          rstd = rsqrtf(v * (1.f / DM) + EPS); }
        f32x4 acc0 = (f32x4){0.f, 0.f, 0.f, 0.f}, acc1 = (f32x4){0.f, 0.f, 0.f, 0.f};
        float lg[4] = {0.f, 0.f, 0.f, 0.f};
        const float* hrow = HMID + (size_t)tok * DM + 4 * q4; const float* modb = MOD + b * 6144 + 4 * q4; const float* gq = G + 4 * q4;
        bf16_t* flrow = FL + (size_t)tok * DM + 4 * q4;
        f32x4 hv[2][2], gv[2][2], sh[2][2], sc[2][2];
#define P5_LOAD(gn_, buf_) do { _Pragma("unroll") for (int uu = 0; uu < 2; ++uu) { const int c = 16 * (2 * (gn_) + uu); \
            hv[buf_][uu] = *(const f32x4*)(hrow + c); gv[buf_][uu] = *(const f32x4*)(gq + c); sh[buf_][uu] = *(const f32x4*)(modb + 3072 + c); sc[buf_][uu] = *(const f32x4*)(modb + 4096 + c); } } while (0)
        P5_LOAD(0, 0);
#define P5_COMP(gn_, bf_) do { u32x2 wst[2]; \
            _Pragma("unroll") for (int uu = 0; uu < 2; ++uu) { const int u = 2 * (gn_) + uu; f32x4 f; \
                _Pragma("unroll") for (int i = 0; i < 4; ++i) f[i] = (hv[bf_][uu][i] * rstd) * gv[bf_][uu][i] * (1.f + sc[bf_][uu][i]) + sh[bf_][uu][i]; \
                wst[uu].x = pk2(f[0], f[1]); wst[uu].y = pk2(f[2], f[3]); \
                const f32x4 w0 = *(const LAS f32x4*)(lds + ((4 * u + q4) * 32 + l15) * 16), w1 = *(const LAS f32x4*)(lds + ((4 * u + q4) * 32 + 16 + l15) * 16); \
                _Pragma("unroll") for (int e = 0; e < 4; ++e) { \
                    acc0 = __builtin_amdgcn_mfma_f32_16x16x4f32(f[e], w0[e], acc0, 0, 0, 0); \
                    acc1 = __builtin_amdgcn_mfma_f32_16x16x4f32(f[e], w1[e], acc1, 0, 0, 0); \
                    const f32x4 wg = *(const LAS f32x4*)(lds + P5_WG + (16 * u + 4 * q4 + e) * 16); \
                    lg[0] += f[e] * wg[0]; lg[1] += f[e] * wg[1]; lg[2] += f[e] * wg[2]; lg[3] += f[e] * wg[3]; } } \
            _Pragma("unroll") for (int uu = 0; uu < 2; ++uu) *(u32x2*)(flrow + 16 * (2 * (gn_) + uu)) = wst[uu]; } while (0)
#pragma unroll 1
        for (int g2 = 0; g2 < 16; ++g2) {
            P5_LOAD(2 * g2 + 1, 1);
            P5_COMP(2 * g2, 0);
            if (g2 < 15) P5_LOAD(2 * g2 + 2, 0);
            P5_COMP(2 * g2 + 1, 1);
        }
#undef P5_COMP
#undef P5_LOAD
#pragma unroll
        for (int e = 0; e < 4; ++e) { float v = lg[e]; v += __shfl_xor(v, 16); v += __shfl_xor(v, 32); lg[e] = v + BGR[e]; }
        __syncthreads();
        LAS float* sl = (LAS float*)(lds + wave * (16 * 33 * 4));
        LAS int* bcnt = (LAS int*)(lds + 32768);
        if (tid < 32) bcnt[tid] = 0;
#pragma unroll
        for (int r = 0; r < 4; ++r) { sl[(4 * q4 + r) * 33 + l15] = acc0[r]; sl[(4 * q4 + r) * 33 + 16 + l15] = acc1[r]; }
        __syncthreads();
        int x1 = 0, x2 = 0, lr1 = 0, lr2 = 0; float w1 = 0.f, w2 = 0.f;
        if (lane < 16) {
            int grp = 0; float gm = lg[0];
#pragma unroll
            for (int e = 1; e < 4; ++e) if (lg[e] > gm) { gm = lg[e]; grp = e; }
            float gs = 0.f;
#pragma unroll
            for (int e = 0; e < 4; ++e) gs += __expf(lg[e] - gm);
            const float pgrp = 1.f / gs;
            float l8[8];
#pragma unroll
            for (int e = 0; e < 8; ++e) l8[e] = sl[lane * 33 + grp * 8 + e] + BEX[grp * 8 + e];
            int i1 = 0; float m1 = l8[0];
#pragma unroll
            for (int e = 1; e < 8; ++e) if (l8[e] > m1) { m1 = l8[e]; i1 = e; }
            int i2 = -1; float m2 = -3.0e38f;
#pragma unroll
            for (int e = 0; e < 8; ++e) if (e != i1 && l8[e] > m2) { m2 = l8[e]; i2 = e; }
            const float e2 = __expf(m2 - m1);
            w1 = pgrp / (1.f + e2); w2 = pgrp * e2 / (1.f + e2);
            x1 = grp * 8 + i1; x2 = grp * 8 + i2;
            lr1 = __hip_atomic_fetch_add(bcnt + x1, 1, __ATOMIC_RELAXED, __HIP_MEMORY_SCOPE_WORKGROUP);
            lr2 = __hip_atomic_fetch_add(bcnt + x2, 1, __ATOMIC_RELAXED, __HIP_MEMORY_SCOPE_WORKGROUP);
        }
        __syncthreads();
        if (tid < 32) bcnt[32 + tid] = atomicAdd(&cnt[tid * 64], bcnt[tid]);
        __syncthreads();
        if (lane < 16) {
            int* ERT = (int*)(p.ws + WS_ERT); float* ERW = (float*)(p.ws + WS_ERW);
            const int i1 = x1 * ECAP + bcnt[32 + x1] + lr1, i2 = x2 * ECAP + bcnt[32 + x2] + lr2;
            ERT[i1] = tok * 2; ERW[i1] = w1; ERT[i2] = tok * 2 + 1; ERW[i2] = w2;
        }
        asm volatile("s_waitcnt lgkmcnt(0)" ::: "memory");
        if (tile0 + nb * 8 < TL / 16) {
            __syncthreads();
            for (int c = tid; c < 8192; c += NT) {
                const int k = c >> 3, o4 = c & 7;
                const f32x4 w = *(const f32x4*)(WEX + (size_t)k * 32 + 4 * o4);
#pragma unroll
                for (int i = 0; i < 4; ++i) *(LAS float*)(lds + ((((k >> 2) * 32 + 4 * o4 + i) * 4 + (k & 3)) * 4)) = w[i];
            }
            __syncthreads();
        }
    }
    __syncthreads();
}

__device__ void phase5b(const Params& p, float* lds, int bid, int nb) {
    const int lane = threadIdx.x & 63;
    const int gw = bid * 8 + (threadIdx.x >> 6), ngw = nb * 8;
    int* sstart = (int*)lds;
    if (threadIdx.x == 0) { const int* cnt = (const int*)(p.ws + WS_CTL) + CW_CNT; int a = 0; for (int e = 0; e < 32; ++e) { sstart[e] = a; a += ((cnt[e * 64] + 255) >> 8) << 8; } sstart[32] = a; }
    __syncthreads();
    const int* ROUTE = (const int*)(p.ws + WS_ROUTE);
    int* rowtok = (int*)(p.ws + WS_ROWTOK); float* roww = (float*)(p.ws + WS_ROWW);
    const bf16_t* FL = (const bf16_t*)(p.ws + WS_FL); bf16_t* XG = (bf16_t*)(p.ws + WS_XG);
    const int l15 = lane & 15, g4 = lane >> 4;
    for (int it4 = gw; it4 < TL * 2 / 4; it4 += ngw) {
        const int it = it4 * 4 + g4;
        const int tok = it >> 1, k = it & 1;
        const int* R = ROUTE + (size_t)tok * 8;
        const int e = R[k], rk = R[2 + k]; const float w = ((const float*)R)[4 + k];
        const int pos = sstart[e] + rk;
        if (l15 == 0) { rowtok[pos] = it; roww[pos] = w; }
        const u32x4* src = (const u32x4*)(FL + (size_t)tok * DM); u32x4* dst = (u32x4*)(XG + (size_t)pos * DM);
        u32x4 v[8];
#pragma unroll
        for (int q = 0; q < 8; ++q) v[q] = src[l15 + 16 * q];
#pragma unroll
        for (int q = 0; q < 8; ++q) dst[l15 + 16 * q] = v[q];
    }
    const int* cnt = (const int*)(p.ws + WS_CTL) + CW_CNT;
    for (int e = 0; e < 32; ++e) {
        const int c = cnt[e * 64], padn = (((c + 255) >> 8) << 8) - c;
        for (int r = gw; r < padn; r += ngw) { u32x4* dst = (u32x4*)(XG + (size_t)(sstart[e] + c + r) * DM); dst[lane] = (u32x4){0, 0, 0, 0}; dst[lane + 64] = (u32x4){0, 0, 0, 0}; }
    }
    __syncthreads();
}

struct SchedMoe {
    __device__ __forceinline__ void a_ready(const Unit&) const {}
    __device__ __forceinline__ void done(const Unit&) const {}
    const bf16_t* A; const bf16_t* B; int K; size_t bexp; const int* tstart;
    int G, c; bool gather;
    __device__ bool next(int i, Unit& u) const {
        const int ntile = __builtin_amdgcn_readfirstlane(tstart[32]);
        if ((G & 7) == 0) {
            const int t = i * (G >> 3) + (c >> 3);
            u.pm = 8 * (t >> 2) + (c & 7); u.pn = t & 3;
            if (u.pm >= ntile) return false;
        } else { const int L = i * G + c; if (L >= ntile * 4) return false; u.pm = L >> 2; u.pn = L & 3; }
        const int e = __builtin_amdgcn_readfirstlane(tstart[40 + u.pm]);
        const int j = u.pm - __builtin_amdgcn_readfirstlane(tstart[e]), ce = __builtin_amdgcn_readfirstlane(tstart[400 + e]);
        u.aux = e; u.rbase = e * ECAP + 256 * j; u.nvalid = min(256, ce - 256 * j);
        u.a = gather ? A : A + (size_t)u.pm * 256 * K; u.b = B + (size_t)e * bexp + (size_t)u.pn * 256 * K;
        return true;
    }
};
struct EpiGU {
    static constexpr bool PERM = false, AFTER_DRAIN = false;
    bf16_t* H;
    __device__ __forceinline__ void operator()(const f32x4 (&acc)[2][2][4][2], const Unit& u, int wr, int wc, int fr, int fq) const {
        const int row0 = u.pm * 256 + wr * 64 + fr, col0 = u.pn * 128 + wc * 32 + 4 * fq;
#pragma unroll
        for (int ai = 0; ai < 2; ++ai)
#pragma unroll
            for (int m = 0; m < 4; ++m)
#pragma unroll
                for (int n = 0; n < 2; ++n) {
                    const f32x4 g = acc[ai][0][m][n], up = acc[ai][1][m][n];
                    u32x2 w; w.x = pk2(siluf_(g[0]) * up[0], siluf_(g[1]) * up[1]); w.y = pk2(siluf_(g[2]) * up[2], siluf_(g[3]) * up[3]);
                    *(u32x2*)(H + (size_t)(row0 + ai * 128 + m * 16) * 512 + col0 + n * 16) = w;
                }
    }
};
struct EpiDown {
    static constexpr bool PERM = false, AFTER_DRAIN = false;
    bf16_t* YS; const int* rowtok; const float* roww;
    __device__ __forceinline__ void operator()(const f32x4 (&acc)[2][2][4][2], const Unit& u, int wr, int wc, int fr, int fq) const {
        const int row0 = u.pm * 256 + wr * 64 + fr, col0 = u.pn * 256 + wc * 32 + 4 * fq;
        int tsv[2][4]; float wv[2][4];
#pragma unroll
        for (int ai = 0; ai < 2; ++ai)
#pragma unroll
            for (int m = 0; m < 4; ++m) { const int rl = wr * 64 + fr + ai * 128 + m * 16; const bool ok = rl < u.nvalid; tsv[ai][m] = ok ? rowtok[u.rbase + rl] : -1; wv[ai][m] = ok ? roww[u.rbase + rl] : 0.f; }
#pragma unroll
        for (int ai = 0; ai < 2; ++ai)
#pragma unroll
            for (int m = 0; m < 4; ++m) {
                const int ts = tsv[ai][m]; const float w = wv[ai][m];
                if (ts >= 0) {
                    bf16_t* rp = YS + ((size_t)(ts & 1) * TL + (ts >> 1)) * 1024 + col0;
#pragma unroll
                    for (int bj = 0; bj < 2; ++bj)
#pragma unroll
                        for (int n = 0; n < 2; ++n) { const f32x4 v = acc[ai][bj][m][n] * w; u32x2 o; o.x = pk2(v[0], v[1]); o.y = pk2(v[2], v[3]); *(u32x2*)(rp + bj * 128 + n * 16) = o; }
                }
            }
    }
};
__device__ void moe_tiles(const Params& p, int* tstart) {
    if (threadIdx.x == 0) { const int* cnt = (const int*)(p.ws + WS_CTL) + CW_CNT; int a = 0;
        for (int e = 0; e < 32; ++e) { tstart[e] = a; const int n = (cnt[e * 64] + 255) >> 8; for (int j = 0; j < n; ++j) tstart[40 + a + j] = e; a += n; }
        tstart[32] = a; for (int e = 0; e < 32; ++e) tstart[400 + e] = cnt[e * 64]; }
    __syncthreads();
}

__device__ void phase7(const Params& p, int bid, int nb) {
    const int lane = threadIdx.x & 63;
    const int gw = bid * 8 + (threadIdx.x >> 6), ngw = nb * 8;
    const float* MOD = (const float*)(p.ws + WS_MOD); const float* HMID = (const float*)(p.ws + WS_HMID);
    const bf16_t* YS = (const bf16_t*)(p.ws + WS_YS);
    const float* G = p.in[I_FNG];
    for (int row = gw; row < TL; row += ngw) {
        const int b = row >> 11;
        f32x4 v[4]; float s = 0.f;
#pragma unroll
        for (int j = 0; j < 4; ++j) {
            const int c = 4 * lane + 256 * j;
            const f32x4 hm = *(const f32x4*)(HMID + (size_t)row * DM + c);
            const f32x4 g2 = *(const f32x4*)(MOD + b * 6144 + 5120 + c);
            const u32x2 y0 = *(const u32x2*)(YS + (size_t)row * DM + c), y1 = *(const u32x2*)(YS + ((size_t)TL + row) * DM + c);
            f32x4 y; y[0] = bflo(y0.x) + bflo(y1.x); y[1] = bfhi(y0.x) + bfhi(y1.x); y[2] = bflo(y0.y) + bflo(y1.y); y[3] = bfhi(y0.y) + bfhi(y1.y);
            v[j] = hm + g2 * y;
            s += v[j][0] * v[j][0] + v[j][1] * v[j][1] + v[j][2] * v[j][2] + v[j][3] * v[j][3];
        }
        const float rstd = rsqrtf(wave_sum(s) * (1.f / DM) + EPS);
#pragma unroll
        for (int j = 0; j < 4; ++j) { const int c = 4 * lane + 256 * j; const f32x4 g = *(const f32x4*)(G + c);
            *(f32x4*)(p.out + (size_t)row * DM + c) = (v[j] * rstd) * g; }
    }
}


#ifndef LAS
#define LAS __attribute__((address_space(3)))
#endif
#define XB_TMO      128
#define XB_XCNT(j)  (256  + 64 * (j))
#define XB_XSUB(j)  (1280 + 64 * (j))
#define XB_XGEN(j)  (2304 + 64 * (j))
#define XB_TOP      3328
#define XB_TOPGEN   3392
#define XCD_BAR_WORDS 3456
#define XB_SPIN_CAP (1u << 18)

__device__ __forceinline__ unsigned xb_ld(unsigned* p)              { return __hip_atomic_load(p, __ATOMIC_RELAXED, __HIP_MEMORY_SCOPE_AGENT); }
__device__ __forceinline__ unsigned xb_add(unsigned* p, unsigned v) { return __hip_atomic_fetch_add(p, v, __ATOMIC_RELAXED, __HIP_MEMORY_SCOPE_AGENT); }
__device__ __forceinline__ unsigned xb_xcc_id() { return (unsigned)__builtin_amdgcn_s_getreg((3 << 11) | 20) & 0xFu; }
#define XB_SPIN(cond, bar) do { unsigned _sp = 0; while (cond) { __builtin_amdgcn_s_sleep(1); \
    if ((++_sp & 255u) == 0u) { if (xb_ld(&(bar)[XB_TMO])) break; if (_sp > XB_SPIN_CAP) { atomicAdd(&(bar)[XB_TMO], 1u); break; } } } } while (0)

struct XcdBarrier {
    unsigned* bar; unsigned x;
    volatile LAS unsigned* st;
};

__device__ __forceinline__ XcdBarrier xcd_barrier_post(unsigned* bar, volatile LAS unsigned* st) {
    XcdBarrier b; b.bar = bar; b.x = xb_xcc_id(); b.st = st;
    if (threadIdx.x == 0) (void)xb_add(&bar[XB_XCNT(b.x)], 1u);
    return b;
}
__device__ __forceinline__ void xcd_barrier_complete(unsigned* bar, unsigned x, unsigned& nloc, unsigned& nx) {
    const unsigned G = gridDim.x * gridDim.y * gridDim.z;
    unsigned sum, cnt, mine, sp = 0u;
    for (;;) {
        sum = 0u; cnt = 0u; mine = 0u;
#pragma unroll
        for (unsigned j = 0; j < 16; ++j) { const unsigned c = xb_ld(&bar[XB_XCNT(j)]); sum += c; cnt += (c > 0u) ? 1u : 0u; mine = (j == x) ? c : mine; }
        if (sum == G) break;
        __builtin_amdgcn_s_sleep(1);
        if ((++sp & 255u) == 0u) { if (xb_ld(&bar[XB_TMO])) break; if (sp > XB_SPIN_CAP) { atomicAdd(&bar[XB_TMO], 1u); break; } }
    }
    nloc = mine > 0u ? mine : 1u; nx = cnt > 0u ? cnt : 1u;
}

__device__ __forceinline__ void xcd_barrier(const XcdBarrier& b) {
    asm volatile("s_waitcnt vmcnt(0)" ::: "memory");
    __syncthreads();
    if (threadIdx.x == 0) {
        unsigned* bar = b.bar;
        __builtin_amdgcn_s_waitcnt(0);
        unsigned nloc = b.st[0], nx = b.st[1];
        if (nloc == 0u) { xcd_barrier_complete(bar, b.x, nloc, nx); b.st[0] = nloc; b.st[1] = nx; }
        const unsigned old = xb_add(&bar[XB_XSUB(b.x)], 1u);
        const unsigned gen = old / nloc;
        if (old + 1u == (gen + 1u) * nloc) {
            __builtin_amdgcn_fence(__ATOMIC_RELEASE, "agent");
            asm volatile("s_waitcnt vmcnt(0)" ::: "memory");
            const unsigned og = xb_add(&bar[XB_TOP], 1u);
            const unsigned tg = og / nx;
            if (og + 1u == (tg + 1u) * nx) xb_add(&bar[XB_TOPGEN], 1u);
            else XB_SPIN(xb_ld(&bar[XB_TOPGEN]) == tg, bar);
            __builtin_amdgcn_fence(__ATOMIC_ACQUIRE, "agent");
            xb_add(&bar[XB_XGEN(b.x)], 1u);
            asm volatile("s_waitcnt vmcnt(0)" ::: "memory");
        } else {
            XB_SPIN(xb_ld(&bar[XB_XGEN(b.x)]) == gen, bar);
            __builtin_amdgcn_fence(__ATOMIC_ACQUIRE, "agent");
            asm volatile("s_waitcnt vmcnt(0)" ::: "memory");
        }
    }
    __syncthreads();
}


template <int PH>
__device__ __forceinline__ void run_phase(const Params& p, unsigned char* lds, int bid, int nb) {
    if constexpr (PH == 0) phase0(p, (float*)lds, bid, nb);
    if constexpr (PH == 1) phase1(p, bid, nb);
    if constexpr (PH == 2) { SchedIn S{(const bf16_t*)p.out, (const bf16_t*)(p.ws + WS_WIN), nb, bid}; EpiIn E{p.ws}; pg8::gemm_phase<decltype(E), decltype(S), true, true>((PG8_LAS unsigned char*)lds, 1024, S, E); }
    if constexpr (PH == 3) phase3(p, lds, bid, nb);
    if constexpr (PH == 4) phase4r(p, bid, nb);
    if constexpr (PH == 5) {
        SchedSq S{(const bf16_t*)(p.ws + WS_ONA), (const bf16_t*)(p.ws + WS_WNAO), 512, (const bf16_t*)(p.ws + WS_GG), (const bf16_t*)(p.ws + WS_WGLAO), 1024, 1, nb, bid};
        { EpiMerge E{p.ws, 0}; pg8::gemm_phase<decltype(E), decltype(S), true, true>((PG8_LAS unsigned char*)lds, 512, S, E); }
        { SchedSq S1{(const bf16_t*)(p.ws + WS_GG), (const bf16_t*)(p.ws + WS_WGLAO), 1024, nullptr, nullptr, 0, 1, nb, bid}; EpiMerge E{p.ws, 1}; pg8::gemm_phase<decltype(E), decltype(S1), true, true>((PG8_LAS unsigned char*)lds, 1024, S1, E); }
    }
    if constexpr (PH == 6) { SchedSq S{(const bf16_t*)(p.ws + WS_M8), (const bf16_t*)(p.ws + WS_WOUT), 1024, nullptr, nullptr, 0, 1, nb, bid};
        EpiOut E{p.in[I_X], (const float*)(p.ws + WS_MOD), (float*)(p.ws + WS_HMID), (float*)(p.ws + WS_ROWSS)}; pg8::gemm_phase<decltype(E), decltype(S), true, true>((PG8_LAS unsigned char*)lds, 1024, S, E); }
    if constexpr (PH == 7) { phase5(p, lds, bid, nb); prep_experts(p, (float*)lds, bid * 8 + (threadIdx.x >> 6), nb * 8); }
    if constexpr (PH == 9) { int* tstart = (int*)(lds + pg8::STAGE_BYTES); moe_tiles(p, tstart);
        SchedMoe S{(const bf16_t*)(p.ws + WS_FL), (const bf16_t*)((unsigned char*)p.out + OUT_WGU), 1024, (size_t)1024 * 1024, tstart, nb, bid, true};
        EpiGU E{(bf16_t*)(p.ws + WS_H)}; const pg8::NoGather GI{(const int*)(p.ws + WS_ERT), TL};
        pg8::gemm_phase<decltype(E), decltype(S), true, true, true>((PG8_LAS unsigned char*)lds, 1024, S, E, GI); }
    if constexpr (PH == 10) { int* tstart = (int*)(lds + pg8::STAGE_BYTES); moe_tiles(p, tstart);
        SchedMoe S{(const bf16_t*)(p.ws + WS_H), (const bf16_t*)((unsigned char*)p.out + OUT_WD), 512, (size_t)1024 * 512, tstart, nb, bid, false};
        EpiDown E{(bf16_t*)(p.ws + WS_YS), (const int*)(p.ws + WS_ERT), (const float*)(p.ws + WS_ERW)}; pg8::gemm_phase<decltype(E), decltype(S), true, true>((PG8_LAS unsigned char*)lds, 512, S, E); }
    if constexpr (PH == 11) phase7(p, bid, nb);
}
constexpr int LDS_BYTES = 155648;

template <int PH>
__global__ void __launch_bounds__(NT, 2) k_phase(Params p) {
    extern __shared__ __attribute__((aligned(16))) unsigned char lds[];
    run_phase<PH>(p, lds, blockIdx.x, gridDim.x);
}


constexpr int LDS_MISC = 155648 - 256;
__global__ void __launch_bounds__(NT, 2) k_mega(Params p) {
    extern __shared__ __attribute__((aligned(16))) unsigned char lds[];
    const int bid = blockIdx.x, nb = gridDim.x;
    volatile LAS unsigned* misc = (volatile LAS unsigned*)((LAS unsigned char*)lds + LDS_MISC);
    if (threadIdx.x < 64) misc[threadIdx.x] = 0u;
    __syncthreads();
    const XcdBarrier bar = xcd_barrier_post((unsigned*)(p.ws + WS_BAR), misc);
#define PHS(N) run_phase<N>(p, lds, bid, nb); if (PROBE_DUP == N) { xcd_barrier(bar); run_phase<N>(p, lds, bid, nb); } xcd_barrier(bar);
    PHS(0) PHS(1) PHS(2) PHS(3) PHS(4) PHS(5) PHS(6) PHS(7) PHS(9) PHS(10)
    run_phase<11>(p, lds, bid, nb);
}

template <int PH> static void launch_phase(const Params& p, int grid, hipStream_t stream) {
    static bool attr = false;
    if (!attr) { (void)hipFuncSetAttribute((const void*)k_phase<PH>, hipFuncAttributeMaxDynamicSharedMemorySize, LDS_BYTES); attr = true; }
    hipLaunchKernelGGL(k_phase<PH>, dim3(grid), dim3(NT), LDS_BYTES, stream, p);
}

extern "C" void kernel_launch(void* const* d_in, const int* in_sizes, int n_in, void* d_out, int out_size, void* d_ws, size_t ws_size, hipStream_t stream) {
    if (n_in != 24 || ws_size < WS_END) { fprintf(stderr, "kernel_launch: unexpected n_in %d / ws %zu\n", n_in, ws_size); return; }
    Params p{};
    for (int i = 0; i < 24; ++i) p.in[i] = (const float*)d_in[i];
    p.out = (float*)d_out; p.ws = (unsigned char*)d_ws;
#if MEGA
    static int grid = 0;
    if (grid == 0) {
        int dev = 0, cus = 0, per_cu = 0;
        (void)hipGetDevice(&dev);
        (void)hipDeviceGetAttribute(&cus, hipDeviceAttributeMultiprocessorCount, dev);
        (void)hipFuncSetAttribute((const void*)k_mega, hipFuncAttributeMaxDynamicSharedMemorySize, LDS_BYTES);
        if (hipOccupancyMaxActiveBlocksPerMultiprocessor(&per_cu, (const void*)k_mega, NT, LDS_BYTES) != hipSuccess || per_cu < 1) { fprintf(stderr, "occupancy query failed (%d)\n", per_cu); per_cu = 1; }
        if (per_cu > 1) per_cu = 1;
        grid = cus * per_cu;
    }
    (void)hipMemsetAsync((unsigned char*)d_ws + WS_BAR, 0, 16384, stream);
    hipLaunchKernelGGL(k_mega, dim3(grid), dim3(NT), LDS_BYTES, stream, p);
    const hipError_t e = hipPeekAtLastError();
    if (e != hipSuccess) fprintf(stderr, "launch failed: %s (grid %d)\n", hipGetErrorString(e), grid);
#else
    const int G = 256;
    launch_phase<0>(p, G, stream); launch_phase<1>(p, G, stream); launch_phase<2>(p, G, stream); launch_phase<3>(p, G, stream);
    launch_phase<4>(p, G, stream); launch_phase<5>(p, G, stream); launch_phase<6>(p, G, stream); launch_phase<7>(p, G, stream);
    launch_phase<8>(p, G, stream); launch_phase<9>(p, G, stream); launch_phase<10>(p, G, stream); launch_phase<11>(p, G, stream);
#endif
}
```

```cpp
#include <hip/hip_runtime.h>
#include <hip/hip_cooperative_groups.h>
#include <cstdint>
#include <cstdio>
namespace cg = cooperative_groups;

#ifndef MEGA
#define MEGA 1
#endif
#define PROBE_DUP -1

typedef unsigned short bf16_t;
typedef short bf16x8 __attribute__((ext_vector_type(8)));
typedef float f32x4 __attribute__((ext_vector_type(4)));
typedef float f32x2 __attribute__((ext_vector_type(2)));
typedef unsigned u32x4 __attribute__((ext_vector_type(4)));
typedef unsigned u32x2 __attribute__((ext_vector_type(2)));

constexpr int NB = 16, SEQ = 2048, DM = 1024, CTX = 256, GW = 64;
constexpr int TL = NB * SEQ;
constexpr int TC = NB * CTX;
constexpr int TA = TL + TC;
constexpr int NEXP = 32, DEXP = 512;
constexpr int NT = 512;
constexpr float EPS = 1e-6f;
constexpr int ECAP = 32768;
constexpr int MAXROWS = 73728;

constexpr size_t MiB = 1u << 20;
constexpr size_t WS_CTL = 0;
constexpr size_t WS_BAR = 64 * 1024;
constexpr size_t WS_MOD = 1 * MiB;
constexpr size_t WS_ROPE = 1 * MiB + 512 * 1024;
constexpr size_t WS_ROUTE = 2 * MiB;
constexpr size_t WS_ROWTOK = 3 * MiB;
constexpr size_t WS_ROWW = 3 * MiB + 512 * 1024;
constexpr size_t WS_WIN = 4 * MiB;
constexpr size_t WS_WNAO = WS_WIN + (size_t)6912 * 1024 * 2;
constexpr size_t WS_WGLAO = WS_WNAO + 1 * MiB;
constexpr size_t WS_WOUT = WS_WGLAO + 2 * MiB;
constexpr size_t WS_ALR = WS_WOUT + 2 * MiB;
constexpr size_t WS_QN = 28 * MiB;
constexpr size_t WS_KN = 60 * MiB;
constexpr size_t WS_VN = 96 * MiB;
constexpr size_t WS_QG = 132 * MiB;
constexpr size_t WS_KG = 164 * MiB;
constexpr size_t WS_VG = 200 * MiB;
constexpr size_t WS_ONA = 272 * MiB;
constexpr size_t WS_GG = 304 * MiB;
constexpr size_t WS_M8 = 368 * MiB;
constexpr size_t WS_M9 = 432 * MiB;
constexpr size_t WS_ROWSS = 496 * MiB;
constexpr size_t WS_ERT = 156 * MiB;
constexpr size_t WS_ERW = 160 * MiB;
constexpr size_t WS_END = 504 * MiB;
constexpr size_t WS_HMID = 28 * MiB;
constexpr size_t WS_FL = 200 * MiB;
constexpr size_t WS_H = 432 * MiB;
constexpr size_t WS_XG = 304 * MiB;
constexpr size_t WS_YS = 304 * MiB;
static_assert(WS_ALR + (size_t)TA * 32 * 4 <= WS_QN, "ws map");
constexpr size_t OUT_WGU = 0;
constexpr size_t OUT_WD = 64 * MiB;

constexpr int CW_CNT = 0;

__device__ __forceinline__ unsigned pk2(float lo, float hi);
__device__ __forceinline__ unsigned f2bf(float f);
typedef __bf16 bf16x2_hw __attribute__((ext_vector_type(2)));
__device__ __forceinline__ unsigned pk2(float lo, float hi) { const f32x2 v = {lo, hi}; return __builtin_bit_cast(unsigned, __builtin_convertvector(v, bf16x2_hw)); }
__device__ __forceinline__ unsigned f2bf(float f) { return pk2(f, 0.f) & 0xffffu; }
__device__ __forceinline__ float bf2f(unsigned short h) { return __builtin_bit_cast(float, (unsigned)h << 16); }
__device__ __forceinline__ float bflo(unsigned u) { return __builtin_bit_cast(float, u << 16); }
__device__ __forceinline__ float bfhi(unsigned u) { return __builtin_bit_cast(float, u & 0xffff0000u); }
__device__ __forceinline__ float wave_sum(float v) {
#pragma unroll
    for (int o = 1; o < 64; o <<= 1) v += __shfl_xor(v, o);
    return v;
}
__device__ __forceinline__ float sigmoidf_(float x) { return 1.f / (1.f + __expf(-x)); }
__device__ __forceinline__ float siluf_(float x) { return x / (1.f + __expf(-x)); }

struct Params {
    const float* in[24];
    float* out;
    unsigned char* ws;
};
enum { I_X = 0, I_C, I_CTX, I_CCTX, I_WMOD, I_BMOD, I_NAG, I_NFG, I_WIN, I_WA2, I_BA2, I_GNG, I_RPB, I_WNAO, I_WGLAO, I_WOUT,
       I_WGRP, I_BGRP, I_WEXP, I_BEXP, I_WG, I_WU, I_WD, I_FNG };

__device__ void p0_mod(const Params& p, float* lds, int blk) {
    const int tid = threadIdx.x;
    float* sc = lds;
    for (int i = tid; i < 17 * 1024; i += NT) {
        const int r = i >> 10, k = i & 1023;
        const float v = r < 16 ? p.in[I_C][r * 1024 + k] : p.in[I_CCTX][k];
        sc[i] = siluf_(v);
    }
    __syncthreads();
    const int cg4 = tid & 7, kr = tid >> 3;
    const int n0 = blk * 32 + cg4 * 4;
    float acc[17][4];
#pragma unroll
    for (int r = 0; r < 17; ++r) { acc[r][0] = 0.f; acc[r][1] = 0.f; acc[r][2] = 0.f; acc[r][3] = 0.f; }
    const float* W = p.in[I_WMOD];
#pragma unroll 2
    for (int kb = 0; kb < 1024; kb += 64) {
        const int k = kb + kr;
        const f32x4 w = *(const f32x4*)(W + (size_t)k * 6144 + n0);
#pragma unroll
        for (int r = 0; r < 17; ++r) { const float s = sc[r * 1024 + k]; acc[r][0] += s * w[0]; acc[r][1] += s * w[1]; acc[r][2] += s * w[2]; acc[r][3] += s * w[3]; }
    }
#pragma unroll
    for (int r = 0; r < 17; ++r)
#pragma unroll
        for (int j = 0; j < 4; ++j) { float v = acc[r][j]; v += __shfl_xor(v, 8); v += __shfl_xor(v, 16); v += __shfl_xor(v, 32); acc[r][j] = v; }
    __syncthreads();
    float* red = lds;
    const int wave = tid >> 6, lane = tid & 63;
    if (lane < 8) {
#pragma unroll
        for (int r = 0; r < 17; ++r)
#pragma unroll
            for (int j = 0; j < 4; ++j) red[(wave * 8 + lane) * 68 + r * 4 + j] = acc[r][j];
    }
    __syncthreads();
    float* MOD = (float*)(p.ws + WS_MOD);
    for (int i = tid; i < 8 * 68; i += NT) {
        const int c = i / 68, q = i % 68, r = q >> 2, j = q & 3;
        float s = 0.f;
#pragma unroll
        for (int w = 0; w < 8; ++w) s += red[(w * 8 + c) * 68 + q];
        const int n = blk * 32 + c * 4 + j;
        MOD[r * 6144 + n] = s + p.in[I_BMOD][n];
    }
    __syncthreads();
}

template <class ColMap>
__device__ __forceinline__ void transpose_item(const float* W, int ld, bf16_t* WT, int K, int k0, int n0, float* scr, int lane, const ColMap& cm) {
    const int sc = cm(n0 + (lane & 31));
    float tv[32];
    const float* wp = W + (size_t)(k0 + (lane >> 5)) * ld + (sc >= 0 ? sc : 0);
#pragma unroll
    for (int i = 0; i < 32; ++i) tv[i] = wp[(size_t)(2 * i) * ld];
#pragma unroll
    for (int i = 0; i < 32; ++i) { const int kk = 2 * i + (lane >> 5); scr[kk * 33 + (lane & 31)] = sc >= 0 ? tv[i] : 0.f; }
    asm volatile("s_waitcnt lgkmcnt(0)" ::: "memory");
    __builtin_amdgcn_wave_barrier();
    const int c = lane & 7;
#pragma unroll
    for (int j = 0; j < 4; ++j) { const int n = (lane >> 3) + 8 * j; const float* s = scr + (8 * c) * 33 + n;
        u32x4 o; o.x = pk2(s[0 * 33], s[1 * 33]); o.y = pk2(s[2 * 33], s[3 * 33]); o.z = pk2(s[4 * 33], s[5 * 33]); o.w = pk2(s[6 * 33], s[7 * 33]);
        *(u32x4*)(WT + (size_t)(n0 + n) * K + k0 + 8 * c) = o; }
    asm volatile("s_waitcnt lgkmcnt(0)" ::: "memory");
    __builtin_amdgcn_wave_barrier();
}
__device__ __forceinline__ int rope_perm(int pp) { const int wc = pp >> 5, n = (pp >> 4) & 1, r = pp & 15; return 64 * (wc >> 1) + 32 * n + 16 * (wc & 1) + r; }
struct CmIn { __device__ int operator()(int n) const {
    if (n < 1536) return n;
    if (n < 2560) return (n & ~127) + rope_perm(n & 127);
    if (n < 4608) return n;
    if (n < 6656) return n + 32;
    if (n < 6688) return n - 6656 + 4608;
    return -1; } };
struct CmId { __device__ int operator()(int n) const { return n; } };
struct CmGU { int which; __device__ int operator()(int n) const { const int t = n >> 8, q = n & 255; return ((q >> 7) == which) ? (128 * t + (q & 127)) : -2; } };

__device__ void p0_prep_small(const Params& p, float* lds, int gw, int ngw) {
    const int lane = threadIdx.x & 63, wave = threadIdx.x >> 6;
    float* scr = lds + wave * (64 * 33);
    constexpr int I_IN = 16 * 216, I_NAO = 8 * 32, I_GLAO = 16 * 32, I_OUT = 16 * 32;
    for (int it = gw; it < I_IN + I_NAO + I_GLAO + I_OUT; it += ngw) {
        int r = it;
        if (r < I_IN) { transpose_item(p.in[I_WIN], 6688, (bf16_t*)(p.ws + WS_WIN), 1024, 64 * (r / 216), 32 * (r % 216), scr, lane, CmIn()); continue; } r -= I_IN;
        if (r < I_NAO) { transpose_item(p.in[I_WNAO], 1024, (bf16_t*)(p.ws + WS_WNAO), 512, 64 * (r / 32), 32 * (r % 32), scr, lane, CmId()); continue; } r -= I_NAO;
        if (r < I_GLAO) { transpose_item(p.in[I_WGLAO], 1024, (bf16_t*)(p.ws + WS_WGLAO), 1024, 64 * (r / 32), 32 * (r % 32), scr, lane, CmId()); continue; } r -= I_GLAO;
        transpose_item(p.in[I_WOUT], 1024, (bf16_t*)(p.ws + WS_WOUT), 1024, 64 * (r / 32), 32 * (r % 32), scr, lane, CmId());
    }
}
__device__ void prep_experts(const Params& p, float* lds, int gw, int ngw) {
    const int lane = threadIdx.x & 63, wave = threadIdx.x >> 6;
    float* scr = lds + wave * (64 * 33);
    bf16_t* WGU = (bf16_t*)((unsigned char*)p.out + OUT_WGU);
    bf16_t* WDt = (bf16_t*)((unsigned char*)p.out + OUT_WD);
    constexpr int PER_GU = 16 * 32, PER_D = 8 * 32;
    for (int it = gw; it < NEXP * (PER_GU + PER_D); it += ngw) {
        const int e = it / (PER_GU + PER_D); int r = it % (PER_GU + PER_D);
        if (r < PER_GU) {
            const int k0 = 64 * (r / 32), n0 = 32 * (r % 32);
            const int t = n0 >> 8, q = n0 & 255, which = q >> 7;
            const float* src = (which == 0 ? p.in[I_WG] : p.in[I_WU]) + (size_t)e * 1024 * 512;
            struct Cm { int base, n0; __device__ int operator()(int n) const { return base + (n - n0); } } cm{128 * t + (q & 127), n0};
            transpose_item(src, 512, WGU + (size_t)e * 1024 * 1024, 1024, k0, n0, scr, lane, cm);
        } else {
            r -= PER_GU;
            transpose_item(p.in[I_WD] + (size_t)e * 512 * 1024, 1024, WDt + (size_t)e * 1024 * 512, 512, 64 * (r / 32), 32 * (r % 32), scr, lane, CmId());
        }
    }
}

__device__ void phase0(const Params& p, float* lds, int bid, int nb) {
    const int tid = threadIdx.x;
    if (bid == 0) {
        for (int i = tid; i < 32 * 64; i += NT) ((int*)(p.ws + WS_CTL))[i] = 0;
        f32x2* RT = (f32x2*)(p.ws + WS_ROPE);
        for (int i = tid; i < 64 * 32; i += NT) {
            const int pos = i >> 5, j = i & 31;
            const float inv = exp2f(-(float)j * 0.41524101186092029f);
            const float ang = (float)pos * inv;
            double rev = (double)ang * 0.15915494309189535; rev -= floor(rev);
            const float fr = (float)rev;
            RT[i] = (f32x2){__builtin_amdgcn_cosf(fr), __builtin_amdgcn_sinf(fr)};
        }
    }
    for (int b = bid; b < 192; b += nb) p0_mod(p, lds, b);
    p0_prep_small(p, lds, bid * 8 + (tid >> 6), nb * 8);
}

__device__ void phase1(const Params& p, int bid, int nb) {
    const int lane = threadIdx.x & 63;
    const int gw = bid * 8 + (threadIdx.x >> 6), ngw = nb * 8;
    const float* MOD = (const float*)(p.ws + WS_MOD);
    bf16_t* A1 = (bf16_t*)p.out;
    const float* G = p.in[I_NAG];
    for (int row = gw; row < TA; row += ngw) {
        const float* xr; int mr;
        if (row < TL) { xr = p.in[I_X] + (size_t)row * DM; mr = row >> 11; } else { xr = p.in[I_CTX] + (size_t)(row - TL) * DM; mr = 16; }
        f32x4 v[4]; float s = 0.f;
#pragma unroll
        for (int j = 0; j < 4; ++j) { v[j] = *(const f32x4*)(xr + 4 * lane + 256 * j); s += v[j][0] * v[j][0] + v[j][1] * v[j][1] + v[j][2] * v[j][2] + v[j][3] * v[j][3]; }
        const float rstd = rsqrtf(wave_sum(s) * (1.f / DM) + EPS);
#pragma unroll
        for (int j = 0; j < 4; ++j) {
            const int c = 4 * lane + 256 * j;
            const f32x4 g = *(const f32x4*)(G + c), sh = *(const f32x4*)(MOD + mr * 6144 + c), sc = *(const f32x4*)(MOD + mr * 6144 + 1024 + c);
            f32x4 o;
#pragma unroll
            for (int i = 0; i < 4; ++i) o[i] = (v[j][i] * rstd) * g[i] * (1.f + sc[i]) + sh[i];
            u32x2 w; w.x = pk2(o[0], o[1]); w.y = pk2(o[2], o[3]);
            *(u32x2*)(A1 + (size_t)row * DM + c) = w;
        }
    }
}


struct Unit { int pm, pn; const bf16_t* a; const bf16_t* b; int aux; int rbase, nvalid; };
namespace pg8 {
#define PG8_LAS __attribute__((address_space(3)))
constexpr int BM = 256, BK = 64, HALF = 128, HTB = HALF * BK * 2  , STAGE_BYTES = 8 * HTB;
__host__ __device__ __forceinline__ int lds_byte(int r, int c) { const int st = (r >> 4) * 2 + (c >> 5), rr = r & 15, cc = c & 31, ob = rr * 64 + cc * 2; return st * 1024 + (ob ^ (((ob >> 9) & 1) << 5)); }
__host__ __device__ __forceinline__ void stage_rc(int b, int& R, int& C) { const int st = b / 1024, sb = b % 1024, swz = sb ^ (((sb >> 9) & 1) << 5); R = (st >> 1) * 16 + swz / 64; C = (st & 1) * 32 + (swz % 64) / 2; }
__host__ __device__ __forceinline__ int perm32(int rho) { const int n = rho >> 4, i = rho & 15; return 8 * (i >> 2) + 4 * n + (i & 3); }
struct NoGather { const int* rowtok; int zero_row; };
template <class Epi, class Sched, bool ALIGN_EPI = false, bool SP2 = false, bool GATHER = false>
__device__ __forceinline__ void gemm_phase(PG8_LAS unsigned char* lds, const int Kdim, const Sched& S, const Epi& E, const NoGather G = NoGather{nullptr, 0}) {
    int tid_ = threadIdx.x; asm volatile("" : "+v"(tid_));
    const int tid = tid_, wid = __builtin_amdgcn_readfirstlane(tid >> 6), lane = tid & 63, wr = wid >> 2, wc = wid & 3, fr = lane & 15, fq = lane >> 4;
    const int K = Kdim, nt = K / BK;
    static_assert(!GATHER || SP2, "gathered A staging is wired into the two-super-phase loop only");
    unsigned voffA[2], voffB[2]; int gR[2], gC[2];
#pragma unroll
    for (int i = 0; i < 2; ++i) { int R, C; stage_rc(tid * 16 + i * 8192, R, C); const int Rb = Epi::PERM ? ((R & ~31) + perm32(R & 31)) : R;
        voffA[i] = (unsigned)(R * K + C) * 2u; voffB[i] = (unsigned)(Rb * K + C) * 2u; gR[i] = R; gC[i] = C; }
    const size_t kstep = (size_t)(BK * 2);
    const size_t hstep = (size_t)HALF * K * 2;
    const size_t tstep = 2 * hstep;
    const unsigned ldsw = (unsigned)wid * 1024u;
    const int aoff = lds_byte(wr * 64 + fr, fq * 8), boff = lds_byte(wc * 32 + fr, fq * 8);
#define PG8_SA(b, h) (((b) * 2 + (h)) * HTB)
#define PG8_SB(b, h) ((4 + (b) * 2 + (h)) * HTB)
#define PG8_STAGE(bufoff, gbase, voff) do { _Pragma("unroll") for (int _i = 0; _i < 2; ++_i) \
        __builtin_amdgcn_global_load_lds((const unsigned*)((const char*)(gbase) + (voff)[_i]), (PG8_LAS unsigned*)(lds + (bufoff) + ldsw + _i * 8192), 16, 0, 0); } while (0)
#define PG8_STAGE_A(bufoff, kbase, half, usenext) do { if constexpr (GATHER) { const bool un_ = (usenext); \
        const unsigned vs_[2] = {un_ ? aoffN[half][0] : aoffC[half][0], un_ ? aoffN[half][1] : aoffC[half][1]}; PG8_STAGE(bufoff, kbase, vs_); } \
    else { PG8_STAGE(bufoff, (kbase) + (half) * hstep, voffA); } } while (0)
#define PG8_GOFF(u_, o_) do { _Pragma("unroll") for (int h_ = 0; h_ < 2; ++h_) _Pragma("unroll") for (int i_ = 0; i_ < 2; ++i_) { \
        const int rl_ = 128 * h_ + gR[i_]; const int tk_ = rl_ < (u_).nvalid ? (G.rowtok[(u_).rbase + rl_] >> 1) : G.zero_row; \
        o_[h_][i_] = (unsigned)(tk_ * K + gC[i_]) * 2u; } } while (0)
#define PG8_LDA(dst, b, h) do { _Pragma("unroll") for (int m = 0; m < 4; ++m) _Pragma("unroll") for (int k = 0; k < 2; ++k) dst[m][k] = *(const PG8_LAS bf16x8*)(lds + PG8_SA(b, h) + aoff + m * 2048 + k * 1024); } while (0)
#define PG8_LDB(dst, b, h) do { _Pragma("unroll") for (int n = 0; n < 2; ++n) _Pragma("unroll") for (int k = 0; k < 2; ++k) dst[n][k] = *(const PG8_LAS bf16x8*)(lds + PG8_SB(b, h) + boff + n * 2048 + k * 1024); } while (0)
#define PG8_MMA(ai, bj, At, Bt) do { __builtin_amdgcn_s_setprio(1); _Pragma("unroll") for (int m = 0; m < 4; ++m) _Pragma("unroll") for (int n = 0; n < 2; ++n) _Pragma("unroll") for (int k = 0; k < 2; ++k) \
        acc[ai][bj][m][n] = __builtin_amdgcn_mfma_f32_16x16x32_bf16(Bt[n][k], At[m][k], acc[ai][bj][m][n], 0, 0, 0); __builtin_amdgcn_s_setprio(0); } while (0)
#define PG8_WAIT_V(n) asm volatile("s_waitcnt vmcnt(" #n ")" ::: "memory")
#define PG8_WAIT_L(n) asm volatile("s_waitcnt lgkmcnt(" #n ")" ::: "memory")
#define PG8_BAR __builtin_amdgcn_s_barrier()
#define PG8_SCHED __builtin_amdgcn_sched_barrier(0)
    Unit cur, nxt; int ui = 0;
    if (!S.next(0, cur)) return;
    f32x4 acc[2][2][4][2];
#pragma unroll
    for (int a = 0; a < 2; ++a)
#pragma unroll
        for (int b = 0; b < 2; ++b)
#pragma unroll
            for (int m = 0; m < 4; ++m)
#pragma unroll
                for (int n = 0; n < 2; ++n) acc[a][b][m][n] = (f32x4){0.f, 0.f, 0.f, 0.f};
    bf16x8 At[4][2], B0[2][2], B1[2][2];
    const char* cA = (const char*)cur.a; const char* cB = (const char*)cur.b;
    unsigned aoffC[2][2] = {{0u, 0u}, {0u, 0u}}, aoffN[2][2] = {{0u, 0u}, {0u, 0u}};
    if constexpr (GATHER) {
        PG8_GOFF(cur, aoffC); { Unit n1; if (S.next(1, n1)) PG8_GOFF(n1, aoffN); }
        asm volatile("s_waitcnt vmcnt(0)" ::: "memory");
    }
    S.a_ready(cur);
    if constexpr (SP2) {
        PG8_STAGE(PG8_SB(0, 0), cB, voffB); PG8_STAGE(PG8_SB(0, 1), cB + hstep, voffB); PG8_STAGE_A(PG8_SA(0, 0), cA, 0, false); PG8_STAGE_A(PG8_SA(0, 1), cA, 1, false);
        if (wr == 1) PG8_BAR;
        PG8_WAIT_V(2); PG8_BAR;
        PG8_STAGE(PG8_SB(1, 0), cB + kstep, voffB); PG8_STAGE_A(PG8_SA(1, 0), cA + kstep, 0, false); PG8_STAGE(PG8_SB(1, 1), cB + hstep + kstep, voffB);
        PG8_WAIT_V(6); PG8_BAR;
    } else {
        PG8_STAGE(PG8_SB(0, 0), cB, voffB); PG8_STAGE(PG8_SA(0, 0), cA, voffA); PG8_STAGE(PG8_SB(0, 1), cB + hstep, voffB); PG8_STAGE(PG8_SA(0, 1), cA + hstep, voffA);
        if (wr == 1) PG8_BAR;
        PG8_WAIT_V(4); PG8_BAR;
        PG8_STAGE(PG8_SB(1, 0), cB + kstep, voffB); PG8_STAGE(PG8_SA(1, 0), cA + kstep, voffA); PG8_STAGE(PG8_SB(1, 1), cB + hstep + kstep, voffB);
        PG8_WAIT_V(6); PG8_BAR;
    }
    for (;;) {
        const bool has_next = S.next(ui + 1, nxt);
        const char* nA = has_next ? (const char*)nxt.a : cA; const char* nB = has_next ? (const char*)nxt.b : cB;
        for (int t = 0; t < nt; t += 2) {
            const bool last = (t == nt - 2);
            const char* a1 = cA + (size_t)(t + 1) * kstep;
            const char* a2 = last ? nA : cA + (size_t)(t + 2) * kstep; const char* b2 = last ? nB : cB + (size_t)(t + 2) * kstep;
            const char* a3 = a2 + kstep; const char* b3 = b2 + kstep;
            if (last && has_next) S.a_ready(nxt);
            if constexpr (SP2) {
            PG8_LDB(B0, 0, 0); PG8_LDB(B1, 0, 1); PG8_SCHED; PG8_LDA(At, 0, 0); PG8_STAGE_A(PG8_SA(1, 1), a1, 1, false);
            PG8_WAIT_V(8); PG8_WAIT_L(0); PG8_BAR; PG8_MMA(0, 0, At, B0); PG8_MMA(0, 1, At, B1); PG8_BAR; PG8_SCHED;
            PG8_LDA(At, 0, 1); PG8_STAGE(PG8_SB(0, 0), b2, voffB); PG8_STAGE(PG8_SB(0, 1), b2 + hstep, voffB); PG8_STAGE_A(PG8_SA(0, 0), a2, 0, last && has_next);
            PG8_WAIT_V(8); PG8_WAIT_L(0); PG8_BAR; PG8_MMA(1, 0, At, B0); PG8_MMA(1, 1, At, B1); PG8_BAR; PG8_SCHED;
            PG8_LDB(B0, 1, 0); PG8_LDB(B1, 1, 1); PG8_SCHED; PG8_LDA(At, 1, 0); PG8_STAGE_A(PG8_SA(0, 1), a2, 1, last && has_next);
            PG8_WAIT_V(8); PG8_WAIT_L(0); PG8_BAR; PG8_MMA(0, 0, At, B0); PG8_MMA(0, 1, At, B1); PG8_BAR; PG8_SCHED;
            PG8_LDA(At, 1, 1); PG8_STAGE(PG8_SB(1, 0), b3, voffB); PG8_STAGE(PG8_SB(1, 1), b3 + hstep, voffB); PG8_STAGE_A(PG8_SA(1, 0), a3, 0, last && has_next);
            PG8_WAIT_V(8); PG8_WAIT_L(0); PG8_BAR; PG8_MMA(1, 0, At, B0); PG8_MMA(1, 1, At, B1); PG8_BAR; PG8_SCHED;
            } else {
            PG8_LDB(B0, 0, 0); PG8_SCHED; PG8_LDA(At, 0, 0); PG8_STAGE(PG8_SA(1, 1), a1 + hstep, voffA);
            PG8_WAIT_L(8); PG8_BAR; PG8_WAIT_L(0); PG8_MMA(0, 0, At, B0); PG8_BAR; PG8_SCHED;
            PG8_LDB(B1, 0, 1); PG8_STAGE(PG8_SB(0, 0), b2, voffB);
            PG8_BAR; PG8_WAIT_L(0); PG8_MMA(0, 1, At, B1); PG8_BAR;
            PG8_LDA(At, 0, 1); PG8_STAGE(PG8_SA(0, 0), a2, voffA);
            PG8_BAR; PG8_WAIT_L(0); PG8_MMA(1, 0, At, B0); PG8_BAR; PG8_SCHED;
            PG8_STAGE(PG8_SB(0, 1), b2 + hstep, voffB);
            PG8_WAIT_V(6); PG8_BAR; PG8_MMA(1, 1, At, B1); PG8_BAR;
            PG8_LDB(B0, 1, 0); PG8_SCHED; PG8_LDA(At, 1, 0); PG8_STAGE(PG8_SA(0, 1), a2 + hstep, voffA);
            PG8_WAIT_L(8); PG8_BAR; PG8_WAIT_L(0); PG8_MMA(0, 0, At, B0); PG8_BAR; PG8_SCHED;
            PG8_LDB(B1, 1, 1); PG8_STAGE(PG8_SB(1, 0), b3, voffB);
            PG8_BAR; PG8_WAIT_L(0); PG8_MMA(0, 1, At, B1); PG8_BAR;
            PG8_LDA(At, 1, 1); PG8_STAGE(PG8_SA(1, 0), a3, voffA);
            PG8_BAR; PG8_WAIT_L(0); PG8_MMA(1, 0, At, B0); PG8_BAR; PG8_SCHED;
            PG8_STAGE(PG8_SB(1, 1), b3 + hstep, voffB);
            PG8_WAIT_V(6); PG8_BAR; PG8_MMA(1, 1, At, B1); PG8_BAR;
            }
        }
        if constexpr (ALIGN_EPI) { if (wr == 0) PG8_BAR; }
        if constexpr (!Epi::AFTER_DRAIN) { E(acc, cur, wr, wc, fr, fq); S.done(cur); }
        if (!has_next) break;
#pragma unroll
        for (int a = 0; a < 2; ++a)
#pragma unroll
            for (int b = 0; b < 2; ++b)
#pragma unroll
                for (int m = 0; m < 4; ++m)
#pragma unroll
                    for (int n = 0; n < 2; ++n) acc[a][b][m][n] = (f32x4){0.f, 0.f, 0.f, 0.f};
        cur = nxt; cA = nA; cB = nB; ++ui;
        if constexpr (GATHER) {
#pragma unroll
            for (int h_ = 0; h_ < 2; ++h_) { aoffC[h_][0] = aoffN[h_][0]; aoffC[h_][1] = aoffN[h_][1]; }
            { Unit n2; if (S.next(ui + 1, n2)) PG8_GOFF(n2, aoffN); }
            asm volatile("s_waitcnt vmcnt(0)" ::: "memory");
        }
        if constexpr (ALIGN_EPI) { if (wr == 1) PG8_BAR; }
    }
    PG8_WAIT_V(0);
    if constexpr (!ALIGN_EPI) { if (wr == 0) PG8_BAR; }
    PG8_BAR;
    if constexpr (Epi::AFTER_DRAIN) { E.fused(acc, cur, wr, wc, fr, fq, lds, wid, lane); S.done(cur); }
#undef PG8_SA
#undef PG8_SB
#undef PG8_STAGE
#undef PG8_LDA
#undef PG8_STAGE_A
#undef PG8_GOFF
#undef PG8_LDB
#undef PG8_MMA
#undef PG8_WAIT_V
#undef PG8_WAIT_L
#undef PG8_BAR
#undef PG8_SCHED
}

}

struct SchedIn {
    __device__ __forceinline__ void a_ready(const Unit&) const {}
    __device__ __forceinline__ void done(const Unit&) const {}
    const bf16_t* A; const bf16_t* Bt; int G, c;
    __device__ bool next(int i, Unit& u) const {
        const int L = i * G + c;
        constexpr int NLAT = 128 * 27, NCTX = 16 * 11;
        if (L >= NLAT + NCTX) return false;
        if (L < NLAT) {
            const int w = (L & 7) * (NLAT / 8) + (L >> 3), gid = w / 216, rem = w % 216;
            u.pm = gid * 8 + (rem & 7); u.pn = rem >> 3; }
        else { const int q = L - NLAT; const int j = q % 11; u.pm = 128 + q / 11; u.pn = j < 4 ? 2 + j : (j < 10 ? 8 + (j - 4) : 26); }
        u.a = A + (size_t)u.pm * 256 * 1024; u.b = Bt + (size_t)u.pn * 256 * 1024; u.aux = 0; u.rbase = 0; u.nvalid = 0;
        return true;
    }
};
struct EpiIn {
    static constexpr bool PERM = false, AFTER_DRAIN = false;
    unsigned char* ws_;
    __device__ __forceinline__ void operator()(const f32x4 (&acc)[2][2][4][2], const Unit& u, int wr, int wc, int fr, int fq) const {
        unsigned zoff = 0; asm volatile("" : "+s"(zoff)); unsigned char* ws = ws_ + zoff;
        const int pn = u.pn;
        const int row0 = u.pm * 256 + wr * 64 + fr;
        if (pn == 26) {
            float* ALR = (float*)(ws + WS_ALR);
            if (wc == 0) {
#pragma unroll
                for (int ai = 0; ai < 2; ++ai)
#pragma unroll
                    for (int m = 0; m < 4; ++m) { const int row = row0 + ai * 128 + m * 16;
#pragma unroll
                        for (int n = 0; n < 2; ++n) *(f32x4*)(ALR + (size_t)row * 32 + 16 * n + 4 * fq) = acc[ai][0][m][n]; }
            }
            return;
        }
        if (pn >= 6 && pn < 10) {
            const bool isq = pn < 8;
            bf16_t* dst = (bf16_t*)(ws + (isq ? WS_QG : WS_KG));
            const float scale = isq ? 0.08838834764831845f : 1.0f;
            const f32x2* RT = (const f32x2*)(ws + WS_ROPE);
            const int half = wc >> 1, j0 = 16 * (wc & 1) + 4 * fq;
#pragma unroll
            for (int ai = 0; ai < 2; ++ai)
#pragma unroll
                for (int m = 0; m < 4; ++m) { const int row = row0 + ai * 128 + m * 16;
                    const bool lat = row < TL; const int t = row & 2047; const int pos = lat ? (half == 0 ? (t >> 6) : (t & 63)) : 0;
                    float cs[4], sn[4];
                    { const f32x4 va = *(const f32x4*)(RT + pos * 32 + j0), vb = *(const f32x4*)(RT + pos * 32 + j0 + 2);
                      cs[0] = va[0]; sn[0] = va[1]; cs[1] = va[2]; sn[1] = va[3]; cs[2] = vb[0]; sn[2] = vb[1]; cs[3] = vb[2]; sn[3] = vb[3]; }
#pragma unroll
                    for (int bj = 0; bj < 2; ++bj) {
                        const int head = (pn & 1) * 2 + bj;
                        const f32x4 x1 = acc[ai][bj][m][0] * scale, x2 = acc[ai][bj][m][1] * scale;
                        float o1[4], o2[4];
#pragma unroll
                        for (int i = 0; i < 4; ++i) { o1[i] = x1[i] * cs[i] - x2[i] * sn[i]; o2[i] = x1[i] * sn[i] + x2[i] * cs[i]; }
                        bf16_t* rp = dst + (size_t)row * 512 + head * 128 + 64 * half + j0;
                        u32x2 w1, w2; w1.x = pk2(o1[0], o1[1]); w1.y = pk2(o1[2], o1[3]); w2.x = pk2(o2[0], o2[1]); w2.y = pk2(o2[2], o2[3]);
                        *(u32x2*)rp = w1; *(u32x2*)(rp + 32) = w2;
                    }
                    asm volatile("" ::: "memory"); }
            return;
        }
        if (pn == 4 || pn == 5) {
            bf16_t* VT = (bf16_t*)(ws + WS_VN);
#pragma unroll
            for (int ai = 0; ai < 2; ++ai)
#pragma unroll
                for (int m = 0; m < 4; ++m) { const int row = row0 + ai * 128 + m * 16;
                    size_t base; int ldt;
                    if (row < TL) { base = (size_t)(row >> 11) * 512 * 2048 + (row & 2047); ldt = 2048; }
                    else { const int rc = row - TL; base = (size_t)32 * MiB / 2 + (size_t)(rc >> 8) * 512 * 256 + (rc & 255); ldt = 256; }
#pragma unroll
                    for (int bj = 0; bj < 2; ++bj)
#pragma unroll
                        for (int n = 0; n < 2; ++n) { const int c = (pn - 4) * 256 + bj * 128 + wc * 32 + n * 16 + 4 * fq;
#pragma unroll
                            for (int i = 0; i < 4; ++i) VT[base + (size_t)(c + i) * ldt] = (bf16_t)f2bf(acc[ai][bj][m][n][i]); }
                    asm volatile("" ::: "memory"); }
            return;
        }
        bf16_t* dst; int ld, cbase; float scale = 1.f;
        if (pn < 2) { dst = (bf16_t*)(ws + WS_QN); ld = 512; cbase = pn * 256; scale = 0.125f; }
        else if (pn < 4) { dst = (bf16_t*)(ws + WS_KN); ld = 512; cbase = (pn - 2) * 256; }
        else if (pn < 14) { dst = (bf16_t*)(ws + WS_VG); ld = 1024; cbase = (pn - 10) * 256; }
        else if (pn < 18) { dst = (bf16_t*)(ws + WS_GG); ld = 1024; cbase = (pn - 14) * 256; }
        else if (pn < 22) { dst = (bf16_t*)(ws + WS_M8); ld = 1024; cbase = (pn - 18) * 256; }
        else { dst = (bf16_t*)(ws + WS_M9); ld = 1024; cbase = (pn - 22) * 256; }
#pragma unroll
        for (int ai = 0; ai < 2; ++ai)
#pragma unroll
            for (int m = 0; m < 4; ++m) { bf16_t* rp = dst + (size_t)(row0 + ai * 128 + m * 16) * ld + cbase + wc * 32 + 4 * fq;
#pragma unroll
                for (int bj = 0; bj < 2; ++bj)
#pragma unroll
                    for (int n = 0; n < 2; ++n) { const f32x4 v = acc[ai][bj][m][n] * scale; u32x2 w; w.x = pk2(v[0], v[1]); w.y = pk2(v[2], v[3]);
                        *(u32x2*)(rp + bj * 128 + n * 16) = w; } }
    }
};

constexpr int NL_K = 0;
constexpr int NL_VT = 36864;
constexpr int NL_RPB = 70656;
constexpr int NL_KW = 72704;
__device__ __forceinline__ int na_swz(int col) { return (((col >> 3) & 3) << 1) | ((col >> 1) & 1); }
__device__ void na_item(const Params& p, unsigned char* ldsg, int b, int r, int j, int h, int rsb) {
    const int lane = threadIdx.x & 63, l15 = lane & 15, q4 = lane >> 4;
    unsigned lzo = 0; asm volatile("" : "+v"(lzo));
    const unsigned char __attribute__((address_space(3)))* lds = (const unsigned char __attribute__((address_space(3)))*)ldsg + lzo;
    b = __builtin_amdgcn_readfirstlane(b); r = __builtin_amdgcn_readfirstlane(r); j = __builtin_amdgcn_readfirstlane(j); h = __builtin_amdgcn_readfirstlane(h); rsb = __builtin_amdgcn_readfirstlane(rsb);
    const bf16_t* QN = (const bf16_t*)(p.ws + WS_QN); const bf16_t* KN = (const bf16_t*)(p.ws + WS_KN);
    const bf16_t* VT = (const bf16_t*)(p.ws + WS_VN);
    const int rs = min(max(r - 4, 0), 24), kc0 = min(max(16 * j - 8, 0), 32);
    const int qc = 16 * j + l15, cs = min(max(qc - 8, 0), 48);
    const int qtok = b * SEQ + r * GW + qc;
    bf16x8 qf[2];
    qf[0] = *(const bf16x8*)(QN + (size_t)qtok * 512 + h * 64 + 8 * q4);
    qf[1] = *(const bf16x8*)(QN + (size_t)qtok * 512 + h * 64 + 32 + 8 * q4);
    const float __attribute__((address_space(3)))* rp = (const float __attribute__((address_space(3)))*)(lds + NL_RPB);
    const int kid = 8 * (l15 >> 2) + (l15 & 3);
    const auto krs = __builtin_amdgcn_make_buffer_rsrc((void*)KN, 0, TA * 512 * 2, 0x00020000);
    const auto vrs = __builtin_amdgcn_make_buffer_rsrc((void*)VT, 0, TA * 512 * 2, 0x00020000);
    const unsigned kwin = (unsigned)((b * SEQ + rs * GW + kc0) * 512 + h * 64) * 2u;
    const unsigned klane = (unsigned)(kid * 512 + 8 * q4) * 2u;
    const unsigned vth = (unsigned)(((b * 8 + h) * 64) * 2048 + rs * GW + kc0) * 2u;
    const unsigned vlw = (unsigned)(l15 * 2048 + 8 * q4) * 2u;
    bf16x8 fb[2][8];
    f32x4 sc[16];
    f32x4 o[4];
#pragma unroll
    for (int dt = 0; dt < 4; ++dt) o[dt] = (f32x4){0.f, 0.f, 0.f, 0.f};
#define NA_LOAD(n_) do { constexpr int n = (n_); constexpr int bq = n & 3; constexpr bool isv = (n & 4) != 0, isc = n >= 8; \
        if (!isv) { _Pragma("unroll") for (int u = 0; u < 4; ++u) { const int ti = bq * 4 + u, g = ti >> 1, T = ti & 1; \
            if (isc) { fb[n & 1][2 * u] = *(const __attribute__((address_space(3))) bf16x8*)(lds + NL_K + (32 * g + 4 * T + kid) * 144 + q4 * 16); \
                       fb[n & 1][2 * u + 1] = *(const __attribute__((address_space(3))) bf16x8*)(lds + NL_K + (32 * g + 4 * T + kid) * 144 + q4 * 16 + 64); } \
            else { const int col_ = kc0 + 4 * T + kid, fx_ = na_swz(col_); const int ro_ = NL_KW + ((rs - rsb + g) * 64 + col_) * 128; \
                fb[n & 1][2 * u] = *(const __attribute__((address_space(3))) bf16x8*)(lds + ro_ + ((q4 ^ fx_) * 16)); \
                fb[n & 1][2 * u + 1] = *(const __attribute__((address_space(3))) bf16x8*)(lds + ro_ + (((q4 + 4) ^ fx_) * 16)); } } } \
        else { _Pragma("unroll") for (int u = 0; u < 2; ++u) { const int ks = bq * 2 + u; _Pragma("unroll") for (int dt = 0; dt < 4; ++dt) \
            { if (isc) fb[n & 1][4 * u + dt] = *(const __attribute__((address_space(3))) bf16x8*)(lds + NL_VT + (16 * dt + l15) * 528 + (32 * ks + 8 * q4) * 2); \
              else fb[n & 1][4 * u + dt] = __builtin_bit_cast(bf16x8, __builtin_amdgcn_raw_buffer_load_b128(vrs, vlw, vth + (unsigned)((16 * dt) * 2048 + ks * GW) * 2u, 0)); } } } } while (0)
#define NA_QK(n_) do { constexpr int n = (n_); constexpr int bq = n & 3; constexpr bool isc = n >= 8; \
        _Pragma("unroll") for (int u = 0; u < 4; ++u) { const int ti = bq * 4 + u; \
            f32x4 acc = (f32x4){0.f, 0.f, 0.f, 0.f}; \
            acc = __builtin_amdgcn_mfma_f32_16x16x32_bf16(fb[n & 1][2 * u], qf[0], acc, 0, 0, 0); \
            acc = __builtin_amdgcn_mfma_f32_16x16x32_bf16(fb[n & 1][2 * u + 1], qf[1], acc, 0, 0, 0); \
            if (!isc) { const int i = ti >> 1, T = ti & 1, ri = rs + i - r + 7; \
                _Pragma("unroll") for (int e = 0; e < 4; ++e) { const int kcol = kc0 + 8 * q4 + 4 * T + e; const bool valid = kcol >= cs && kcol < cs + 16; \
                    const int ci = min(max(kcol - qc + 15, 0), 30); acc[e] = valid ? acc[e] + rp[ri * 31 + ci] : -1e30f; } } \
            sc[ti] = acc; } } while (0)
#define NA_PV(n_) do { constexpr int n = (n_); constexpr int bq = n & 3; \
        _Pragma("unroll") for (int u = 0; u < 2; ++u) { const int ks = bq * 2 + u; \
            u32x4 bw; bw.x = pk2(sc[2 * ks][0], sc[2 * ks][1]); bw.y = pk2(sc[2 * ks][2], sc[2 * ks][3]); bw.z = pk2(sc[2 * ks + 1][0], sc[2 * ks + 1][1]); bw.w = pk2(sc[2 * ks + 1][2], sc[2 * ks + 1][3]); \
            const bf16x8 B = __builtin_bit_cast(bf16x8, bw); \
            _Pragma("unroll") for (int dt = 0; dt < 4; ++dt) o[dt] = __builtin_amdgcn_mfma_f32_16x16x32_bf16(fb[n & 1][4 * u + dt], B, o[dt], 0, 0, 0); } } while (0)
    NA_LOAD(0);
    NA_LOAD(1); NA_QK(0);
    NA_LOAD(2); NA_QK(1);
    NA_LOAD(3); NA_QK(2);
    NA_LOAD(4); NA_QK(3);
    float m1 = -1e30f;
#pragma unroll
    for (int ti = 0; ti < 16; ++ti) m1 = fmaxf(fmaxf(fmaxf(m1, sc[ti][0]), fmaxf(sc[ti][1], sc[ti][2])), sc[ti][3]);
    m1 = fmaxf(m1, __shfl_xor(m1, 16)); m1 = fmaxf(m1, __shfl_xor(m1, 32));
    float l = 0.f;
#pragma unroll
    for (int ti = 0; ti < 16; ++ti) {
#pragma unroll
        for (int e = 0; e < 4; ++e) { const float pe = __expf(sc[ti][e] - m1); sc[ti][e] = pe; l += pe; }
    }
    NA_LOAD(5); NA_PV(4);
    NA_LOAD(6); NA_PV(5);
    NA_LOAD(7); NA_PV(6);
    NA_LOAD(8); NA_PV(7);
    NA_LOAD(9); NA_QK(8);
    NA_LOAD(10); NA_QK(9);
    NA_LOAD(11); NA_QK(10);
    NA_LOAD(12); NA_QK(11);
    float m2 = -1e30f;
#pragma unroll
    for (int ti = 0; ti < 16; ++ti) m2 = fmaxf(fmaxf(fmaxf(m2, sc[ti][0]), fmaxf(sc[ti][1], sc[ti][2])), sc[ti][3]);
    m2 = fmaxf(m2, __shfl_xor(m2, 16)); m2 = fmaxf(m2, __shfl_xor(m2, 32));
    const float mm = fmaxf(m1, m2), al = __expf(m1 - mm);
    l *= al;
#pragma unroll
    for (int dt = 0; dt < 4; ++dt) o[dt] = o[dt] * al;
#pragma unroll
    for (int ti = 0; ti < 16; ++ti) {
#pragma unroll
        for (int e = 0; e < 4; ++e) { const float pe = __expf(sc[ti][e] - mm); sc[ti][e] = pe; l += pe; }
    }
    NA_LOAD(13); NA_PV(12);
    NA_LOAD(14); NA_PV(13);
    NA_LOAD(15); NA_PV(14);
    NA_PV(15);
#undef NA_LOAD
#undef NA_QK
#undef NA_PV
    l += __shfl_xor(l, 16); l += __shfl_xor(l, 32);
    const float il = 1.f / l;
    bf16_t* ONA = (bf16_t*)(p.ws + WS_ONA);
#pragma unroll
    for (int dt = 0; dt < 4; ++dt) { u32x2 w; w.x = pk2(o[dt][0] * il, o[dt][1] * il); w.y = pk2(o[dt][2] * il, o[dt][3] * il);
        *(u32x2*)(ONA + (size_t)qtok * 512 + h * 64 + 16 * dt + 4 * q4) = w; }
}

#ifndef LAS
#define LAS __attribute__((address_space(3)))
#endif
constexpr int GL_Q = 0;
constexpr int GL_K = 17408;
constexpr int GL_KT = 34816;
constexpr int GL_VR = 53248;
constexpr int GL_VT = 69632;
constexpr int GL_ATT = 88064;
constexpr int GL_O = 97280;
constexpr int GL_ALR = 114688;
constexpr int GL_SEG = 118784;
constexpr int GL_D = 120832;
__device__ __forceinline__ int gla_row0(int b, int dir, int n) {
    if (n < 4) return TL + b * CTX + (dir == 0 ? n : 3 - n) * 64;
    return b * SEQ + (dir == 0 ? n - 4 : 35 - n) * 64;
}
__device__ void gla_chain(const Params& p, unsigned char* ldsg, int item) {
    LAS unsigned char* lds = (LAS unsigned char*)ldsg;
    const int tid = threadIdx.x, lane = tid & 63, wave = tid >> 6;
    const int slice = item & 1, dir = (item >> 1) & 1, h = (item >> 2) & 3, b = item >> 4;
    const int d_ = tid & 127, seg = tid >> 7, l15 = lane & 15, q4 = lane >> 4;
    const bf16_t* QG = (const bf16_t*)(p.ws + WS_QG); const bf16_t* KG = (const bf16_t*)(p.ws + WS_KG); const bf16_t* VG = (const bf16_t*)(p.ws + WS_VG);
    const float* ALR = (const float*)(p.ws + WS_ALR);
    bf16_t* OX = (bf16_t*)((unsigned char*)p.out + (dir == 0 ? 0 : (size_t)64 * MiB));
    float w2[16];
#pragma unroll
    for (int r = 0; r < 16; ++r) w2[r] = p.in[I_WA2][(dir * 16 + r) * 512 + h * 128 + d_];
    const float b2 = p.in[I_BA2][dir * 512 + h * 128 + d_];
    f32x4 S[8];
#pragma unroll
    for (int i = 0; i < 8; ++i) S[i] = (f32x4){0.f, 0.f, 0.f, 0.f};
    u32x4 pq[2], pk[2], pv[2], pa;
    {
        const int r0 = gla_row0(b, dir, 0);
#pragma unroll
        for (int j = 0; j < 2; ++j) { const int c = tid + 512 * j, row = c >> 4, c16 = c & 15;
            pq[j] = (u32x4){0u, 0u, 0u, 0u};
            pk[j] = *(const u32x4*)(KG + (size_t)(r0 + row) * 512 + h * 128 + c16 * 8);
            pv[j] = *(const u32x4*)(VG + (size_t)(r0 + row) * 1024 + h * 256 + slice * 128 + c16 * 8); }
        pa = (u32x4){0u, 0u, 0u, 0u};
        if (tid < 256) pa = *(const u32x4*)(ALR + (size_t)(r0 + (tid >> 2)) * 32 + dir * 16 + (tid & 3) * 4);
    }
    for (int n = 0; n < 36; ++n) {
        const bool lat = n >= 4;
        const int r0 = gla_row0(b, dir, n);
#pragma unroll
        for (int j = 0; j < 2; ++j) { const int c = tid + 512 * j, row = c >> 4, c16 = c & 15;
            *(LAS u32x4*)(lds + GL_Q + row * 272 + c16 * 16) = pq[j];
            *(LAS u32x4*)(lds + GL_K + row * 272 + c16 * 16) = pk[j];
            *(LAS u32x4*)(lds + GL_VR + row * 256 + c16 * 16) = pv[j]; }
        if (tid < 256) *(LAS u32x4*)(lds + GL_ALR + (tid >> 2) * 64 + (tid & 3) * 16) = pa;
        if (n + 1 < 36) {
            const int r1 = gla_row0(b, dir, n + 1); const bool lat1 = n + 1 >= 4;
#pragma unroll
            for (int j = 0; j < 2; ++j) { const int c = tid + 512 * j, row = c >> 4, c16 = c & 15;
                if (lat1) pq[j] = *(const u32x4*)(QG + (size_t)(r1 + row) * 512 + h * 128 + c16 * 8);
                pk[j] = *(const u32x4*)(KG + (size_t)(r1 + row) * 512 + h * 128 + c16 * 8);
                pv[j] = *(const u32x4*)(VG + (size_t)(r1 + row) * 1024 + h * 256 + slice * 128 + c16 * 8); }
            if (tid < 256) pa = *(const u32x4*)(ALR + (size_t)(r1 + (tid >> 2)) * 32 + dir * 16 + (tid & 3) * 4);
        }
        __syncthreads();
        float g[16];
#pragma unroll
        for (int i = 0; i < 16; ++i) {
            const int t = 16 * seg + i;
            float z = b2;
#pragma unroll
            for (int r4 = 0; r4 < 4; ++r4) { const f32x4 a = *(const LAS f32x4*)(lds + GL_ALR + t * 64 + r4 * 16);
                z += a[0] * w2[4 * r4] + a[1] * w2[4 * r4 + 1] + a[2] * w2[4 * r4 + 2] + a[3] * w2[4 * r4 + 3]; }
            const float ls = fminf(z, 0.f) - __logf(1.f + __expf(-fabsf(z)));
            g[i] = ls * (1.f / 16.f);
        }
        if (dir == 0) {
#pragma unroll
            for (int i = 1; i < 16; ++i) g[i] += g[i - 1];
        } else {
#pragma unroll
            for (int i = 14; i >= 0; --i) g[i] += g[i + 1];
        }
        *(LAS float*)(lds + GL_SEG + (seg * 128 + d_) * 4) = dir == 0 ? g[15] : g[0];
        __syncthreads();
        {
            const float s0 = *(const LAS float*)(lds + GL_SEG + (0 * 128 + d_) * 4), s1 = *(const LAS float*)(lds + GL_SEG + (1 * 128 + d_) * 4),
                        s2 = *(const LAS float*)(lds + GL_SEG + (2 * 128 + d_) * 4), s3 = *(const LAS float*)(lds + GL_SEG + (3 * 128 + d_) * 4);
            float off;
            if (dir == 0) off = (seg > 0 ? s0 : 0.f) + (seg > 1 ? s1 : 0.f) + (seg > 2 ? s2 : 0.f);
            else off = (seg < 1 ? s1 : 0.f) + (seg < 2 ? s2 : 0.f) + (seg < 3 ? s3 : 0.f);
            if (seg == 0) *(LAS float*)(lds + GL_D + d_ * 4) = __expf((s0 + s1) + (s2 + s3));
            unsigned kt[8], vt[8];
#pragma unroll
            for (int i = 0; i < 16; ++i) {
                const int t = 16 * seg + i;
                const float bb = g[i] + off, e1 = __expf(bb), e2 = __builtin_amdgcn_rcpf(e1);
                if (lat) { LAS unsigned short* qp = (LAS unsigned short*)(lds + GL_Q + t * 272 + d_ * 2); *qp = (unsigned short)f2bf(bf2f(*qp) * e1); }
                LAS unsigned short* kp = (LAS unsigned short*)(lds + GL_K + t * 272 + d_ * 2);
                const unsigned kb = f2bf(bf2f(*kp) * e2);
                if (lat) *kp = (unsigned short)kb;
                const unsigned vb = *(const LAS unsigned short*)(lds + GL_VR + t * 256 + d_ * 2);
                if (i & 1) { kt[i >> 1] |= kb << 16; vt[i >> 1] |= vb << 16; } else { kt[i >> 1] = kb; vt[i >> 1] = vb; }
            }
            *(LAS u32x4*)(lds + GL_KT + d_ * 144 + seg * 32) = (u32x4){kt[0], kt[1], kt[2], kt[3]};
            *(LAS u32x4*)(lds + GL_KT + d_ * 144 + seg * 32 + 16) = (u32x4){kt[4], kt[5], kt[6], kt[7]};
            *(LAS u32x4*)(lds + GL_VT + d_ * 144 + seg * 32) = (u32x4){vt[0], vt[1], vt[2], vt[3]};
            *(LAS u32x4*)(lds + GL_VT + d_ * 144 + seg * 32 + 16) = (u32x4){vt[4], vt[5], vt[6], vt[7]};
        }
        __syncthreads();
        if (lat) {
            const int tt = wave >> 1, ss0 = (wave & 1) * 2;
            f32x4 a0 = (f32x4){0.f, 0.f, 0.f, 0.f}, a1 = (f32x4){0.f, 0.f, 0.f, 0.f};
#pragma unroll
            for (int kk = 0; kk < 4; ++kk) {
                const bf16x8 A = *(const LAS bf16x8*)(lds + GL_Q + (16 * tt + l15) * 272 + (32 * kk + 8 * q4) * 2);
                const bf16x8 B0 = *(const LAS bf16x8*)(lds + GL_K + (16 * ss0 + l15) * 272 + (32 * kk + 8 * q4) * 2);
                const bf16x8 B1 = *(const LAS bf16x8*)(lds + GL_K + (16 * (ss0 + 1) + l15) * 272 + (32 * kk + 8 * q4) * 2);
                a0 = __builtin_amdgcn_mfma_f32_16x16x32_bf16(A, B0, a0, 0, 0, 0);
                a1 = __builtin_amdgcn_mfma_f32_16x16x32_bf16(A, B1, a1, 0, 0, 0);
            }
#pragma unroll
            for (int r = 0; r < 4; ++r) {
                const int t = 16 * tt + 4 * q4 + r, sA = 16 * ss0 + l15, sB = sA + 16;
                const bool kA = dir == 0 ? (sA <= t) : (sA >= t), kB = dir == 0 ? (sB <= t) : (sB >= t);
                *(LAS unsigned short*)(lds + GL_ATT + t * 144 + sA * 2) = (unsigned short)f2bf(kA ? a0[r] : 0.f);
                *(LAS unsigned short*)(lds + GL_ATT + t * 144 + sB * 2) = (unsigned short)f2bf(kB ? a1[r] : 0.f);
            }
        }
        __syncthreads();
        {
            bf16x8 vB[2];
#pragma unroll
            for (int kk = 0; kk < 2; ++kk) vB[kk] = *(const LAS bf16x8*)(lds + GL_VT + (16 * wave + l15) * 144 + (32 * kk + 8 * q4) * 2);
            if (lat) {
                f32x4 o[4];
#pragma unroll
                for (int tt = 0; tt < 4; ++tt) o[tt] = (f32x4){0.f, 0.f, 0.f, 0.f};
#pragma unroll
                for (int tt = 0; tt < 4; ++tt)
#pragma unroll
                    for (int kk = 0; kk < 2; ++kk) { const bf16x8 A = *(const LAS bf16x8*)(lds + GL_ATT + (16 * tt + l15) * 144 + (32 * kk + 8 * q4) * 2);
                        o[tt] = __builtin_amdgcn_mfma_f32_16x16x32_bf16(A, vB[kk], o[tt], 0, 0, 0); }
#pragma unroll
                for (int kk = 0; kk < 4; ++kk) {
                    const f32x4 sa = S[2 * kk], sb = S[2 * kk + 1];
                    u32x4 bw; bw.x = pk2(sa[0], sa[1]); bw.y = pk2(sa[2], sa[3]); bw.z = pk2(sb[0], sb[1]); bw.w = pk2(sb[2], sb[3]);
                    const bf16x8 Bs = __builtin_bit_cast(bf16x8, bw);
#pragma unroll
                    for (int tt = 0; tt < 4; ++tt) {
                        const u32x2 lo = *(const LAS u32x2*)(lds + GL_Q + (16 * tt + l15) * 272 + (32 * kk + 4 * q4) * 2);
                        const u32x2 hi = *(const LAS u32x2*)(lds + GL_Q + (16 * tt + l15) * 272 + (32 * kk + 16 + 4 * q4) * 2);
                        const bf16x8 A = __builtin_bit_cast(bf16x8, (u32x4){lo.x, lo.y, hi.x, hi.y});
                        o[tt] = __builtin_amdgcn_mfma_f32_16x16x32_bf16(A, Bs, o[tt], 0, 0, 0);
                    }
                }
#pragma unroll
                for (int tt = 0; tt < 4; ++tt)
#pragma unroll
                    for (int r = 0; r < 4; ++r) *(LAS unsigned short*)(lds + GL_O + (16 * tt + 4 * q4 + r) * 272 + (16 * wave + l15) * 2) = (unsigned short)f2bf(o[tt][r]);
            }
#pragma unroll
            for (int dt = 0; dt < 8; ++dt) {
#pragma unroll
                for (int kk = 0; kk < 2; ++kk) { const bf16x8 A = *(const LAS bf16x8*)(lds + GL_KT + (16 * dt + l15) * 144 + (32 * kk + 8 * q4) * 2);
                    S[dt] = __builtin_amdgcn_mfma_f32_16x16x32_bf16(A, vB[kk], S[dt], 0, 0, 0); }
                const f32x4 Dv = *(const LAS f32x4*)(lds + GL_D + (16 * dt + 4 * q4) * 4);
                S[dt] = S[dt] * Dv;
            }
        }
        __syncthreads();
        if (lat) {
#pragma unroll
            for (int j = 0; j < 2; ++j) { const int c = tid + 512 * j, row = c >> 4, c16 = c & 15;
                const u32x4 v = *(const LAS u32x4*)(lds + GL_O + row * 272 + c16 * 16);
                *(u32x4*)(OX + (size_t)(r0 + row) * 1024 + h * 256 + slice * 128 + c16 * 8) = v; }
        }
    }
    __syncthreads();
}

__device__ void phase3(const Params& p, unsigned char* lds, int bid, int nb) {
    for (int it = bid; it < 256; it += nb) gla_chain(p, lds, it);
    {
        const bool xm = (nb & 7) == 0;
        const int wv = __builtin_amdgcn_readfirstlane(threadIdx.x >> 6), tid = threadIdx.x;
        const int s0 = xm ? (bid >> 3) : bid, ds = xm ? (nb >> 3) : nb, smax = xm ? 32 : 256;
        const bf16_t* KN = (const bf16_t*)(p.ws + WS_KN); const bf16_t* VTC = (const bf16_t*)(p.ws + WS_VN) + (size_t)32 * MiB / 2;
        const float* RPB = p.in[I_RPB];
        for (int sl = s0; sl < smax; sl += ds) {
            const int slab = xm ? ((((bid & 7) + 8 * (sl >> 4)) << 4) | (sl & 15)) : sl;
            const int b = slab >> 4, h = (slab >> 1) & 7, half = slab & 1;
            __syncthreads();
            int tl = tid; asm volatile("" : "+v"(tl));
#pragma unroll
            for (int q = 0; q < 4; ++q) { const int c = tl + NT * q;
                const u32x4 kv = *(const u32x4*)(KN + ((size_t)TL + b * CTX + (c >> 3)) * 512 + h * 64 + (c & 7) * 8);
                const u32x4 vv = *(const u32x4*)(VTC + ((size_t)(b * 8 + h) * 64 + (c >> 5)) * 256 + (c & 31) * 8);
                *(u32x4*)(lds + NL_K + (c >> 3) * 144 + (c & 7) * 16) = kv;
                *(u32x4*)(lds + NL_VT + (c >> 5) * 528 + (c & 31) * 16) = vv; }
            for (int i = tl; i < 465; i += NT) ((float*)(lds + NL_RPB))[i] = RPB[h * 465 + i];
            __syncthreads();
            _Pragma("nounroll") for (int it = 0; it < 8; ++it) {
                const int r0 = 16 * half + 2 * it, rsb = min(max(r0 - 4, 0), 24), nrows = min(9, 32 - rsb);
                __syncthreads();
                int t2 = tid; asm volatile("" : "+v"(t2));
#pragma unroll
                for (int q = 0; q < 9; ++q) { const int c = t2 + NT * q, slot = c >> 9, tok = (c >> 3) & 63, ch = c & 7;
                    if (slot < nrows) { const u32x4 kv = *(const u32x4*)(KN + ((size_t)b * SEQ + (rsb + slot) * GW + tok) * 512 + h * 64 + ch * 8);
                        *(u32x4*)(lds + NL_KW + (slot * 64 + tok) * 128 + ((ch ^ na_swz(tok)) * 16)) = kv; } }
                __syncthreads();
                const int idx = it * 8 + wv; na_item(p, lds, b, 16 * half + (idx >> 2), idx & 3, h, rsb);
            }
        }
    }
    __syncthreads();
}

__device__ void phase4r(const Params& p, int bid, int nb) {
    const int lane = threadIdx.x & 63;
    const int gw = bid * 8 + (threadIdx.x >> 6), ngw = nb * 8;
    const bf16_t* OF = (const bf16_t*)p.out; const bf16_t* OB = (const bf16_t*)((const unsigned char*)p.out + (size_t)64 * MiB); bf16_t* GG = (bf16_t*)(p.ws + WS_GG);
    const float* gng = p.in[I_GNG];
    for (int row = gw; row < TL; row += ngw) {
        f32x4 v[4]; float s = 0.f;
        {
            const u32x4* fp = (const u32x4*)(OF + (size_t)row * 1024 + 16 * lane); const u32x4* bp = (const u32x4*)(OB + (size_t)row * 1024 + 16 * lane);
            const u32x4 f0 = fp[0], f1 = fp[1], b0 = bp[0], b1 = bp[1];
            v[0] = (f32x4){bflo(f0.x) + bflo(b0.x), bfhi(f0.x) + bfhi(b0.x), bflo(f0.y) + bflo(b0.y), bfhi(f0.y) + bfhi(b0.y)};
            v[1] = (f32x4){bflo(f0.z) + bflo(b0.z), bfhi(f0.z) + bfhi(b0.z), bflo(f0.w) + bflo(b0.w), bfhi(f0.w) + bfhi(b0.w)};
            v[2] = (f32x4){bflo(f1.x) + bflo(b1.x), bfhi(f1.x) + bfhi(b1.x), bflo(f1.y) + bflo(b1.y), bfhi(f1.y) + bfhi(b1.y)};
            v[3] = (f32x4){bflo(f1.z) + bflo(b1.z), bfhi(f1.z) + bfhi(b1.z), bflo(f1.w) + bflo(b1.w), bfhi(f1.w) + bfhi(b1.w)};
#pragma unroll
            for (int j = 0; j < 4; ++j) s += v[j][0] * v[j][0] + v[j][1] * v[j][1] + v[j][2] * v[j][2] + v[j][3] * v[j][3];
        }
        s += __shfl_xor(s, 1); s += __shfl_xor(s, 2); s += __shfl_xor(s, 4); s += __shfl_xor(s, 8);
        const float rstd = rsqrtf(s * (1.f / 256.f) + EPS);
        u32x4* gp = (u32x4*)(GG + (size_t)row * 1024 + 16 * lane);
        const u32x4 g0 = gp[0], g1 = gp[1];
        const unsigned gu[8] = {g0.x, g0.y, g0.z, g0.w, g1.x, g1.y, g1.z, g1.w};
        unsigned ou[8];
#pragma unroll
        for (int j = 0; j < 8; ++j) {
            const int c = (16 * lane + 2 * j) & 255;
            const float a0 = v[j >> 1][(2 * j) & 3] * rstd * gng[c] * siluf_(bflo(gu[j]));
            const float a1 = v[j >> 1][(2 * j + 1) & 3] * rstd * gng[c + 1] * siluf_(bfhi(gu[j]));
            ou[j] = pk2(a0, a1);
        }
        gp[0] = (u32x4){ou[0], ou[1], ou[2], ou[3]}; gp[1] = (u32x4){ou[4], ou[5], ou[6], ou[7]};
    }
}

struct SchedSq {
    __device__ __forceinline__ void a_ready(const Unit&) const {}
    __device__ __forceinline__ void done(const Unit&) const {}
    const bf16_t* A0; const bf16_t* B0; int K0; const bf16_t* A1; const bf16_t* B1; int K1; int passes; int G, c;
    __device__ bool next(int i, Unit& u) const {
        const int s = i % passes;
        if ((G & 7) == 0) {
            const int t = (i / passes) * (G >> 3) + (c >> 3); if (t >= 64) return false;
            u.pm = 16 * (c & 7) + (t >> 2); u.pn = t & 3;
        } else { const int L = (i / passes) * G + c; if (L >= 512) return false; u.pm = L >> 2; u.pn = L & 3; }
        u.aux = s; u.rbase = 0; u.nvalid = 0;
        if (s == 0) { u.a = A0 + (size_t)u.pm * 256 * K0; u.b = B0 + (size_t)u.pn * 256 * K0; }
        else { u.a = A1 + (size_t)u.pm * 256 * K1; u.b = B1 + (size_t)u.pn * 256 * K1; }
        return true;
    }
};
struct EpiMerge {
    static constexpr bool PERM = false, AFTER_DRAIN = false;
    unsigned char* ws; int pass;
    __device__ __forceinline__ void operator()(const f32x4 (&acc)[2][2][4][2], const Unit& u, int wr, int wc, int fr, int fq) const {
        bf16_t* M8 = (bf16_t*)(ws + WS_M8); const bf16_t* M9 = (const bf16_t*)(ws + WS_M9);
        const int row0 = u.pm * 256 + wr * 64 + fr, col0 = u.pn * 256 + wc * 32 + 4 * fq;
        u32x2 g8[2][2][2], g9[2][2][2];
#define EM_LOAD(k_, buf_) do { _Pragma("unroll") for (int bj = 0; bj < 2; ++bj) _Pragma("unroll") for (int n = 0; n < 2; ++n) { \
            const size_t off = (size_t)(row0 + ((k_) >> 2) * 128 + ((k_) & 3) * 16) * 1024 + col0 + bj * 128 + n * 16; \
            g8[buf_][bj][n] = *(const u32x2*)(M8 + off); if (pass != 0) g9[buf_][bj][n] = *(const u32x2*)(M9 + off); } } while (0)
#define EM_STORE(k_, buf_) do { _Pragma("unroll") for (int bj = 0; bj < 2; ++bj) _Pragma("unroll") for (int n = 0; n < 2; ++n) { \
            const int ai = (k_) >> 2, m = (k_) & 3; \
            const size_t off = (size_t)(row0 + ai * 128 + m * 16) * 1024 + col0 + bj * 128 + n * 16; \
            const f32x4 v = acc[ai][bj][m][n]; const u32x2 g = g8[buf_][bj][n]; u32x2 w; \
            if (pass == 0) { w.x = pk2(v[0] * sigmoidf_(bflo(g.x)), v[1] * sigmoidf_(bfhi(g.x))); w.y = pk2(v[2] * sigmoidf_(bflo(g.y)), v[3] * sigmoidf_(bfhi(g.y))); } \
            else { const u32x2 q9 = g9[buf_][bj][n]; \
                w.x = pk2(bflo(g.x) + v[0] * sigmoidf_(bflo(q9.x)), bfhi(g.x) + v[1] * sigmoidf_(bfhi(q9.x))); \
                w.y = pk2(bflo(g.y) + v[2] * sigmoidf_(bflo(q9.y)), bfhi(g.y) + v[3] * sigmoidf_(bfhi(q9.y))); } \
            *(u32x2*)(M8 + off) = w; } } while (0)
        EM_LOAD(0, 0); EM_LOAD(1, 1);
        EM_STORE(0, 0); EM_LOAD(2, 0);
        EM_STORE(1, 1); EM_LOAD(3, 1);
        EM_STORE(2, 0); EM_LOAD(4, 0);
        EM_STORE(3, 1); EM_LOAD(5, 1);
        EM_STORE(4, 0); EM_LOAD(6, 0);
        EM_STORE(5, 1); EM_LOAD(7, 1);
        EM_STORE(6, 0);
        EM_STORE(7, 1);
#undef EM_LOAD
#undef EM_STORE
    }
};
struct EpiOut {
    static constexpr bool PERM = false, AFTER_DRAIN = false;
    const float* x; const float* MOD; float* HMID; float* ROWSS;
    __device__ __forceinline__ void operator()(const f32x4 (&acc)[2][2][4][2], const Unit& u, int wr, int wc, int fr, int fq) const {
        const int row0 = u.pm * 256 + wr * 64 + fr, col0 = u.pn * 256 + wc * 32 + 4 * fq;
        const int b = (u.pm * 256) >> 11;
        float ss[2][4];
#pragma unroll
        for (int ai = 0; ai < 2; ++ai)
#pragma unroll
            for (int m = 0; m < 4; ++m) ss[ai][m] = 0.f;
#pragma unroll
        for (int bj = 0; bj < 2; ++bj)
#pragma unroll
            for (int n = 0; n < 2; ++n) {
                const int c = col0 + bj * 128 + n * 16;
                const f32x4 g1 = *(const f32x4*)(MOD + b * 6144 + 2048 + c);
                f32x4 xin[2][4];
#pragma unroll
                for (int ai = 0; ai < 2; ++ai)
#pragma unroll
                    for (int m = 0; m < 4; ++m) xin[ai][m] = *(const f32x4*)(x + (size_t)(row0 + ai * 128 + m * 16) * 1024 + c);
#pragma unroll
                for (int ai = 0; ai < 2; ++ai)
#pragma unroll
                    for (int m = 0; m < 4; ++m) { const size_t off = (size_t)(row0 + ai * 128 + m * 16) * 1024 + c;
                        const f32x4 hv = xin[ai][m] + g1 * acc[ai][bj][m][n];
                        *(f32x4*)(HMID + off) = hv;
                        ss[ai][m] += (hv[0] * hv[0] + hv[1] * hv[1]) + (hv[2] * hv[2] + hv[3] * hv[3]); }
            }
#pragma unroll
        for (int ai = 0; ai < 2; ++ai)
#pragma unroll
            for (int m = 0; m < 4; ++m) { float v = ss[ai][m]; v += __shfl_xor(v, 16); v += __shfl_xor(v, 32);
                if (fq == 0) ROWSS[(size_t)(row0 + ai * 128 + m * 16) * 16 + u.pn * 4 + wc] = v; }
    }
};

constexpr int P5_WG = 131072;
__device__ void phase5(const Params& p, unsigned char* ldsg, int bid, int nb) {
    LAS unsigned char* lds = (LAS unsigned char*)ldsg;
    const int tid = threadIdx.x, lane = tid & 63, wave = tid >> 6, l15 = lane & 15, q4 = lane >> 4;
    const float* MOD = (const float*)(p.ws + WS_MOD); const float* HMID = (const float*)(p.ws + WS_HMID); const float* ROWSS = (const float*)(p.ws + WS_ROWSS);
    bf16_t* FL = (bf16_t*)(p.ws + WS_FL);
    const float* G = p.in[I_NFG]; const float* WGR = p.in[I_WGRP]; const float* WEX = p.in[I_WEXP]; const float* BGR = p.in[I_BGRP]; const float* BEX = p.in[I_BEXP];
    int* cnt = (int*)(p.ws + WS_CTL) + CW_CNT;
    if (bid == 0 && tid < 128) *(u32x4*)(FL + (size_t)TL * DM + tid * 8) = (u32x4){0u, 0u, 0u, 0u};
    for (int c = tid; c < 8192; c += NT) {
        const int k = c >> 3, o4 = c & 7;
        const f32x4 w = *(const f32x4*)(WEX + (size_t)k * 32 + 4 * o4);
#pragma unroll
        for (int i = 0; i < 4; ++i) *(LAS float*)(lds + ((((k >> 2) * 32 + 4 * o4 + i) * 4 + (k & 3)) * 4)) = w[i];
    }
    for (int c = tid; c < 1024; c += NT) *(LAS f32x4*)(lds + P5_WG + c * 16) = *(const f32x4*)(WGR + (size_t)c * 4);
    __syncthreads();
    for (int tile0 = bid * 8; tile0 < TL / 16; tile0 += nb * 8) {
        const int tile = tile0 + wave;
        const int tok = tile * 16 + l15, b = (tile * 16) >> 11;
        float rstd;
        { const f32x4 r4 = *(const f32x4*)(ROWSS + (size_t)tok * 16 + 4 * q4); float v = (r4[0] + r4[1]) + (r4[2] + r4[3]); v += __shfl_xor(v, 16); v += __shfl_xor(v, 32);
          rstd = rsqrtf(v * (1.f / DM) + EPS); }
        f32x4 acc0 = (f32x4){0.f, 0.f, 0.f, 0.f}, acc1 = (f32x4){0.f, 0.f, 0.f, 0.f};
        float lg[4] = {0.f, 0.f, 0.f, 0.f};
        const float* hrow = HMID + (size_t)tok * DM + 4 * q4; const float* modb = MOD + b * 6144 + 4 * q4; const float* gq = G + 4 * q4;
        bf16_t* flrow = FL + (size_t)tok * DM + 4 * q4;
        f32x4 hv[2][2], gv[2][2], sh[2][2], sc[2][2];
#define P5_LOAD(gn_, buf_) do { _Pragma("unroll") for (int uu = 0; uu < 2; ++uu) { const int c = 16 * (2 * (gn_) + uu); \
            hv[buf_][uu] = *(const f32x4*)(hrow + c); gv[buf_][uu] = *(const f32x4*)(gq + c); sh[buf_][uu] = *(const f32x4*)(modb + 3072 + c); sc[buf_][uu] = *(const f32x4*)(modb + 4096 + c); } } while (0)
        P5_LOAD(0, 0);
#define P5_COMP(gn_, bf_) do { u32x2 wst[2]; \
            _Pragma("unroll") for (int uu = 0; uu < 2; ++uu) { const int u = 2 * (gn_) + uu; f32x4 f; \
                _Pragma("unroll") for (int i = 0; i < 4; ++i) f[i] = (hv[bf_][uu][i] * rstd) * gv[bf_][uu][i] * (1.f + sc[bf_][uu][i]) + sh[bf_][uu][i]; \
                wst[uu].x = pk2(f[0], f[1]); wst[uu].y = pk2(f[2], f[3]); \
                const f32x4 w0 = *(const LAS f32x4*)(lds + ((4 * u + q4) * 32 + l15) * 16), w1 = *(const LAS f32x4*)(lds + ((4 * u + q4) * 32 + 16 + l15) * 16); \
                _Pragma("unroll") for (int e = 0; e < 4; ++e) { \
                    acc0 = __builtin_amdgcn_mfma_f32_16x16x4f32(f[e], w0[e], acc0, 0, 0, 0); \
                    acc1 = __builtin_amdgcn_mfma_f32_16x16x4f32(f[e], w1[e], acc1, 0, 0, 0); \
                    const f32x4 wg = *(const LAS f32x4*)(lds + P5_WG + (16 * u + 4 * q4 + e) * 16); \
                    lg[0] += f[e] * wg[0]; lg[1] += f[e] * wg[1]; lg[2] += f[e] * wg[2]; lg[3] += f[e] * wg[3]; } } \
            _Pragma("unroll") for (int uu = 0; uu < 2; ++uu) *(u32x2*)(flrow + 16 * (2 * (gn_) + uu)) = wst[uu]; } while (0)
#pragma unroll 1
        for (int g2 = 0; g2 < 16; ++g2) {
            P5_LOAD(2 * g2 + 1, 1);
            P5_COMP(2 * g2, 0);
            if (g2 < 15) P5_LOAD(2 * g2 + 2, 0);
            P5_COMP(2 * g2 + 1, 1);
        }
#undef P5_COMP
#undef P5_LOAD
#pragma unroll
        for (int e = 0; e < 4; ++e) { float v = lg[e]; v += __shfl_xor(v, 16); v += __shfl_xor(v, 32); lg[e] = v + BGR[e]; }
        __syncthreads();
        LAS float* sl = (LAS float*)(lds + wave * (16 * 33 * 4));
        LAS int* bcnt = (LAS int*)(lds + 32768);
        if (tid < 32) bcnt[tid] = 0;
#pragma unroll
        for (int r = 0; r < 4; ++r) { sl[(4 * q4 + r) * 33 + l15] = acc0[r]; sl[(4 * q4 + r) * 33 + 16 + l15] = acc1[r]; }
        __syncthreads();
        int x1 = 0, x2 = 0, lr1 = 0, lr2 = 0; float w1 = 0.f, w2 = 0.f;
        if (lane < 16) {
            int grp = 0; float gm = lg[0];
#pragma unroll
            for (int e = 1; e < 4; ++e) if (lg[e] > gm) { gm = lg[e]; grp = e; }
            float gs = 0.f;
#pragma unroll
            for (int e = 0; e < 4; ++e) gs += __expf(lg[e] - gm);
            const float pgrp = 1.f / gs;
            float l8[8];
#pragma unroll
            for (int e = 0; e < 8; ++e) l8[e] = sl[lane * 33 + grp * 8 + e] + BEX[grp * 8 + e];
            int i1 = 0; float m1 = l8[0];
#pragma unroll
            for (int e = 1; e < 8; ++e) if (l8[e] > m1) { m1 = l8[e]; i1 = e; }
            int i2 = -1; float m2 = -3.0e38f;
#pragma unroll
            for (int e = 0; e < 8; ++e) if (e != i1 && l8[e] > m2) { m2 = l8[e]; i2 = e; }
            const float e2 = __expf(m2 - m1);
            w1 = pgrp / (1.f + e2); w2 = pgrp * e2 / (1.f + e2);
            x1 = grp * 8 + i1; x2 = grp * 8 + i2;
            lr1 = __hip_atomic_fetch_add(bcnt + x1, 1, __ATOMIC_RELAXED, __HIP_MEMORY_SCOPE_WORKGROUP);
            lr2 = __hip_atomic_fetch_add(bcnt + x2, 1, __ATOMIC_RELAXED, __HIP_MEMORY_SCOPE_WORKGROUP);
        }
        __syncthreads();
        if (tid < 32) bcnt[32 + tid] = atomicAdd(&cnt[tid * 64], bcnt[tid]);
        __syncthreads();
        if (lane < 16) {
            int* ERT = (int*)(p.ws + WS_ERT); float* ERW = (float*)(p.ws + WS_ERW);
            const int i1 = x1 * ECAP + bcnt[32 + x1] + lr1, i2 = x2 * ECAP + bcnt[32 + x2] + lr2;
            ERT[i1] = tok * 2; ERW[i1] = w1; ERT[i2] = tok * 2 + 1; ERW[i2] = w2;
        }
        asm volatile("s_waitcnt lgkmcnt(0)" ::: "memory");
        if (tile0 + nb * 8 < TL / 16) {
            __syncthreads();
            for (int c = tid; c < 8192; c += NT) {
                const int k = c >> 3, o4 = c & 7;
                const f32x4 w = *(const f32x4*)(WEX + (size_t)k * 32 + 4 * o4);
#pragma unroll
                for (int i = 0; i < 4; ++i) *(LAS float*)(lds + ((((k >> 2) * 32 + 4 * o4 + i) * 4 + (k & 3)) * 4)) = w[i];
            }
            __syncthreads();
        }
    }
    __syncthreads();
}

__device__ void phase5b(const Params& p, float* lds, int bid, int nb) {
    const int lane = threadIdx.x & 63;
    const int gw = bid * 8 + (threadIdx.x >> 6), ngw = nb * 8;
    int* sstart = (int*)lds;
    if (threadIdx.x == 0) { const int* cnt = (const int*)(p.ws + WS_CTL) + CW_CNT; int a = 0; for (int e = 0; e < 32; ++e) { sstart[e] = a; a += ((cnt[e * 64] + 255) >> 8) << 8; } sstart[32] = a; }
    __syncthreads();
    const int* ROUTE = (const int*)(p.ws + WS_ROUTE);
    int* rowtok = (int*)(p.ws + WS_ROWTOK); float* roww = (float*)(p.ws + WS_ROWW);
    const bf16_t* FL = (const bf16_t*)(p.ws + WS_FL); bf16_t* XG = (bf16_t*)(p.ws + WS_XG);
    const int l15 = lane & 15, g4 = lane >> 4;
    for (int it4 = gw; it4 < TL * 2 / 4; it4 += ngw) {
        const int it = it4 * 4 + g4;
        const int tok = it >> 1, k = it & 1;
        const int* R = ROUTE + (size_t)tok * 8;
        const int e = R[k], rk = R[2 + k]; const float w = ((const float*)R)[4 + k];
        const int pos = sstart[e] + rk;
        if (l15 == 0) { rowtok[pos] = it; roww[pos] = w; }
        const u32x4* src = (const u32x4*)(FL + (size_t)tok * DM); u32x4* dst = (u32x4*)(XG + (size_t)pos * DM);
        u32x4 v[8];
#pragma unroll
        for (int q = 0; q < 8; ++q) v[q] = src[l15 + 16 * q];
#pragma unroll
        for (int q = 0; q < 8; ++q) dst[l15 + 16 * q] = v[q];
    }
    const int* cnt = (const int*)(p.ws + WS_CTL) + CW_CNT;
    for (int e = 0; e < 32; ++e) {
        const int c = cnt[e * 64], padn = (((c + 255) >> 8) << 8) - c;
        for (int r = gw; r < padn; r += ngw) { u32x4* dst = (u32x4*)(XG + (size_t)(sstart[e] + c + r) * DM); dst[lane] = (u32x4){0, 0, 0, 0}; dst[lane + 64] = (u32x4){0, 0, 0, 0}; }
    }
    __syncthreads();
}

struct SchedMoe {
    __device__ __forceinline__ void a_ready(const Unit&) const {}
    __device__ __forceinline__ void done(const Unit&) const {}
    const bf16_t* A; const bf16_t* B; int K; size_t bexp; const int* tstart;
    int G, c; bool gather;
    __device__ bool next(int i, Unit& u) const {
        const int ntile = __builtin_amdgcn_readfirstlane(tstart[32]);
        if ((G & 7) == 0) {
            const int t = i * (G >> 3) + (c >> 3);
            u.pm = 8 * (t >> 2) + (c & 7); u.pn = t & 3;
            if (u.pm >= ntile) return false;
        } else { const int L = i * G + c; if (L >= ntile * 4) return false; u.pm = L >> 2; u.pn = L & 3; }
        const int e = __builtin_amdgcn_readfirstlane(tstart[40 + u.pm]);
        const int j = u.pm - __builtin_amdgcn_readfirstlane(tstart[e]), ce = __builtin_amdgcn_readfirstlane(tstart[400 + e]);
        u.aux = e; u.rbase = e * ECAP + 256 * j; u.nvalid = min(256, ce - 256 * j);
        u.a = gather ? A : A + (size_t)u.pm * 256 * K; u.b = B + (size_t)e * bexp + (size_t)u.pn * 256 * K;
        return true;
    }
};
struct EpiGU {
    static constexpr bool PERM = false, AFTER_DRAIN = false;
    bf16_t* H;
    __device__ __forceinline__ void operator()(const f32x4 (&acc)[2][2][4][2], const Unit& u, int wr, int wc, int fr, int fq) const {
        const int row0 = u.pm * 256 + wr * 64 + fr, col0 = u.pn * 128 + wc * 32 + 4 * fq;
#pragma unroll
        for (int ai = 0; ai < 2; ++ai)
#pragma unroll
            for (int m = 0; m < 4; ++m)
#pragma unroll
                for (int n = 0; n < 2; ++n) {
                    const f32x4 g = acc[ai][0][m][n], up = acc[ai][1][m][n];
                    u32x2 w; w.x = pk2(siluf_(g[0]) * up[0], siluf_(g[1]) * up[1]); w.y = pk2(siluf_(g[2]) * up[2], siluf_(g[3]) * up[3]);
                    *(u32x2*)(H + (size_t)(row0 + ai * 128 + m * 16) * 512 + col0 + n * 16) = w;
                }
    }
};
struct EpiDown {
    static constexpr bool PERM = false, AFTER_DRAIN = false;
    bf16_t* YS; const int* rowtok; const float* roww;
    __device__ __forceinline__ void operator()(const f32x4 (&acc)[2][2][4][2], const Unit& u, int wr, int wc, int fr, int fq) const {
        const int row0 = u.pm * 256 + wr * 64 + fr, col0 = u.pn * 256 + wc * 32 + 4 * fq;
        int tsv[2][4]; float wv[2][4];
#pragma unroll
        for (int ai = 0; ai < 2; ++ai)
#pragma unroll
            for (int m = 0; m < 4; ++m) { const int rl = wr * 64 + fr + ai * 128 + m * 16; const bool ok = rl < u.nvalid; tsv[ai][m] = ok ? rowtok[u.rbase + rl] : -1; wv[ai][m] = ok ? roww[u.rbase + rl] : 0.f; }
#pragma unroll
        for (int ai = 0; ai < 2; ++ai)
#pragma unroll
            for (int m = 0; m < 4; ++m) {
                const int ts = tsv[ai][m]; const float w = wv[ai][m];
                if (ts >= 0) {
                    bf16_t* rp = YS + ((size_t)(ts & 1) * TL + (ts >> 1)) * 1024 + col0;
#pragma unroll
                    for (int bj = 0; bj < 2; ++bj)
#pragma unroll
                        for (int n = 0; n < 2; ++n) { const f32x4 v = acc[ai][bj][m][n] * w; u32x2 o; o.x = pk2(v[0], v[1]); o.y = pk2(v[2], v[3]); *(u32x2*)(rp + bj * 128 + n * 16) = o; }
                }
            }
    }
};
__device__ void moe_tiles(const Params& p, int* tstart) {
    if (threadIdx.x == 0) { const int* cnt = (const int*)(p.ws + WS_CTL) + CW_CNT; int a = 0;
        for (int e = 0; e < 32; ++e) { tstart[e] = a; const int n = (cnt[e * 64] + 255) >> 8; for (int j = 0; j < n; ++j) tstart[40 + a + j] = e; a += n; }
        tstart[32] = a; for (int e = 0; e < 32; ++e) tstart[400 + e] = cnt[e * 64]; }
    __syncthreads();
}

__device__ void phase7(const Params& p, int bid, int nb) {
    const int lane = threadIdx.x & 63;
    const int gw = bid * 8 + (threadIdx.x >> 6), ngw = nb * 8;
    const float* MOD = (const float*)(p.ws + WS_MOD); const float* HMID = (const float*)(p.ws + WS_HMID);
    const bf16_t* YS = (const bf16_t*)(p.ws + WS_YS);
    const float* G = p.in[I_FNG];
    for (int row = gw; row < TL; row += ngw) {
        const int b = row >> 11;
        f32x4 v[4]; float s = 0.f;
#pragma unroll
        for (int j = 0; j < 4; ++j) {
            const int c = 4 * lane + 256 * j;
            const f32x4 hm = *(const f32x4*)(HMID + (size_t)row * DM + c);
            const f32x4 g2 = *(const f32x4*)(MOD + b * 6144 + 5120 + c);
            const u32x2 y0 = *(const u32x2*)(YS + (size_t)row * DM + c), y1 = *(const u32x2*)(YS + ((size_t)TL + row) * DM + c);
            f32x4 y; y[0] = bflo(y0.x) + bflo(y1.x); y[1] = bfhi(y0.x) + bfhi(y1.x); y[2] = bflo(y0.y) + bflo(y1.y); y[3] = bfhi(y0.y) + bfhi(y1.y);
            v[j] = hm + g2 * y;
            s += v[j][0] * v[j][0] + v[j][1] * v[j][1] + v[j][2] * v[j][2] + v[j][3] * v[j][3];
        }
        const float rstd = rsqrtf(wave_sum(s) * (1.f / DM) + EPS);
#pragma unroll
        for (int j = 0; j < 4; ++j) { const int c = 4 * lane + 256 * j; const f32x4 g = *(const f32x4*)(G + c);
            *(f32x4*)(p.out + (size_t)row * DM + c) = (v[j] * rstd) * g; }
    }
}


#ifndef LAS
#define LAS __attribute__((address_space(3)))
#endif
#define XB_TMO      128
#define XB_XCNT(j)  (256  + 64 * (j))
#define XB_XSUB(j)  (1280 + 64 * (j))
#define XB_XGEN(j)  (2304 + 64 * (j))
#define XB_TOP      3328
#define XB_TOPGEN   3392
#define XCD_BAR_WORDS 3456
#define XB_SPIN_CAP (1u << 18)

__device__ __forceinline__ unsigned xb_ld(unsigned* p)              { return __hip_atomic_load(p, __ATOMIC_RELAXED, __HIP_MEMORY_SCOPE_AGENT); }
__device__ __forceinline__ unsigned xb_add(unsigned* p, unsigned v) { return __hip_atomic_fetch_add(p, v, __ATOMIC_RELAXED, __HIP_MEMORY_SCOPE_AGENT); }
__device__ __forceinline__ unsigned xb_xcc_id() { return (unsigned)__builtin_amdgcn_s_getreg((3 << 11) | 20) & 0xFu; }
#define XB_SPIN(cond, bar) do { unsigned _sp = 0; while (cond) { __builtin_amdgcn_s_sleep(1); \
    if ((++_sp & 255u) == 0u) { if (xb_ld(&(bar)[XB_TMO])) break; if (_sp > XB_SPIN_CAP) { atomicAdd(&(bar)[XB_TMO], 1u); break; } } } } while (0)

struct XcdBarrier {
    unsigned* bar; unsigned x;
    volatile LAS unsigned* st;
};

__device__ __forceinline__ XcdBarrier xcd_barrier_post(unsigned* bar, volatile LAS unsigned* st) {
    XcdBarrier b; b.bar = bar; b.x = xb_xcc_id(); b.st = st;
    if (threadIdx.x == 0) (void)xb_add(&bar[XB_XCNT(b.x)], 1u);
    return b;
}
__device__ __forceinline__ void xcd_barrier_complete(unsigned* bar, unsigned x, unsigned& nloc, unsigned& nx) {
    const unsigned G = gridDim.x * gridDim.y * gridDim.z;
    unsigned sum, cnt, mine, sp = 0u;
    for (;;) {
        sum = 0u; cnt = 0u; mine = 0u;
#pragma unroll
        for (unsigned j = 0; j < 16; ++j) { const unsigned c = xb_ld(&bar[XB_XCNT(j)]); sum += c; cnt += (c > 0u) ? 1u : 0u; mine = (j == x) ? c : mine; }
        if (sum == G) break;
        __builtin_amdgcn_s_sleep(1);
        if ((++sp & 255u) == 0u) { if (xb_ld(&bar[XB_TMO])) break; if (sp > XB_SPIN_CAP) { atomicAdd(&bar[XB_TMO], 1u); break; } }
    }
    nloc = mine > 0u ? mine : 1u; nx = cnt > 0u ? cnt : 1u;
}

__device__ __forceinline__ void xcd_barrier(const XcdBarrier& b) {
    asm volatile("s_waitcnt vmcnt(0)" ::: "memory");
    __syncthreads();
    if (threadIdx.x == 0) {
        unsigned* bar = b.bar;
        __builtin_amdgcn_s_waitcnt(0);
        unsigned nloc = b.st[0], nx = b.st[1];
        if (nloc == 0u) { xcd_barrier_complete(bar, b.x, nloc, nx); b.st[0] = nloc; b.st[1] = nx; }
        const unsigned old = xb_add(&bar[XB_XSUB(b.x)], 1u);
        const unsigned gen = old / nloc;
        if (old + 1u == (gen + 1u) * nloc) {
            __builtin_amdgcn_fence(__ATOMIC_RELEASE, "agent");
            asm volatile("s_waitcnt vmcnt(0)" ::: "memory");
            const unsigned og = xb_add(&bar[XB_TOP], 1u);
            const unsigned tg = og / nx;
            if (og + 1u == (tg + 1u) * nx) xb_add(&bar[XB_TOPGEN], 1u);
            else XB_SPIN(xb_ld(&bar[XB_TOPGEN]) == tg, bar);
            __builtin_amdgcn_fence(__ATOMIC_ACQUIRE, "agent");
            xb_add(&bar[XB_XGEN(b.x)], 1u);
            asm volatile("s_waitcnt vmcnt(0)" ::: "memory");
        } else {
            XB_SPIN(xb_ld(&bar[XB_XGEN(b.x)]) == gen, bar);
            __builtin_amdgcn_fence(__ATOMIC_ACQUIRE, "agent");
            asm volatile("s_waitcnt vmcnt(0)" ::: "memory");
        }
    }
    __syncthreads();
}


template <int PH>
__device__ __forceinline__ void run_phase(const Params& p, unsigned char* lds, int bid, int nb) {
    if constexpr (PH == 0) phase0(p, (float*)lds, bid, nb);
    if constexpr (PH == 1) phase1(p, bid, nb);
    if constexpr (PH == 2) { SchedIn S{(const bf16_t*)p.out, (const bf16_t*)(p.ws + WS_WIN), nb, bid}; EpiIn E{p.ws}; pg8::gemm_phase<decltype(E), decltype(S), true, true>((PG8_LAS unsigned char*)lds, 1024, S, E); }
    if constexpr (PH == 3) phase3(p, lds, bid, nb);
    if constexpr (PH == 4) phase4r(p, bid, nb);
    if constexpr (PH == 5) {
        SchedSq S{(const bf16_t*)(p.ws + WS_ONA), (const bf16_t*)(p.ws + WS_WNAO), 512, (const bf16_t*)(p.ws + WS_GG), (const bf16_t*)(p.ws + WS_WGLAO), 1024, 1, nb, bid};
        { EpiMerge E{p.ws, 0}; pg8::gemm_phase<decltype(E), decltype(S), true, true>((PG8_LAS unsigned char*)lds, 512, S, E); }
        { SchedSq S1{(const bf16_t*)(p.ws + WS_GG), (const bf16_t*)(p.ws + WS_WGLAO), 1024, nullptr, nullptr, 0, 1, nb, bid}; EpiMerge E{p.ws, 1}; pg8::gemm_phase<decltype(E), decltype(S1), true, true>((PG8_LAS unsigned char*)lds, 1024, S1, E); }
    }
    if constexpr (PH == 6) { SchedSq S{(const bf16_t*)(p.ws + WS_M8), (const bf16_t*)(p.ws + WS_WOUT), 1024, nullptr, nullptr, 0, 1, nb, bid};
        EpiOut E{p.in[I_X], (const float*)(p.ws + WS_MOD), (float*)(p.ws + WS_HMID), (float*)(p.ws + WS_ROWSS)}; pg8::gemm_phase<decltype(E), decltype(S), true, true>((PG8_LAS unsigned char*)lds, 1024, S, E); }
    if constexpr (PH == 7) { phase5(p, lds, bid, nb); prep_experts(p, (float*)lds, bid * 8 + (threadIdx.x >> 6), nb * 8); }
    if constexpr (PH == 9) { int* tstart = (int*)(lds + pg8::STAGE_BYTES); moe_tiles(p, tstart);
        SchedMoe S{(const bf16_t*)(p.ws + WS_FL), (const bf16_t*)((unsigned char*)p.out + OUT_WGU), 1024, (size_t)1024 * 1024, tstart, nb, bid, true};
        EpiGU E{(bf16_t*)(p.ws + WS_H)}; const pg8::NoGather GI{(const int*)(p.ws + WS_ERT), TL};
        pg8::gemm_phase<decltype(E), decltype(S), true, true, true>((PG8_LAS unsigned char*)lds, 1024, S, E, GI); }
    if constexpr (PH == 10) { int* tstart = (int*)(lds + pg8::STAGE_BYTES); moe_tiles(p, tstart);
        SchedMoe S{(const bf16_t*)(p.ws + WS_H), (const bf16_t*)((unsigned char*)p.out + OUT_WD), 512, (size_t)1024 * 512, tstart, nb, bid, false};
        EpiDown E{(bf16_t*)(p.ws + WS_YS), (const int*)(p.ws + WS_ERT), (const float*)(p.ws + WS_ERW)}; pg8::gemm_phase<decltype(E), decltype(S), true, true>((PG8_LAS unsigned char*)lds, 512, S, E); }
    if constexpr (PH == 11) phase7(p, bid, nb);
}
constexpr int LDS_BYTES = 155648;

template <int PH>
__global__ void __launch_bounds__(NT, 2) k_phase(Params p) {
    extern __shared__ __attribute__((aligned(16))) unsigned char lds[];
    run_phase<PH>(p, lds, blockIdx.x, gridDim.x);
}


constexpr int LDS_MISC = 155648 - 256;
__global__ void __launch_bounds__(NT, 2) k_mega(Params p) {
    extern __shared__ __attribute__((aligned(16))) unsigned char lds[];
    const int bid = blockIdx.x, nb = gridDim.x;
    volatile LAS unsigned* misc = (volatile LAS unsigned*)((LAS unsigned char*)lds + LDS_MISC);
    if (threadIdx.x < 64) misc[threadIdx.x] = 0u;
    __syncthreads();
    const XcdBarrier bar = xcd_barrier_post((unsigned*)(p.ws + WS_BAR), misc);
#define PHS(N) run_phase<N>(p, lds, bid, nb); if (PROBE_DUP == N) { xcd_barrier(bar); run_phase<N>(p, lds, bid, nb); } xcd_barrier(bar);
    PHS(0) PHS(1) PHS(2) PHS(3) PHS(4) PHS(5) PHS(6) PHS(7) PHS(9) PHS(10)
    run_phase<11>(p, lds, bid, nb);
}

template <int PH> static void launch_phase(const Params& p, int grid, hipStream_t stream) {
    static bool attr = false;
    if (!attr) { (void)hipFuncSetAttribute((const void*)k_phase<PH>, hipFuncAttributeMaxDynamicSharedMemorySize, LDS_BYTES); attr = true; }
    hipLaunchKernelGGL(k_phase<PH>, dim3(grid), dim3(NT), LDS_BYTES, stream, p);
}

extern "C" void kernel_launch(void* const* d_in, const int* in_sizes, int n_in, void* d_out, int out_size, void* d_ws, size_t ws_size, hipStream_t stream) {
    if (n_in != 24 || ws_size < WS_END) { fprintf(stderr, "kernel_launch: unexpected n_in %d / ws %zu\n", n_in, ws_size); return; }
    Params p{};
    for (int i = 0; i < 24; ++i) p.in[i] = (const float*)d_in[i];
    p.out = (float*)d_out; p.ws = (unsigned char*)d_ws;
#if MEGA
    static int grid = 0;
    if (grid == 0) {
        int dev = 0, cus = 0, per_cu = 0;
        (void)hipGetDevice(&dev);
        (void)hipDeviceGetAttribute(&cus, hipDeviceAttributeMultiprocessorCount, dev);
        (void)hipFuncSetAttribute((const void*)k_mega, hipFuncAttributeMaxDynamicSharedMemorySize, LDS_BYTES);
        if (hipOccupancyMaxActiveBlocksPerMultiprocessor(&per_cu, (const void*)k_mega, NT, LDS_BYTES) != hipSuccess || per_cu < 1) { fprintf(stderr, "occupancy query failed (%d)\n", per_cu); per_cu = 1; }
        if (per_cu > 1) per_cu = 1;
        grid = cus * per_cu;
    }
    (void)hipMemsetAsync((unsigned char*)d_ws + WS_BAR, 0, 16384, stream);
    hipLaunchKernelGGL(k_mega, dim3(grid), dim3(NT), LDS_BYTES, stream, p);
    const hipError_t e = hipPeekAtLastError();
    if (e != hipSuccess) fprintf(stderr, "launch failed: %s (grid %d)\n", hipGetErrorString(e), grid);
#else
    const int G = 256;
    launch_phase<0>(p, G, stream); launch_phase<1>(p, G, stream); launch_phase<2>(p, G, stream); launch_phase<3>(p, G, stream);
    launch_phase<4>(p, G, stream); launch_phase<5>(p, G, stream); launch_phase<6>(p, G, stream); launch_phase<7>(p, G, stream);
    launch_phase<8>(p, G, stream); launch_phase<9>(p, G, stream); launch_phase<10>(p, G, stream); launch_phase<11>(p, G, stream);
#endif
}
```

```cpp
#include <hip/hip_runtime.h>
#include <hip/hip_cooperative_groups.h>
#include <cstdint>
#include <cstdio>
namespace cg = cooperative_groups;

#ifndef MEGA
#define MEGA 1
#endif
#define PROBE_DUP -1

typedef unsigned short bf16_t;
typedef short bf16x8 __attribute__((ext_vector_type(8)));
typedef float f32x4 __attribute__((ext_vector_type(4)));
typedef float f32x2 __attribute__((ext_vector_type(2)));
typedef unsigned u32x4 __attribute__((ext_vector_type(4)));
typedef unsigned u32x2 __attribute__((ext_vector_type(2)));

constexpr int NB = 16, SEQ = 2048, DM = 1024, CTX = 256, GW = 64;
constexpr int TL = NB * SEQ;
constexpr int TC = NB * CTX;
constexpr int TA = TL + TC;
constexpr int NEXP = 32, DEXP = 512;
constexpr int NT = 512;
constexpr float EPS = 1e-6f;
constexpr int ECAP = 32768;
constexpr int MAXROWS = 73728;

constexpr size_t MiB = 1u << 20;
constexpr size_t WS_CTL = 0;
constexpr size_t WS_BAR = 64 * 1024;
constexpr size_t WS_MOD = 1 * MiB;
constexpr size_t WS_ROPE = 1 * MiB + 512 * 1024;
constexpr size_t WS_ROUTE = 2 * MiB;
constexpr size_t WS_ROWTOK = 3 * MiB;
constexpr size_t WS_ROWW = 3 * MiB + 512 * 1024;
constexpr size_t WS_WIN = 4 * MiB;
constexpr size_t WS_WNAO = WS_WIN + (size_t)6912 * 1024 * 2;
constexpr size_t WS_WGLAO = WS_WNAO + 1 * MiB;
constexpr size_t WS_WOUT = WS_WGLAO + 2 * MiB;
constexpr size_t WS_ALR = WS_WOUT + 2 * MiB;
constexpr size_t WS_QN = 28 * MiB;
constexpr size_t WS_KN = 60 * MiB;
constexpr size_t WS_VN = 96 * MiB;
constexpr size_t WS_QG = 132 * MiB;
constexpr size_t WS_KG = 164 * MiB;
constexpr size_t WS_VG = 200 * MiB;
constexpr size_t WS_ONA = 272 * MiB;
constexpr size_t WS_GG = 304 * MiB;
constexpr size_t WS_M8 = 368 * MiB;
constexpr size_t WS_M9 = 432 * MiB;
constexpr size_t WS_ROWSS = 496 * MiB;
constexpr size_t WS_ERT = 156 * MiB;
constexpr size_t WS_ERW = 160 * MiB;
constexpr size_t WS_END = 504 * MiB;
constexpr size_t WS_HMID = 28 * MiB;
constexpr size_t WS_FL = 200 * MiB;
constexpr size_t WS_H = 432 * MiB;
constexpr size_t WS_XG = 304 * MiB;
constexpr size_t WS_YS = 304 * MiB;
static_assert(WS_ALR + (size_t)TA * 32 * 4 <= WS_QN, "ws map");
constexpr size_t OUT_WGU = 0;
constexpr size_t OUT_WD = 64 * MiB;

constexpr int CW_CNT = 0;

__device__ __forceinline__ unsigned pk2(float lo, float hi);
__device__ __forceinline__ unsigned f2bf(float f);
typedef __bf16 bf16x2_hw __attribute__((ext_vector_type(2)));
__device__ __forceinline__ unsigned pk2(float lo, float hi) { const f32x2 v = {lo, hi}; return __builtin_bit_cast(unsigned, __builtin_convertvector(v, bf16x2_hw)); }
__device__ __forceinline__ unsigned f2bf(float f) { return pk2(f, 0.f) & 0xffffu; }
__device__ __forceinline__ float bf2f(unsigned short h) { return __builtin_bit_cast(float, (unsigned)h << 16); }
__device__ __forceinline__ float bflo(unsigned u) { return __builtin_bit_cast(float, u << 16); }
__device__ __forceinline__ float bfhi(unsigned u) { return __builtin_bit_cast(float, u & 0xffff0000u); }
__device__ __forceinline__ float wave_sum(float v) {
#pragma unroll
    for (int o = 1; o < 64; o <<= 1) v += __shfl_xor(v, o);
    return v;
}
__device__ __forceinline__ float sigmoidf_(float x) { return 1.f / (1.f + __expf(-x)); }
__device__ __forceinline__ float siluf_(float x) { return x / (1.f + __expf(-x)); }

struct Params {
    const float* in[24];
    float* out;
    unsigned char* ws;
};
enum { I_X = 0, I_C, I_CTX, I_CCTX, I_WMOD, I_BMOD, I_NAG, I_NFG, I_WIN, I_WA2, I_BA2, I_GNG, I_RPB, I_WNAO, I_WGLAO, I_WOUT,
       I_WGRP, I_BGRP, I_WEXP, I_BEXP, I_WG, I_WU, I_WD, I_FNG };

__device__ void p0_mod(const Params& p, float* lds, int blk) {
    const int tid = threadIdx.x;
    float* sc = lds;
    for (int i = tid; i < 17 * 1024; i += NT) {
        const int r = i >> 10, k = i & 1023;
        const float v = r < 16 ? p.in[I_C][r * 1024 + k] : p.in[I_CCTX][k];
        sc[i] = siluf_(v);
    }
    __syncthreads();
    const int cg4 = tid & 7, kr = tid >> 3;
    const int n0 = blk * 32 + cg4 * 4;
    float acc[17][4];
#pragma unroll
    for (int r = 0; r < 17; ++r) { acc[r][0] = 0.f; acc[r][1] = 0.f; acc[r][2] = 0.f; acc[r][3] = 0.f; }
    const float* W = p.in[I_WMOD];
#pragma unroll 2
    for (int kb = 0; kb < 1024; kb += 64) {
        const int k = kb + kr;
        const f32x4 w = *(const f32x4*)(W + (size_t)k * 6144 + n0);
#pragma unroll
        for (int r = 0; r < 17; ++r) { const float s = sc[r * 1024 + k]; acc[r][0] += s * w[0]; acc[r][1] += s * w[1]; acc[r][2] += s * w[2]; acc[r][3] += s * w[3]; }
    }
#pragma unroll
    for (int r = 0; r < 17; ++r)
#pragma unroll
        for (int j = 0; j < 4; ++j) { float v = acc[r][j]; v += __shfl_xor(v, 8); v += __shfl_xor(v, 16); v += __shfl_xor(v, 32); acc[r][j] = v; }
    __syncthreads();
    float* red = lds;
    const int wave = tid >> 6, lane = tid & 63;
    if (lane < 8) {
#pragma unroll
        for (int r = 0; r < 17; ++r)
#pragma unroll
            for (int j = 0; j < 4; ++j) red[(wave * 8 + lane) * 68 + r * 4 + j] = acc[r][j];
    }
    __syncthreads();
    float* MOD = (float*)(p.ws + WS_MOD);
    for (int i = tid; i < 8 * 68; i += NT) {
        const int c = i / 68, q = i % 68, r = q >> 2, j = q & 3;
        float s = 0.f;
#pragma unroll
        for (int w = 0; w < 8; ++w) s += red[(w * 8 + c) * 68 + q];
        const int n = blk * 32 + c * 4 + j;
        MOD[r * 6144 + n] = s + p.in[I_BMOD][n];
    }
    __syncthreads();
}

template <class ColMap>
__device__ __forceinline__ void transpose_item(const float* W, int ld, bf16_t* WT, int K, int k0, int n0, float* scr, int lane, const ColMap& cm) {
    const int sc = cm(n0 + (lane & 31));
    float tv[32];
    const float* wp = W + (size_t)(k0 + (lane >> 5)) * ld + (sc >= 0 ? sc : 0);
#pragma unroll
    for (int i = 0; i < 32; ++i) tv[i] = wp[(size_t)(2 * i) * ld];
#pragma unroll
    for (int i = 0; i < 32; ++i) { const int kk = 2 * i + (lane >> 5); scr[kk * 33 + (lane & 31)] = sc >= 0 ? tv[i] : 0.f; }
    asm volatile("s_waitcnt lgkmcnt(0)" ::: "memory");
    __builtin_amdgcn_wave_barrier();
    const int c = lane & 7;
#pragma unroll
    for (int j = 0; j < 4; ++j) { const int n = (lane >> 3) + 8 * j; const float* s = scr + (8 * c) * 33 + n;
        u32x4 o; o.x = pk2(s[0 * 33], s[1 * 33]); o.y = pk2(s[2 * 33], s[3 * 33]); o.z = pk2(s[4 * 33], s[5 * 33]); o.w = pk2(s[6 * 33], s[7 * 33]);
        *(u32x4*)(WT + (size_t)(n0 + n) * K + k0 + 8 * c) = o; }
    asm volatile("s_waitcnt lgkmcnt(0)" ::: "memory");
    __builtin_amdgcn_wave_barrier();
}
__device__ __forceinline__ int rope_perm(int pp) { const int wc = pp >> 5, n = (pp >> 4) & 1, r = pp & 15; return 64 * (wc >> 1) + 32 * n + 16 * (wc & 1) + r; }
struct CmIn { __device__ int operator()(int n) const {
    if (n < 1536) return n;
    if (n < 2560) return (n & ~127) + rope_perm(n & 127);
    if (n < 4608) return n;
    if (n < 6656) return n + 32;
    if (n < 6688) return n - 6656 + 4608;
    return -1; } };
struct CmId { __device__ int operator()(int n) const { return n; } };
struct CmGU { int which; __device__ int operator()(int n) const { const int t = n >> 8, q = n & 255; return ((q >> 7) == which) ? (128 * t + (q & 127)) : -2; } };

__device__ void p0_prep_small(const Params& p, float* lds, int gw, int ngw) {
    const int lane = threadIdx.x & 63, wave = threadIdx.x >> 6;
    float* scr = lds + wave * (64 * 33);
    constexpr int I_IN = 16 * 216, I_NAO = 8 * 32, I_GLAO = 16 * 32, I_OUT = 16 * 32;
    for (int it = gw; it < I_IN + I_NAO + I_GLAO + I_OUT; it += ngw) {
        int r = it;
        if (r < I_IN) { transpose_item(p.in[I_WIN], 6688, (bf16_t*)(p.ws + WS_WIN), 1024, 64 * (r / 216), 32 * (r % 216), scr, lane, CmIn()); continue; } r -= I_IN;
        if (r < I_NAO) { transpose_item(p.in[I_WNAO], 1024, (bf16_t*)(p.ws + WS_WNAO), 512, 64 * (r / 32), 32 * (r % 32), scr, lane, CmId()); continue; } r -= I_NAO;
        if (r < I_GLAO) { transpose_item(p.in[I_WGLAO], 1024, (bf16_t*)(p.ws + WS_WGLAO), 1024, 64 * (r / 32), 32 * (r % 32), scr, lane, CmId()); continue; } r -= I_GLAO;
        transpose_item(p.in[I_WOUT], 1024, (bf16_t*)(p.ws + WS_WOUT), 1024, 64 * (r / 32), 32 * (r % 32), scr, lane, CmId());
    }
}
__device__ void prep_experts(const Params& p, float* lds, int gw, int ngw) {
    const int lane = threadIdx.x & 63, wave = threadIdx.x >> 6;
    float* scr = lds + wave * (64 * 33);
    bf16_t* WGU = (bf16_t*)((unsigned char*)p.out + OUT_WGU);
    bf16_t* WDt = (bf16_t*)((unsigned char*)p.out + OUT_WD);
    constexpr int PER_GU = 16 * 32, PER_D = 8 * 32;
    for (int it = gw; it < NEXP * (PER_GU + PER_D); it += ngw) {
        const int e = it / (PER_GU + PER_D); int r = it % (PER_GU + PER_D);
        if (r < PER_GU) {
            const int k0 = 64 * (r / 32), n0 = 32 * (r % 32);
            const int t = n0 >> 8, q = n0 & 255, which = q >> 7;
            const float* src = (which == 0 ? p.in[I_WG] : p.in[I_WU]) + (size_t)e * 1024 * 512;
            struct Cm { int base, n0; __device__ int operator()(int n) const { return base + (n - n0); } } cm{128 * t + (q & 127), n0};
            transpose_item(src, 512, WGU + (size_t)e * 1024 * 1024, 1024, k0, n0, scr, lane, cm);
        } else {
            r -= PER_GU;
            transpose_item(p.in[I_WD] + (size_t)e * 512 * 1024, 1024, WDt + (size_t)e * 1024 * 512, 512, 64 * (r / 32), 32 * (r % 32), scr, lane, CmId());
        }
    }
}

__device__ void phase0(const Params& p, float* lds, int bid, int nb) {
    const int tid = threadIdx.x;
    if (bid == 0) {
        for (int i = tid; i < 32 * 64; i += NT) ((int*)(p.ws + WS_CTL))[i] = 0;
        f32x2* RT = (f32x2*)(p.ws + WS_ROPE);
        for (int i = tid; i < 64 * 32; i += NT) {
            const int pos = i >> 5, j = i & 31;
            const float inv = exp2f(-(float)j * 0.41524101186092029f);
            const float ang = (float)pos * inv;
            double rev = (double)ang * 0.15915494309189535; rev -= floor(rev);
            const float fr = (float)rev;
            RT[i] = (f32x2){__builtin_amdgcn_cosf(fr), __builtin_amdgcn_sinf(fr)};
        }
    }
    for (int b = bid; b < 192; b += nb) p0_mod(p, lds, b);
    p0_prep_small(p, lds, bid * 8 + (tid >> 6), nb * 8);
}

__device__ void phase1(const Params& p, int bid, int nb) {
    const int lane = threadIdx.x & 63;
    const int gw = bid * 8 + (threadIdx.x >> 6), ngw = nb * 8;
    const float* MOD = (const float*)(p.ws + WS_MOD);
    bf16_t* A1 = (bf16_t*)p.out;
    const float* G = p.in[I_NAG];
    for (int row = gw; row < TA; row += ngw) {
        const float* xr; int mr;
        if (row < TL) { xr = p.in[I_X] + (size_t)row * DM; mr = row >> 11; } else { xr = p.in[I_CTX] + (size_t)(row - TL) * DM; mr = 16; }
        f32x4 v[4]; float s = 0.f;
#pragma unroll
        for (int j = 0; j < 4; ++j) { v[j] = *(const f32x4*)(xr + 4 * lane + 256 * j); s += v[j][0] * v[j][0] + v[j][1] * v[j][1] + v[j][2] * v[j][2] + v[j][3] * v[j][3]; }
        const float rstd = rsqrtf(wave_sum(s) * (1.f / DM) + EPS);
#pragma unroll
        for (int j = 0; j < 4; ++j) {
            const int c = 4 * lane + 256 * j;
            const f32x4 g = *(const f32x4*)(G + c), sh = *(const f32x4*)(MOD + mr * 6144 + c), sc = *(const f32x4*)(MOD + mr * 6144 + 1024 + c);
            f32x4 o;
#pragma unroll
            for (int i = 0; i < 4; ++i) o[i] = (v[j][i] * rstd) * g[i] * (1.f + sc[i]) + sh[i];
            u32x2 w; w.x = pk2(o[0], o[1]); w.y = pk2(o[2], o[3]);
            *(u32x2*)(A1 + (size_t)row * DM + c) = w;
        }
    }
}


struct Unit { int pm, pn; const bf16_t* a; const bf16_t* b; int aux; int rbase, nvalid; };
namespace pg8 {
#define PG8_LAS __attribute__((address_space(3)))
constexpr int BM = 256, BK = 64, HALF = 128, HTB = HALF * BK * 2  , STAGE_BYTES = 8 * HTB;
__host__ __device__ __forceinline__ int lds_byte(int r, int c) { const int st = (r >> 4) * 2 + (c >> 5), rr = r & 15, cc = c & 31, ob = rr * 64 + cc * 2; return st * 1024 + (ob ^ (((ob >> 9) & 1) << 5)); }
__host__ __device__ __forceinline__ void stage_rc(int b, int& R, int& C) { const int st = b / 1024, sb = b % 1024, swz = sb ^ (((sb >> 9) & 1) << 5); R = (st >> 1) * 16 + swz / 64; C = (st & 1) * 32 + (swz % 64) / 2; }
__host__ __device__ __forceinline__ int perm32(int rho) { const int n = rho >> 4, i = rho & 15; return 8 * (i >> 2) + 4 * n + (i & 3); }
struct NoGather { const int* rowtok; int zero_row; };
template <class Epi, class Sched, bool ALIGN_EPI = false, bool SP2 = false, bool GATHER = false>
__device__ __forceinline__ void gemm_phase(PG8_LAS unsigned char* lds, const int Kdim, const Sched& S, const Epi& E, const NoGather G = NoGather{nullptr, 0}) {
    int tid_ = threadIdx.x; asm volatile("" : "+v"(tid_));
    const int tid = tid_, wid = __builtin_amdgcn_readfirstlane(tid >> 6), lane = tid & 63, wr = wid >> 2, wc = wid & 3, fr = lane & 15, fq = lane >> 4;
    const int K = Kdim, nt = K / BK;
    static_assert(!GATHER || SP2, "gathered A staging is wired into the two-super-phase loop only");
    unsigned voffA[2], voffB[2]; int gR[2], gC[2];
#pragma unroll
    for (int i = 0; i < 2; ++i) { int R, C; stage_rc(tid * 16 + i * 8192, R, C); const int Rb = Epi::PERM ? ((R & ~31) + perm32(R & 31)) : R;
        voffA[i] = (unsigned)(R * K + C) * 2u; voffB[i] = (unsigned)(Rb * K + C) * 2u; gR[i] = R; gC[i] = C; }
    const size_t kstep = (size_t)(BK * 2);
    const size_t hstep = (size_t)HALF * K * 2;
    const size_t tstep = 2 * hstep;
    const unsigned ldsw = (unsigned)wid * 1024u;
    const int aoff = lds_byte(wr * 64 + fr, fq * 8), boff = lds_byte(wc * 32 + fr, fq * 8);
#define PG8_SA(b, h) (((b) * 2 + (h)) * HTB)
#define PG8_SB(b, h) ((4 + (b) * 2 + (h)) * HTB)
#define PG8_STAGE(bufoff, gbase, voff) do { _Pragma("unroll") for (int _i = 0; _i < 2; ++_i) \
        __builtin_amdgcn_global_load_lds((const unsigned*)((const char*)(gbase) + (voff)[_i]), (PG8_LAS unsigned*)(lds + (bufoff) + ldsw + _i * 8192), 16, 0, 0); } while (0)
#define PG8_STAGE_A(bufoff, kbase, half, usenext) do { if constexpr (GATHER) { const bool un_ = (usenext); \
        const unsigned vs_[2] = {un_ ? aoffN[half][0] : aoffC[half][0], un_ ? aoffN[half][1] : aoffC[half][1]}; PG8_STAGE(bufoff, kbase, vs_); } \
    else { PG8_STAGE(bufoff, (kbase) + (half) * hstep, voffA); } } while (0)
#define PG8_GOFF(u_, o_) do { _Pragma("unroll") for (int h_ = 0; h_ < 2; ++h_) _Pragma("unroll") for (int i_ = 0; i_ < 2; ++i_) { \
        const int rl_ = 128 * h_ + gR[i_]; const int tk_ = rl_ < (u_).nvalid ? (G.rowtok[(u_).rbase + rl_] >> 1) : G.zero_row; \
        o_[h_][i_] = (unsigned)(tk_ * K + gC[i_]) * 2u; } } while (0)
#define PG8_LDA(dst, b, h) do { _Pragma("unroll") for (int m = 0; m < 4; ++m) _Pragma("unroll") for (int k = 0; k < 2; ++k) dst[m][k] = *(const PG8_LAS bf16x8*)(lds + PG8_SA(b, h) + aoff + m * 2048 + k * 1024); } while (0)
#define PG8_LDB(dst, b, h) do { _Pragma("unroll") for (int n = 0; n < 2; ++n) _Pragma("unroll") for (int k = 0; k < 2; ++k) dst[n][k] = *(const PG8_LAS bf16x8*)(lds + PG8_SB(b, h) + boff + n * 2048 + k * 1024); } while (0)
#define PG8_MMA(ai, bj, At, Bt) do { __builtin_amdgcn_s_setprio(1); _Pragma("unroll") for (int m = 0; m < 4; ++m) _Pragma("unroll") for (int n = 0; n < 2; ++n) _Pragma("unroll") for (int k = 0; k < 2; ++k) \
        acc[ai][bj][m][n] = __builtin_amdgcn_mfma_f32_16x16x32_bf16(Bt[n][k], At[m][k], acc[ai][bj][m][n], 0, 0, 0); __builtin_amdgcn_s_setprio(0); } while (0)
#define PG8_WAIT_V(n) asm volatile("s_waitcnt vmcnt(" #n ")" ::: "memory")
#define PG8_WAIT_L(n) asm volatile("s_waitcnt lgkmcnt(" #n ")" ::: "memory")
#define PG8_BAR __builtin_amdgcn_s_barrier()
#define PG8_SCHED __builtin_amdgcn_sched_barrier(0)
    Unit cur, nxt; int ui = 0;
    if (!S.next(0, cur)) return;
    f32x4 acc[2][2][4][2];
#pragma unroll
    for (int a = 0; a < 2; ++a)
#pragma unroll
        for (int b = 0; b < 2; ++b)
#pragma unroll
            for (int m = 0; m < 4; ++m)
#pragma unroll
                for (int n = 0; n < 2; ++n) acc[a][b][m][n] = (f32x4){0.f, 0.f, 0.f, 0.f};
    bf16x8 At[4][2], B0[2][2], B1[2][2];
    const char* cA = (const char*)cur.a; const char* cB = (const char*)cur.b;
    unsigned aoffC[2][2] = {{0u, 0u}, {0u, 0u}}, aoffN[2][2] = {{0u, 0u}, {0u, 0u}};
    if constexpr (GATHER) {
        PG8_GOFF(cur, aoffC); { Unit n1; if (S.next(1, n1)) PG8_GOFF(n1, aoffN); }
        asm volatile("s_waitcnt vmcnt(0)" ::: "memory");
    }
    S.a_ready(cur);
    if constexpr (SP2) {
        PG8_STAGE(PG8_SB(0, 0), cB, voffB); PG8_STAGE(PG8_SB(0, 1), cB + hstep, voffB); PG8_STAGE_A(PG8_SA(0, 0), cA, 0, false); PG8_STAGE_A(PG8_SA(0, 1), cA, 1, false);
        if (wr == 1) PG8_BAR;
        PG8_WAIT_V(2); PG8_BAR;
        PG8_STAGE(PG8_SB(1, 0), cB + kstep, voffB); PG8_STAGE_A(PG8_SA(1, 0), cA + kstep, 0, false); PG8_STAGE(PG8_SB(1, 1), cB + hstep + kstep, voffB);
        PG8_WAIT_V(6); PG8_BAR;
    } else {
        PG8_STAGE(PG8_SB(0, 0), cB, voffB); PG8_STAGE(PG8_SA(0, 0), cA, voffA); PG8_STAGE(PG8_SB(0, 1), cB + hstep, voffB); PG8_STAGE(PG8_SA(0, 1), cA + hstep, voffA);
        if (wr == 1) PG8_BAR;
        PG8_WAIT_V(4); PG8_BAR;
        PG8_STAGE(PG8_SB(1, 0), cB + kstep, voffB); PG8_STAGE(PG8_SA(1, 0), cA + kstep, voffA); PG8_STAGE(PG8_SB(1, 1), cB + hstep + kstep, voffB);
        PG8_WAIT_V(6); PG8_BAR;
    }
    for (;;) {
        const bool has_next = S.next(ui + 1, nxt);
        const char* nA = has_next ? (const char*)nxt.a : cA; const char* nB = has_next ? (const char*)nxt.b : cB;
        for (int t = 0; t < nt; t += 2) {
            const bool last = (t == nt - 2);
            const char* a1 = cA + (size_t)(t + 1) * kstep;
            const char* a2 = last ? nA : cA + (size_t)(t + 2) * kstep; const char* b2 = last ? nB : cB + (size_t)(t + 2) * kstep;
            const char* a3 = a2 + kstep; const char* b3 = b2 + kstep;
            if (last && has_next) S.a_ready(nxt);
            if constexpr (SP2) {
            PG8_LDB(B0, 0, 0); PG8_LDB(B1, 0, 1); PG8_SCHED; PG8_LDA(At, 0, 0); PG8_STAGE_A(PG8_SA(1, 1), a1, 1, false);
            PG8_WAIT_V(8); PG8_WAIT_L(0); PG8_BAR; PG8_MMA(0, 0, At, B0); PG8_MMA(0, 1, At, B1); PG8_BAR; PG8_SCHED;
            PG8_LDA(At, 0, 1); PG8_STAGE(PG8_SB(0, 0), b2, voffB); PG8_STAGE(PG8_SB(0, 1), b2 + hstep, voffB); PG8_STAGE_A(PG8_SA(0, 0), a2, 0, last && has_next);
            PG8_WAIT_V(8); PG8_WAIT_L(0); PG8_BAR; PG8_MMA(1, 0, At, B0); PG8_MMA(1, 1, At, B1); PG8_BAR; PG8_SCHED;
            PG8_LDB(B0, 1, 0); PG8_LDB(B1, 1, 1); PG8_SCHED; PG8_LDA(At, 1, 0); PG8_STAGE_A(PG8_SA(0, 1), a2, 1, last && has_next);
            PG8_WAIT_V(8); PG8_WAIT_L(0); PG8_BAR; PG8_MMA(0, 0, At, B0); PG8_MMA(0, 1, At, B1); PG8_BAR; PG8_SCHED;
            PG8_LDA(At, 1, 1); PG8_STAGE(PG8_SB(1, 0), b3, voffB); PG8_STAGE(PG8_SB(1, 1), b3 + hstep, voffB); PG8_STAGE_A(PG8_SA(1, 0), a3, 0, last && has_next);
            PG8_WAIT_V(8); PG8_WAIT_L(0); PG8_BAR; PG8_MMA(1, 0, At, B0); PG8_MMA(1, 1, At, B1); PG8_BAR; PG8_SCHED;
            } else {
            PG8_LDB(B0, 0, 0); PG8_SCHED; PG8_LDA(At, 0, 0); PG8_STAGE(PG8_SA(1, 1), a1 + hstep, voffA);
            PG8_WAIT_L(8); PG8_BAR; PG8_WAIT_L(0); PG8_MMA(0, 0, At, B0); PG8_BAR; PG8_SCHED;
            PG8_LDB(B1, 0, 1); PG8_STAGE(PG8_SB(0, 0), b2, voffB);
            PG8_BAR; PG8_WAIT_L(0); PG8_MMA(0, 1, At, B1); PG8_BAR;
            PG8_LDA(At, 0, 1); PG8_STAGE(PG8_SA(0, 0), a2, voffA);
            PG8_BAR; PG8_WAIT_L(0); PG8_MMA(1, 0, At, B0); PG8_BAR; PG8_SCHED;
            PG8_STAGE(PG8_SB(0, 1), b2 + hstep, voffB);
            PG8_WAIT_V(6); PG8_BAR; PG8_MMA(1, 1, At, B1); PG8_BAR;
            PG8_LDB(B0, 1, 0); PG8_SCHED; PG8_LDA(At, 1, 0); PG8_STAGE(PG8_SA(0, 1), a2 + hstep, voffA);
            PG8_WAIT_L(8); PG8_BAR; PG8_WAIT_L(0); PG8_MMA(0, 0, At, B0); PG8_BAR; PG8_SCHED;
            PG8_LDB(B1, 1, 1); PG8_STAGE(PG8_SB(1, 0), b3, voffB);
            PG8_BAR; PG8_WAIT_L(0); PG8_MMA(0, 1, At, B1); PG8_BAR;
            PG8_LDA(At, 1, 1); PG8_STAGE(PG8_SA(1, 0), a3, voffA);
            PG8_BAR; PG8_WAIT_L(0); PG8_MMA(1, 0, At, B0); PG8_BAR; PG8_SCHED;
            PG8_STAGE(PG8_SB(1, 1), b3 + hstep, voffB);
            PG8_WAIT_V(6); PG8_BAR; PG8_MMA(1, 1, At, B1); PG8_BAR;
            }
        }
        if constexpr (ALIGN_EPI) { if (wr == 0) PG8_BAR; }
        if constexpr (!Epi::AFTER_DRAIN) { E(acc, cur, wr, wc, fr, fq); S.done(cur); }
        if (!has_next) break;
#pragma unroll
        for (int a = 0; a < 2; ++a)
#pragma unroll
            for (int b = 0; b < 2; ++b)
#pragma unroll
                for (int m = 0; m < 4; ++m)
#pragma unroll
                    for (int n = 0; n < 2; ++n) acc[a][b][m][n] = (f32x4){0.f, 0.f, 0.f, 0.f};
        cur = nxt; cA = nA; cB = nB; ++ui;
        if constexpr (GATHER) {
#pragma unroll
            for (int h_ = 0; h_ < 2; ++h_) { aoffC[h_][0] = aoffN[h_][0]; aoffC[h_][1] = aoffN[h_][1]; }
            { Unit n2; if (S.next(ui + 1, n2)) PG8_GOFF(n2, aoffN); }
            asm volatile("s_waitcnt vmcnt(0)" ::: "memory");
        }
        if constexpr (ALIGN_EPI) { if (wr == 1) PG8_BAR; }
    }
    PG8_WAIT_V(0);
    if constexpr (!ALIGN_EPI) { if (wr == 0) PG8_BAR; }
    PG8_BAR;
    if constexpr (Epi::AFTER_DRAIN) { E.fused(acc, cur, wr, wc, fr, fq, lds, wid, lane); S.done(cur); }
#undef PG8_SA
#undef PG8_SB
#undef PG8_STAGE
#undef PG8_LDA
#undef PG8_STAGE_A
#undef PG8_GOFF
#undef PG8_LDB
#undef PG8_MMA
#undef PG8_WAIT_V
#undef PG8_WAIT_L
#undef PG8_BAR
#undef PG8_SCHED
}

}

struct SchedIn {
    __device__ __forceinline__ void a_ready(const Unit&) const {}
    __device__ __forceinline__ void done(const Unit&) const {}
    const bf16_t* A; const bf16_t* Bt; int G, c;
    __device__ bool next(int i, Unit& u) const {
        const int L = i * G + c;
        constexpr int NLAT = 128 * 27, NCTX = 16 * 11;
        if (L >= NLAT + NCTX) return false;
        if (L < NLAT) {
            const int w = (L & 7) * (NLAT / 8) + (L >> 3), gid = w / 216, rem = w % 216;
            u.pm = gid * 8 + (rem & 7); u.pn = rem >> 3; }
        else { const int q = L - NLAT; const int j = q % 11; u.pm = 128 + q / 11; u.pn = j < 4 ? 2 + j : (j < 10 ? 8 + (j - 4) : 26); }
        u.a = A + (size_t)u.pm * 256 * 1024; u.b = Bt + (size_t)u.pn * 256 * 1024; u.aux = 0; u.rbase = 0; u.nvalid = 0;
        return true;
    }
};
struct EpiIn {
    static constexpr bool PERM = false, AFTER_DRAIN = false;
    unsigned char* ws_;
    __device__ __forceinline__ void operator()(const f32x4 (&acc)[2][2][4][2], const Unit& u, int wr, int wc, int fr, int fq) const {
        unsigned zoff = 0; asm volatile("" : "+s"(zoff)); unsigned char* ws = ws_ + zoff;
        const int pn = u.pn;
        const int row0 = u.pm * 256 + wr * 64 + fr;
        if (pn == 26) {
            float* ALR = (float*)(ws + WS_ALR);
            if (wc == 0) {
#pragma unroll
                for (int ai = 0; ai < 2; ++ai)
#pragma unroll
                    for (int m = 0; m < 4; ++m) { const int row = row0 + ai * 128 + m * 16;
#pragma unroll
                        for (int n = 0; n < 2; ++n) *(f32x4*)(ALR + (size_t)row * 32 + 16 * n + 4 * fq) = acc[ai][0][m][n]; }
            }
            return;
        }
        if (pn >= 6 && pn < 10) {
            const bool isq = pn < 8;
            bf16_t* dst = (bf16_t*)(ws + (isq ? WS_QG : WS_KG));
            const float scale = isq ? 0.08838834764831845f : 1.0f;
            const f32x2* RT = (const f32x2*)(ws + WS_ROPE);
            const int half = wc >> 1, j0 = 16 * (wc & 1) + 4 * fq;
#pragma unroll
            for (int ai = 0; ai < 2; ++ai)
#pragma unroll
                for (int m = 0; m < 4; ++m) { const int row = row0 + ai * 128 + m * 16;
                    const bool lat = row < TL; const int t = row & 2047; const int pos = lat ? (half == 0 ? (t >> 6) : (t & 63)) : 0;
                    float cs[4], sn[4];
                    { const f32x4 va = *(const f32x4*)(RT + pos * 32 + j0), vb = *(const f32x4*)(RT + pos * 32 + j0 + 2);
                      cs[0] = va[0]; sn[0] = va[1]; cs[1] = va[2]; sn[1] = va[3]; cs[2] = vb[0]; sn[2] = vb[1]; cs[3] = vb[2]; sn[3] = vb[3]; }
#pragma unroll
                    for (int bj = 0; bj < 2; ++bj) {
                        const int head = (pn & 1) * 2 + bj;
                        const f32x4 x1 = acc[ai][bj][m][0] * scale, x2 = acc[ai][bj][m][1] * scale;
                        float o1[4], o2[4];
#pragma unroll
                        for (int i = 0; i < 4; ++i) { o1[i] = x1[i] * cs[i] - x2[i] * sn[i]; o2[i] = x1[i] * sn[i] + x2[i] * cs[i]; }
                        bf16_t* rp = dst + (size_t)row * 512 + head * 128 + 64 * half + j0;
                        u32x2 w1, w2; w1.x = pk2(o1[0], o1[1]); w1.y = pk2(o1[2], o1[3]); w2.x = pk2(o2[0], o2[1]); w2.y = pk2(o2[2], o2[3]);
                        *(u32x2*)rp = w1; *(u32x2*)(rp + 32) = w2;
                    }
                    asm volatile("" ::: "memory"); }
            return;
        }
        if (pn == 4 || pn == 5) {
            bf16_t* VT = (bf16_t*)(ws + WS_VN);
#pragma unroll
            for (int ai = 0; ai < 2; ++ai)
#pragma unroll
                for (int m = 0; m < 4; ++m) { const int row = row0 + ai * 128 + m * 16;
                    size_t base; int ldt;
                    if (row < TL) { base = (size_t)(row >> 11) * 512 * 2048 + (row & 2047); ldt = 2048; }
                    else { const int rc = row - TL; base = (size_t)32 * MiB / 2 + (size_t)(rc >> 8) * 512 * 256 + (rc & 255); ldt = 256; }
#pragma unroll
                    for (int bj = 0; bj < 2; ++bj)
#pragma unroll
                        for (int n = 0; n < 2; ++n) { const int c = (pn - 4) * 256 + bj * 128 + wc * 32 + n * 16 + 4 * fq;
#pragma unroll
                            for (int i = 0; i < 4; ++i) VT[base + (size_t)(c + i) * ldt] = (bf16_t)f2bf(acc[ai][bj][m][n][i]); }
                    asm volatile("" ::: "memory"); }
            return;
        }
        bf16_t* dst; int ld, cbase; float scale = 1.f;
        if (pn < 2) { dst = (bf16_t*)(ws + WS_QN); ld = 512; cbase = pn * 256; scale = 0.125f; }
        else if (pn < 4) { dst = (bf16_t*)(ws + WS_KN); ld = 512; cbase = (pn - 2) * 256; }
        else if (pn < 14) { dst = (bf16_t*)(ws + WS_VG); ld = 1024; cbase = (pn - 10) * 256; }
        else if (pn < 18) { dst = (bf16_t*)(ws + WS_GG); ld = 1024; cbase = (pn - 14) * 256; }
        else if (pn < 22) { dst = (bf16_t*)(ws + WS_M8); ld = 1024; cbase = (pn - 18) * 256; }
        else { dst = (bf16_t*)(ws + WS_M9); ld = 1024; cbase = (pn - 22) * 256; }
#pragma unroll
        for (int ai = 0; ai < 2; ++ai)
#pragma unroll
            for (int m = 0; m < 4; ++m) { bf16_t* rp = dst + (size_t)(row0 + ai * 128 + m * 16) * ld + cbase + wc * 32 + 4 * fq;
#pragma unroll
                for (int bj = 0; bj < 2; ++bj)
#pragma unroll
                    for (int n = 0; n < 2; ++n) { const f32x4 v = acc[ai][bj][m][n] * scale; u32x2 w; w.x = pk2(v[0], v[1]); w.y = pk2(v[2], v[3]);
                        *(u32x2*)(rp + bj * 128 + n * 16) = w; } }
    }
};

constexpr int NL_RPB = 0;
constexpr int NL_KW = 2048;
constexpr int NL_VW = 75776;
constexpr int NL_K = 2048;
constexpr int NL_VT = 38912;
__device__ __forceinline__ int na_swz(int col) { return (((col >> 3) & 3) << 1) | ((col >> 1) & 1); }
__device__ void na_item(const Params& p, unsigned char* ldsg, int b, int r, int j, int h, int rsb) {
    const int lane = threadIdx.x & 63, l15 = lane & 15, q4 = lane >> 4;
    unsigned lzo = 0; asm volatile("" : "+v"(lzo));
    unsigned char __attribute__((address_space(3)))* lds = (unsigned char __attribute__((address_space(3)))*)ldsg + lzo;
    b = __builtin_amdgcn_readfirstlane(b); r = __builtin_amdgcn_readfirstlane(r); j = __builtin_amdgcn_readfirstlane(j); h = __builtin_amdgcn_readfirstlane(h); rsb = __builtin_amdgcn_readfirstlane(rsb);
    const bf16_t* QN = (const bf16_t*)(p.ws + WS_QN); const bf16_t* KN = (const bf16_t*)(p.ws + WS_KN);
    const bf16_t* VT = (const bf16_t*)(p.ws + WS_VN);
    const int rs = min(max(r - 4, 0), 24), kc0 = min(max(16 * j - 8, 0), 32);
    const int qc = 16 * j + l15, cs = min(max(qc - 8, 0), 48);
    const int qtok = b * SEQ + r * GW + qc;
    bf16x8 qf[2];
    qf[0] = *(const bf16x8*)(QN + (size_t)qtok * 512 + h * 64 + 8 * q4);
    qf[1] = *(const bf16x8*)(QN + (size_t)qtok * 512 + h * 64 + 32 + 8 * q4);
    const float __attribute__((address_space(3)))* rp = (const float __attribute__((address_space(3)))*)(lds + NL_RPB);
    const int kid = 8 * (l15 >> 2) + (l15 & 3);
    const auto krs = __builtin_amdgcn_make_buffer_rsrc((void*)KN, 0, TA * 512 * 2, 0x00020000);
    const auto vrs = __builtin_amdgcn_make_buffer_rsrc((void*)VT, 0, TA * 512 * 2, 0x00020000);
    const unsigned kwin = (unsigned)((b * SEQ + rs * GW + kc0) * 512 + h * 64) * 2u;
    const unsigned klane = (unsigned)(kid * 512 + 8 * q4) * 2u;
    const unsigned vth = (unsigned)(((b * 8 + h) * 64) * 2048 + rs * GW + kc0) * 2u;
    const unsigned vlw = (unsigned)(l15 * 2048 + 8 * q4) * 2u;
    bf16x8 fb[2][8];
    f32x4 sc[16];
    f32x4 o[4];
#pragma unroll
    for (int dt = 0; dt < 4; ++dt) o[dt] = (f32x4){0.f, 0.f, 0.f, 0.f};
#define NA_LOAD(n_) do { constexpr int n = (n_); constexpr int bq = n & 3; constexpr bool isv = (n & 4) != 0, isc = n >= 8; \
        if (!isv) { _Pragma("unroll") for (int u = 0; u < 4; ++u) { const int ti = bq * 4 + u, g = ti >> 1, T = ti & 1; \
            if (isc) { fb[n & 1][2 * u] = *(const __attribute__((address_space(3))) bf16x8*)(lds + NL_K + (32 * g + 4 * T + kid) * 144 + q4 * 16); \
                       fb[n & 1][2 * u + 1] = *(const __attribute__((address_space(3))) bf16x8*)(lds + NL_K + (32 * g + 4 * T + kid) * 144 + q4 * 16 + 64); } \
            else { const int col_ = kc0 + 4 * T + kid, fx_ = na_swz(col_); const int ro_ = NL_KW + ((rs - rsb + g) * 64 + col_) * 128; \
                fb[n & 1][2 * u] = *(const __attribute__((address_space(3))) bf16x8*)(lds + ro_ + ((q4 ^ fx_) * 16)); \
                fb[n & 1][2 * u + 1] = *(const __attribute__((address_space(3))) bf16x8*)(lds + ro_ + (((q4 + 4) ^ fx_) * 16)); } } } \
        else { _Pragma("unroll") for (int u = 0; u < 2; ++u) { const int ks = bq * 2 + u; _Pragma("unroll") for (int dt = 0; dt < 4; ++dt) \
            { if (isc) fb[n & 1][4 * u + dt] = *(const __attribute__((address_space(3))) bf16x8*)(lds + NL_VT + (16 * dt + l15) * 528 + (32 * ks + 8 * q4) * 2); \
              else fb[n & 1][4 * u + dt] = *(const __attribute__((address_space(3))) bf16x8*)(lds + NL_VW + (16 * dt + l15) * 1168 + ((rs - rsb + ks) * 64 + kc0 + 8 * q4) * 2); } } } } while (0)
#define NA_QK(n_) do { constexpr int n = (n_); constexpr int bq = n & 3; constexpr bool isc = n >= 8; \
        _Pragma("unroll") for (int u = 0; u < 4; ++u) { const int ti = bq * 4 + u; \
            f32x4 acc = (f32x4){0.f, 0.f, 0.f, 0.f}; \
            acc = __builtin_amdgcn_mfma_f32_16x16x32_bf16(fb[n & 1][2 * u], qf[0], acc, 0, 0, 0); \
            acc = __builtin_amdgcn_mfma_f32_16x16x32_bf16(fb[n & 1][2 * u + 1], qf[1], acc, 0, 0, 0); \
            if (!isc) { const int i = ti >> 1, T = ti & 1, ri = rs + i - r + 7; \
                _Pragma("unroll") for (int e = 0; e < 4; ++e) { const int kcol = kc0 + 8 * q4 + 4 * T + e; const bool valid = kcol >= cs && kcol < cs + 16; \
                    const int ci = min(max(kcol - qc + 15, 0), 30); acc[e] = valid ? acc[e] + rp[ri * 31 + ci] : -1e30f; } } \
            sc[ti] = acc; } } while (0)
#define NA_PV(n_) do { constexpr int n = (n_); constexpr int bq = n & 3; \
        _Pragma("unroll") for (int u = 0; u < 2; ++u) { const int ks = bq * 2 + u; \
            u32x4 bw; bw.x = pk2(sc[2 * ks][0], sc[2 * ks][1]); bw.y = pk2(sc[2 * ks][2], sc[2 * ks][3]); bw.z = pk2(sc[2 * ks + 1][0], sc[2 * ks + 1][1]); bw.w = pk2(sc[2 * ks + 1][2], sc[2 * ks + 1][3]); \
            const bf16x8 B = __builtin_bit_cast(bf16x8, bw); \
            _Pragma("unroll") for (int dt = 0; dt < 4; ++dt) o[dt] = __builtin_amdgcn_mfma_f32_16x16x32_bf16(fb[n & 1][4 * u + dt], B, o[dt], 0, 0, 0); } } while (0)
    NA_LOAD(0);
    NA_LOAD(1); NA_QK(0);
    NA_LOAD(2); NA_QK(1);
    NA_LOAD(3); NA_QK(2);
    NA_LOAD(4); NA_QK(3);
    float m1 = -1e30f;
#pragma unroll
    for (int ti = 0; ti < 16; ++ti) m1 = fmaxf(fmaxf(fmaxf(m1, sc[ti][0]), fmaxf(sc[ti][1], sc[ti][2])), sc[ti][3]);
    m1 = fmaxf(m1, __shfl_xor(m1, 16)); m1 = fmaxf(m1, __shfl_xor(m1, 32));
    float l = 0.f;
#pragma unroll
    for (int ti = 0; ti < 16; ++ti) {
#pragma unroll
        for (int e = 0; e < 4; ++e) { const float pe = __expf(sc[ti][e] - m1); sc[ti][e] = pe; l += pe; }
    }
    NA_LOAD(5); NA_PV(4);
    NA_LOAD(6); NA_PV(5);
    NA_LOAD(7); NA_PV(6);
    NA_PV(7);
    __syncthreads();
    { int tl = threadIdx.x; asm volatile("" : "+v"(tl));
      const bf16_t* VTC = VT + (size_t)32 * MiB / 2;
#pragma unroll
      for (int q = 0; q < 4; ++q) { const int c = tl + NT * q;
          const u32x4 kv = *(const u32x4*)(KN + ((size_t)TL + b * CTX + (c >> 3)) * 512 + h * 64 + (c & 7) * 8);
          const u32x4 vv = *(const u32x4*)(VTC + ((size_t)(b * 8 + h) * 64 + (c >> 5)) * 256 + (c & 31) * 8);
          *(__attribute__((address_space(3))) u32x4*)(lds + NL_K + (c >> 3) * 144 + (c & 7) * 16) = kv;
          *(__attribute__((address_space(3))) u32x4*)(lds + NL_VT + (c >> 5) * 528 + (c & 31) * 16) = vv; } }
    __syncthreads();
    NA_LOAD(8);
    NA_LOAD(9); NA_QK(8);
    NA_LOAD(10); NA_QK(9);
    NA_LOAD(11); NA_QK(10);
    NA_LOAD(12); NA_QK(11);
    float m2 = -1e30f;
#pragma unroll
    for (int ti = 0; ti < 16; ++ti) m2 = fmaxf(fmaxf(fmaxf(m2, sc[ti][0]), fmaxf(sc[ti][1], sc[ti][2])), sc[ti][3]);
    m2 = fmaxf(m2, __shfl_xor(m2, 16)); m2 = fmaxf(m2, __shfl_xor(m2, 32));
    const float mm = fmaxf(m1, m2), al = __expf(m1 - mm);
    l *= al;
#pragma unroll
    for (int dt = 0; dt < 4; ++dt) o[dt] = o[dt] * al;
#pragma unroll
    for (int ti = 0; ti < 16; ++ti) {
#pragma unroll
        for (int e = 0; e < 4; ++e) { const float pe = __expf(sc[ti][e] - mm); sc[ti][e] = pe; l += pe; }
    }
    NA_LOAD(13); NA_PV(12);
    NA_LOAD(14); NA_PV(13);
    NA_LOAD(15); NA_PV(14);
    NA_PV(15);
#undef NA_LOAD
#undef NA_QK
#undef NA_PV
    l += __shfl_xor(l, 16); l += __shfl_xor(l, 32);
    const float il = 1.f / l;
    bf16_t* ONA = (bf16_t*)(p.ws + WS_ONA);
#pragma unroll
    for (int dt = 0; dt < 4; ++dt) { u32x2 w; w.x = pk2(o[dt][0] * il, o[dt][1] * il); w.y = pk2(o[dt][2] * il, o[dt][3] * il);
        *(u32x2*)(ONA + (size_t)qtok * 512 + h * 64 + 16 * dt + 4 * q4) = w; }
}

#ifndef LAS
#define LAS __attribute__((address_space(3)))
#endif
constexpr int GL_Q = 0;
constexpr int GL_K = 17408;
constexpr int GL_KT = 34816;
constexpr int GL_VR = 53248;
constexpr int GL_VT = 69632;
constexpr int GL_ATT = 88064;
constexpr int GL_O = 97280;
constexpr int GL_ALR = 114688;
constexpr int GL_SEG = 118784;
constexpr int GL_D = 120832;
__device__ __forceinline__ int gla_row0(int b, int dir, int n) {
    if (n < 4) return TL + b * CTX + (dir == 0 ? n : 3 - n) * 64;
    return b * SEQ + (dir == 0 ? n - 4 : 35 - n) * 64;
}
__device__ void gla_chain(const Params& p, unsigned char* ldsg, int item) {
    LAS unsigned char* lds = (LAS unsigned char*)ldsg;
    const int tid = threadIdx.x, lane = tid & 63, wave = tid >> 6;
    const int slice = item & 1, dir = (item >> 1) & 1, h = (item >> 2) & 3, b = item >> 4;
    const int d_ = tid & 127, seg = tid >> 7, l15 = lane & 15, q4 = lane >> 4;
    const bf16_t* QG = (const bf16_t*)(p.ws + WS_QG); const bf16_t* KG = (const bf16_t*)(p.ws + WS_KG); const bf16_t* VG = (const bf16_t*)(p.ws + WS_VG);
    const float* ALR = (const float*)(p.ws + WS_ALR);
    bf16_t* OX = (bf16_t*)((unsigned char*)p.out + (dir == 0 ? 0 : (size_t)64 * MiB));
    float w2[16];
#pragma unroll
    for (int r = 0; r < 16; ++r) w2[r] = p.in[I_WA2][(dir * 16 + r) * 512 + h * 128 + d_];
    const float b2 = p.in[I_BA2][dir * 512 + h * 128 + d_];
    f32x4 S[8];
#pragma unroll
    for (int i = 0; i < 8; ++i) S[i] = (f32x4){0.f, 0.f, 0.f, 0.f};
    u32x4 pq[2], pk[2], pv[2], pa;
    {
        const int r0 = gla_row0(b, dir, 0);
#pragma unroll
        for (int j = 0; j < 2; ++j) { const int c = tid + 512 * j, row = c >> 4, c16 = c & 15;
            pq[j] = (u32x4){0u, 0u, 0u, 0u};
            pk[j] = *(const u32x4*)(KG + (size_t)(r0 + row) * 512 + h * 128 + c16 * 8);
            pv[j] = *(const u32x4*)(VG + (size_t)(r0 + row) * 1024 + h * 256 + slice * 128 + c16 * 8); }
        pa = (u32x4){0u, 0u, 0u, 0u};
        if (tid < 256) pa = *(const u32x4*)(ALR + (size_t)(r0 + (tid >> 2)) * 32 + dir * 16 + (tid & 3) * 4);
    }
    for (int n = 0; n < 36; ++n) {
        const bool lat = n >= 4;
        const int r0 = gla_row0(b, dir, n);
#pragma unroll
        for (int j = 0; j < 2; ++j) { const int c = tid + 512 * j, row = c >> 4, c16 = c & 15;
            *(LAS u32x4*)(lds + GL_Q + row * 272 + c16 * 16) = pq[j];
            *(LAS u32x4*)(lds + GL_K + row * 272 + c16 * 16) = pk[j];
            *(LAS u32x4*)(lds + GL_VR + row * 256 + c16 * 16) = pv[j]; }
        if (tid < 256) *(LAS u32x4*)(lds + GL_ALR + (tid >> 2) * 64 + (tid & 3) * 16) = pa;
        if (n + 1 < 36) {
            const int r1 = gla_row0(b, dir, n + 1); const bool lat1 = n + 1 >= 4;
#pragma unroll
            for (int j = 0; j < 2; ++j) { const int c = tid + 512 * j, row = c >> 4, c16 = c & 15;
                if (lat1) pq[j] = *(const u32x4*)(QG + (size_t)(r1 + row) * 512 + h * 128 + c16 * 8);
                pk[j] = *(const u32x4*)(KG + (size_t)(r1 + row) * 512 + h * 128 + c16 * 8);
                pv[j] = *(const u32x4*)(VG + (size_t)(r1 + row) * 1024 + h * 256 + slice * 128 + c16 * 8); }
            if (tid < 256) pa = *(const u32x4*)(ALR + (size_t)(r1 + (tid >> 2)) * 32 + dir * 16 + (tid & 3) * 4);
        }
        __syncthreads();
        float g[16];
#pragma unroll
        for (int i = 0; i < 16; ++i) {
            const int t = 16 * seg + i;
            float z = b2;
#pragma unroll
            for (int r4 = 0; r4 < 4; ++r4) { const f32x4 a = *(const LAS f32x4*)(lds + GL_ALR + t * 64 + r4 * 16);
                z += a[0] * w2[4 * r4] + a[1] * w2[4 * r4 + 1] + a[2] * w2[4 * r4 + 2] + a[3] * w2[4 * r4 + 3]; }
            const float ls = fminf(z, 0.f) - __logf(1.f + __expf(-fabsf(z)));
            g[i] = ls * (1.f / 16.f);
        }
        if (dir == 0) {
#pragma unroll
            for (int i = 1; i < 16; ++i) g[i] += g[i - 1];
        } else {
#pragma unroll
            for (int i = 14; i >= 0; --i) g[i] += g[i + 1];
        }
        *(LAS float*)(lds + GL_SEG + (seg * 128 + d_) * 4) = dir == 0 ? g[15] : g[0];
        __syncthreads();
        {
            const float s0 = *(const LAS float*)(lds + GL_SEG + (0 * 128 + d_) * 4), s1 = *(const LAS float*)(lds + GL_SEG + (1 * 128 + d_) * 4),
                        s2 = *(const LAS float*)(lds + GL_SEG + (2 * 128 + d_) * 4), s3 = *(const LAS float*)(lds + GL_SEG + (3 * 128 + d_) * 4);
            float off;
            if (dir == 0) off = (seg > 0 ? s0 : 0.f) + (seg > 1 ? s1 : 0.f) + (seg > 2 ? s2 : 0.f);
            else off = (seg < 1 ? s1 : 0.f) + (seg < 2 ? s2 : 0.f) + (seg < 3 ? s3 : 0.f);
            if (seg == 0) *(LAS float*)(lds + GL_D + d_ * 4) = __expf((s0 + s1) + (s2 + s3));
            unsigned kt[8], vt[8];
#pragma unroll
            for (int i = 0; i < 16; ++i) {
                const int t = 16 * seg + i;
                const float bb = g[i] + off, e1 = __expf(bb), e2 = __builtin_amdgcn_rcpf(e1);
                if (lat) { LAS unsigned short* qp = (LAS unsigned short*)(lds + GL_Q + t * 272 + d_ * 2); *qp = (unsigned short)f2bf(bf2f(*qp) * e1); }
                LAS unsigned short* kp = (LAS unsigned short*)(lds + GL_K + t * 272 + d_ * 2);
                const unsigned kb = f2bf(bf2f(*kp) * e2);
                if (lat) *kp = (unsigned short)kb;
                const unsigned vb = *(const LAS unsigned short*)(lds + GL_VR + t * 256 + d_ * 2);
                if (i & 1) { kt[i >> 1] |= kb << 16; vt[i >> 1] |= vb << 16; } else { kt[i >> 1] = kb; vt[i >> 1] = vb; }
            }
            *(LAS u32x4*)(lds + GL_KT + d_ * 144 + seg * 32) = (u32x4){kt[0], kt[1], kt[2], kt[3]};
            *(LAS u32x4*)(lds + GL_KT + d_ * 144 + seg * 32 + 16) = (u32x4){kt[4], kt[5], kt[6], kt[7]};
            *(LAS u32x4*)(lds + GL_VT + d_ * 144 + seg * 32) = (u32x4){vt[0], vt[1], vt[2], vt[3]};
            *(LAS u32x4*)(lds + GL_VT + d_ * 144 + seg * 32 + 16) = (u32x4){vt[4], vt[5], vt[6], vt[7]};
        }
        __syncthreads();
        if (lat) {
            const int tt = wave >> 1, ss0 = (wave & 1) * 2;
            f32x4 a0 = (f32x4){0.f, 0.f, 0.f, 0.f}, a1 = (f32x4){0.f, 0.f, 0.f, 0.f};
#pragma unroll
            for (int kk = 0; kk < 4; ++kk) {
                const bf16x8 A = *(const LAS bf16x8*)(lds + GL_Q + (16 * tt + l15) * 272 + (32 * kk + 8 * q4) * 2);
                const bf16x8 B0 = *(const LAS bf16x8*)(lds + GL_K + (16 * ss0 + l15) * 272 + (32 * kk + 8 * q4) * 2);
                const bf16x8 B1 = *(const LAS bf16x8*)(lds + GL_K + (16 * (ss0 + 1) + l15) * 272 + (32 * kk + 8 * q4) * 2);
                a0 = __builtin_amdgcn_mfma_f32_16x16x32_bf16(A, B0, a0, 0, 0, 0);
                a1 = __builtin_amdgcn_mfma_f32_16x16x32_bf16(A, B1, a1, 0, 0, 0);
            }
#pragma unroll
            for (int r = 0; r < 4; ++r) {
                const int t = 16 * tt + 4 * q4 + r, sA = 16 * ss0 + l15, sB = sA + 16;
                const bool kA = dir == 0 ? (sA <= t) : (sA >= t), kB = dir == 0 ? (sB <= t) : (sB >= t);
                *(LAS unsigned short*)(lds + GL_ATT + t * 144 + sA * 2) = (unsigned short)f2bf(kA ? a0[r] : 0.f);
                *(LAS unsigned short*)(lds + GL_ATT + t * 144 + sB * 2) = (unsigned short)f2bf(kB ? a1[r] : 0.f);
            }
        }
        __syncthreads();
        {
            bf16x8 vB[2];
#pragma unroll
            for (int kk = 0; kk < 2; ++kk) vB[kk] = *(const LAS bf16x8*)(lds + GL_VT + (16 * wave + l15) * 144 + (32 * kk + 8 * q4) * 2);
            if (lat) {
                f32x4 o[4];
#pragma unroll
                for (int tt = 0; tt < 4; ++tt) o[tt] = (f32x4){0.f, 0.f, 0.f, 0.f};
#pragma unroll
                for (int tt = 0; tt < 4; ++tt)
#pragma unroll
                    for (int kk = 0; kk < 2; ++kk) { const bf16x8 A = *(const LAS bf16x8*)(lds + GL_ATT + (16 * tt + l15) * 144 + (32 * kk + 8 * q4) * 2);
                        o[tt] = __builtin_amdgcn_mfma_f32_16x16x32_bf16(A, vB[kk], o[tt], 0, 0, 0); }
#pragma unroll
                for (int kk = 0; kk < 4; ++kk) {
                    const f32x4 sa = S[2 * kk], sb = S[2 * kk + 1];
                    u32x4 bw; bw.x = pk2(sa[0], sa[1]); bw.y = pk2(sa[2], sa[3]); bw.z = pk2(sb[0], sb[1]); bw.w = pk2(sb[2], sb[3]);
                    const bf16x8 Bs = __builtin_bit_cast(bf16x8, bw);
#pragma unroll
                    for (int tt = 0; tt < 4; ++tt) {
                        const u32x2 lo = *(const LAS u32x2*)(lds + GL_Q + (16 * tt + l15) * 272 + (32 * kk + 4 * q4) * 2);
                        const u32x2 hi = *(const LAS u32x2*)(lds + GL_Q + (16 * tt + l15) * 272 + (32 * kk + 16 + 4 * q4) * 2);
                        const bf16x8 A = __builtin_bit_cast(bf16x8, (u32x4){lo.x, lo.y, hi.x, hi.y});
                        o[tt] = __builtin_amdgcn_mfma_f32_16x16x32_bf16(A, Bs, o[tt], 0, 0, 0);
                    }
                }
#pragma unroll
                for (int tt = 0; tt < 4; ++tt)
#pragma unroll
                    for (int r = 0; r < 4; ++r) *(LAS unsigned short*)(lds + GL_O + (16 * tt + 4 * q4 + r) * 272 + (16 * wave + l15) * 2) = (unsigned short)f2bf(o[tt][r]);
            }
#pragma unroll
            for (int dt = 0; dt < 8; ++dt) {
#pragma unroll
                for (int kk = 0; kk < 2; ++kk) { const bf16x8 A = *(const LAS bf16x8*)(lds + GL_KT + (16 * dt + l15) * 144 + (32 * kk + 8 * q4) * 2);
                    S[dt] = __builtin_amdgcn_mfma_f32_16x16x32_bf16(A, vB[kk], S[dt], 0, 0, 0); }
                const f32x4 Dv = *(const LAS f32x4*)(lds + GL_D + (16 * dt + 4 * q4) * 4);
                S[dt] = S[dt] * Dv;
            }
        }
        __syncthreads();
        if (lat) {
#pragma unroll
            for (int j = 0; j < 2; ++j) { const int c = tid + 512 * j, row = c >> 4, c16 = c & 15;
                const u32x4 v = *(const LAS u32x4*)(lds + GL_O + row * 272 + c16 * 16);
                *(u32x4*)(OX + (size_t)(r0 + row) * 1024 + h * 256 + slice * 128 + c16 * 8) = v; }
        }
    }
    __syncthreads();
}

__device__ void phase3(const Params& p, unsigned char* lds, int bid, int nb) {
    for (int it = bid; it < 256; it += nb) gla_chain(p, lds, it);
    {
        const bool xm = (nb & 7) == 0;
        const int wv = __builtin_amdgcn_readfirstlane(threadIdx.x >> 6), tid = threadIdx.x;
        const int s0 = xm ? (bid >> 3) : bid, ds = xm ? (nb >> 3) : nb, smax = xm ? 32 : 256;
        const bf16_t* KN = (const bf16_t*)(p.ws + WS_KN); const bf16_t* VTW = (const bf16_t*)(p.ws + WS_VN);
        const float* RPB = p.in[I_RPB];
        for (int sl = s0; sl < smax; sl += ds) {
            const int slab = xm ? ((((bid & 7) + 8 * (sl >> 4)) << 4) | (sl & 15)) : sl;
            const int b = slab >> 4, h = (slab >> 1) & 7, half = slab & 1;
            __syncthreads();
            for (int i = tid; i < 465; i += NT) ((float*)(lds + NL_RPB))[i] = RPB[h * 465 + i];
            _Pragma("nounroll") for (int it = 0; it < 8; ++it) {
                const int r0 = 16 * half + 2 * it, rsb = min(max(r0 - 4, 0), 24), nrows = min(9, 32 - rsb);
                __syncthreads();
                int t2 = tid; asm volatile("" : "+v"(t2));
#pragma unroll
                for (int q = 0; q < 9; ++q) { const int c = t2 + NT * q, slot = c >> 9, tok = (c >> 3) & 63, ch = c & 7;
                    if (slot < nrows) { const u32x4 kv = *(const u32x4*)(KN + ((size_t)b * SEQ + (rsb + slot) * GW + tok) * 512 + h * 64 + ch * 8);
                        *(u32x4*)(lds + NL_KW + (slot * 64 + tok) * 128 + ((ch ^ na_swz(tok)) * 16)) = kv;
                        const u32x4 vv = *(const u32x4*)(VTW + ((size_t)(b * 8 + h) * 64 + tok) * 2048 + (rsb + slot) * GW + ch * 8);
                        *(u32x4*)(lds + NL_VW + tok * 1168 + (slot * 64 + ch * 8) * 2) = vv; } }
                __syncthreads();
                const int idx = it * 8 + wv; na_item(p, lds, b, 16 * half + (idx >> 2), idx & 3, h, rsb);
            }
        }
    }
    __syncthreads();
}

__device__ void phase4r(const Params& p, int bid, int nb) {
    const int lane = threadIdx.x & 63;
    const int gw = bid * 8 + (threadIdx.x >> 6), ngw = nb * 8;
    const bf16_t* OF = (const bf16_t*)p.out; const bf16_t* OB = (const bf16_t*)((const unsigned char*)p.out + (size_t)64 * MiB); bf16_t* GG = (bf16_t*)(p.ws + WS_GG);
    const float* gng = p.in[I_GNG];
    for (int row = gw; row < TL; row += ngw) {
        f32x4 v[4]; float s = 0.f;
        {
            const u32x4* fp = (const u32x4*)(OF + (size_t)row * 1024 + 16 * lane); const u32x4* bp = (const u32x4*)(OB + (size_t)row * 1024 + 16 * lane);
            const u32x4 f0 = fp[0], f1 = fp[1], b0 = bp[0], b1 = bp[1];
            v[0] = (f32x4){bflo(f0.x) + bflo(b0.x), bfhi(f0.x) + bfhi(b0.x), bflo(f0.y) + bflo(b0.y), bfhi(f0.y) + bfhi(b0.y)};
            v[1] = (f32x4){bflo(f0.z) + bflo(b0.z), bfhi(f0.z) + bfhi(b0.z), bflo(f0.w) + bflo(b0.w), bfhi(f0.w) + bfhi(b0.w)};
            v[2] = (f32x4){bflo(f1.x) + bflo(b1.x), bfhi(f1.x) + bfhi(b1.x), bflo(f1.y) + bflo(b1.y), bfhi(f1.y) + bfhi(b1.y)};
            v[3] = (f32x4){bflo(f1.z) + bflo(b1.z), bfhi(f1.z) + bfhi(b1.z), bflo(f1.w) + bflo(b1.w), bfhi(f1.w) + bfhi(b1.w)};
#pragma unroll
            for (int j = 0; j < 4; ++j) s += v[j][0] * v[j][0] + v[j][1] * v[j][1] + v[j][2] * v[j][2] + v[j][3] * v[j][3];
        }
        s += __shfl_xor(s, 1); s += __shfl_xor(s, 2); s += __shfl_xor(s, 4); s += __shfl_xor(s, 8);
        const float rstd = rsqrtf(s * (1.f / 256.f) + EPS);
        u32x4* gp = (u32x4*)(GG + (size_t)row * 1024 + 16 * lane);
        const u32x4 g0 = gp[0], g1 = gp[1];
        const unsigned gu[8] = {g0.x, g0.y, g0.z, g0.w, g1.x, g1.y, g1.z, g1.w};
        unsigned ou[8];
#pragma unroll
        for (int j = 0; j < 8; ++j) {
            const int c = (16 * lane + 2 * j) & 255;
            const float a0 = v[j >> 1][(2 * j) & 3] * rstd * gng[c] * siluf_(bflo(gu[j]));
            const float a1 = v[j >> 1][(2 * j + 1) & 3] * rstd * gng[c + 1] * siluf_(bfhi(gu[j]));
            ou[j] = pk2(a0, a1);
        }
        gp[0] = (u32x4){ou[0], ou[1], ou[2], ou[3]}; gp[1] = (u32x4){ou[4], ou[5], ou[6], ou[7]};
    }
}

struct SchedSq {
    __device__ __forceinline__ void a_ready(const Unit&) const {}
    __device__ __forceinline__ void done(const Unit&) const {}
    const bf16_t* A0; const bf16_t* B0; int K0; const bf16_t* A1; const bf16_t* B1; int K1; int passes; int G, c;
    __device__ bool next(int i, Unit& u) const {
        const int s = i % passes;
        if ((G & 7) == 0) {
            const int t = (i / passes) * (G >> 3) + (c >> 3); if (t >= 64) return false;
            u.pm = 16 * (c & 7) + (t >> 2); u.pn = t & 3;
        } else { const int L = (i / passes) * G + c; if (L >= 512) return false; u.pm = L >> 2; u.pn = L & 3; }
        u.aux = s; u.rbase = 0; u.nvalid = 0;
        if (s == 0) { u.a = A0 + (size_t)u.pm * 256 * K0; u.b = B0 + (size_t)u.pn * 256 * K0; }
        else { u.a = A1 + (size_t)u.pm * 256 * K1; u.b = B1 + (size_t)u.pn * 256 * K1; }
        return true;
    }
};
struct EpiMerge {
    static constexpr bool PERM = false, AFTER_DRAIN = false;
    unsigned char* ws; int pass;
    __device__ __forceinline__ void operator()(const f32x4 (&acc)[2][2][4][2], const Unit& u, int wr, int wc, int fr, int fq) const {
        bf16_t* M8 = (bf16_t*)(ws + WS_M8); const bf16_t* M9 = (const bf16_t*)(ws + WS_M9);
        const int row0 = u.pm * 256 + wr * 64 + fr, col0 = u.pn * 256 + wc * 32 + 4 * fq;
        u32x2 g8[2][2][2], g9[2][2][2];
#define EM_LOAD(k_, buf_) do { _Pragma("unroll") for (int bj = 0; bj < 2; ++bj) _Pragma("unroll") for (int n = 0; n < 2; ++n) { \
            const size_t off = (size_t)(row0 + ((k_) >> 2) * 128 + ((k_) & 3) * 16) * 1024 + col0 + bj * 128 + n * 16; \
            g8[buf_][bj][n] = *(const u32x2*)(M8 + off); if (pass != 0) g9[buf_][bj][n] = *(const u32x2*)(M9 + off); } } while (0)
#define EM_STORE(k_, buf_) do { _Pragma("unroll") for (int bj = 0; bj < 2; ++bj) _Pragma("unroll") for (int n = 0; n < 2; ++n) { \
            const int ai = (k_) >> 2, m = (k_) & 3; \
            const size_t off = (size_t)(row0 + ai * 128 + m * 16) * 1024 + col0 + bj * 128 + n * 16; \
            const f32x4 v = acc[ai][bj][m][n]; const u32x2 g = g8[buf_][bj][n]; u32x2 w; \
            if (pass == 0) { w.x = pk2(v[0] * sigmoidf_(bflo(g.x)), v[1] * sigmoidf_(bfhi(g.x))); w.y = pk2(v[2] * sigmoidf_(bflo(g.y)), v[3] * sigmoidf_(bfhi(g.y))); } \
            else { const u32x2 q9 = g9[buf_][bj][n]; \
                w.x = pk2(bflo(g.x) + v[0] * sigmoidf_(bflo(q9.x)), bfhi(g.x) + v[1] * sigmoidf_(bfhi(q9.x))); \
                w.y = pk2(bflo(g.y) + v[2] * sigmoidf_(bflo(q9.y)), bfhi(g.y) + v[3] * sigmoidf_(bfhi(q9.y))); } \
            *(u32x2*)(M8 + off) = w; } } while (0)
        EM_LOAD(0, 0); EM_LOAD(1, 1);
        EM_STORE(0, 0); EM_LOAD(2, 0);
        EM_STORE(1, 1); EM_LOAD(3, 1);
        EM_STORE(2, 0); EM_LOAD(4, 0);
        EM_STORE(3, 1); EM_LOAD(5, 1);
        EM_STORE(4, 0); EM_LOAD(6, 0);
        EM_STORE(5, 1); EM_LOAD(7, 1);
        EM_STORE(6, 0);
        EM_STORE(7, 1);
#undef EM_LOAD
#undef EM_STORE
    }
};
struct EpiOut {
    static constexpr bool PERM = false, AFTER_DRAIN = false;
    const float* x; const float* MOD; float* HMID; float* ROWSS;
    __device__ __forceinline__ void operator()(const f32x4 (&acc)[2][2][4][2], const Unit& u, int wr, int wc, int fr, int fq) const {
        const int row0 = u.pm * 256 + wr * 64 + fr, col0 = u.pn * 256 + wc * 32 + 4 * fq;
        const int b = (u.pm * 256) >> 11;
        float ss[2][4];
#pragma unroll
        for (int ai = 0; ai < 2; ++ai)
#pragma unroll
            for (int m = 0; m < 4; ++m) ss[ai][m] = 0.f;
#pragma unroll
        for (int bj = 0; bj < 2; ++bj)
#pragma unroll
            for (int n = 0; n < 2; ++n) {
                const int c = col0 + bj * 128 + n * 16;
                const f32x4 g1 = *(const f32x4*)(MOD + b * 6144 + 2048 + c);
                f32x4 xin[2][4];
#pragma unroll
                for (int ai = 0; ai < 2; ++ai)
#pragma unroll
                    for (int m = 0; m < 4; ++m) xin[ai][m] = *(const f32x4*)(x + (size_t)(row0 + ai * 128 + m * 16) * 1024 + c);
#pragma unroll
                for (int ai = 0; ai < 2; ++ai)
#pragma unroll
                    for (int m = 0; m < 4; ++m) { const size_t off = (size_t)(row0 + ai * 128 + m * 16) * 1024 + c;
                        const f32x4 hv = xin[ai][m] + g1 * acc[ai][bj][m][n];
                        *(f32x4*)(HMID + off) = hv;
                        ss[ai][m] += (hv[0] * hv[0] + hv[1] * hv[1]) + (hv[2] * hv[2] + hv[3] * hv[3]); }
            }
#pragma unroll
        for (int ai = 0; ai < 2; ++ai)
#pragma unroll
            for (int m = 0; m < 4; ++m) { float v = ss[ai][m]; v += __shfl_xor(v, 16); v += __shfl_xor(v, 32);
                if (fq == 0) ROWSS[(size_t)(row0 + ai * 128 + m * 16) * 16 + u.pn * 4 + wc] = v; }
    }
};

constexpr int P5_WG = 131072;
__device__ void phase5(const Params& p, unsigned char* ldsg, int bid, int nb) {
    LAS unsigned char* lds = (LAS unsigned char*)ldsg;
    const int tid = threadIdx.x, lane = tid & 63, wave = tid >> 6, l15 = lane & 15, q4 = lane >> 4;
    const float* MOD = (const float*)(p.ws + WS_MOD); const float* HMID = (const float*)(p.ws + WS_HMID); const float* ROWSS = (const float*)(p.ws + WS_ROWSS);
    bf16_t* FL = (bf16_t*)(p.ws + WS_FL);
    const float* G = p.in[I_NFG]; const float* WGR = p.in[I_WGRP]; const float* WEX = p.in[I_WEXP]; const float* BGR = p.in[I_BGRP]; const float* BEX = p.in[I_BEXP];
    int* cnt = (int*)(p.ws + WS_CTL) + CW_CNT;
    if (bid == 0 && tid < 128) *(u32x4*)(FL + (size_t)TL * DM + tid * 8) = (u32x4){0u, 0u, 0u, 0u};
    for (int c = tid; c < 8192; c += NT) {
        const int k = c >> 3, o4 = c & 7;
        const f32x4 w = *(const f32x4*)(WEX + (size_t)k * 32 + 4 * o4);
#pragma unroll
        for (int i = 0; i < 4; ++i) *(LAS float*)(lds + ((((k >> 2) * 32 + 4 * o4 + i) * 4 + (k & 3)) * 4)) = w[i];
    }
    for (int c = tid; c < 1024; c += NT) *(LAS f32x4*)(lds + P5_WG + c * 16) = *(const f32x4*)(WGR + (size_t)c * 4);
    __syncthreads();
    for (int tile0 = bid * 8; tile0 < TL / 16; tile0 += nb * 8) {
        const int tile = tile0 + wave;
        const int tok = tile * 16 + l15, b = (tile * 16) >> 11;
        float rstd;
        { const f32x4 r4 = *(const f32x4*)(ROWSS + (size_t)tok * 16 + 4 * q4); float v = (r4[0] + r4[1]) + (r4[2] + r4[3]); v += __shfl_xor(v, 16); v += __shfl_xor(v, 32);
          rstd = rsqrtf(v * (1.f / DM) + EPS); }
        f32x4 acc0 = (f32x4){0.f, 0.f, 0.f, 0.f}, acc1 = (f32x4){0.f, 0.f, 0.f, 0.f};
        float lg[4] = {0.f, 0.f, 0.f, 0.f};
        const float* hrow = HMID + (size_t)tok * DM + 4 * q4; const float* modb = MOD + b * 6144 + 4 * q4; const float* gq = G + 4 * q4;
        bf16_t* flrow = FL + (size_t)tok * DM + 4 * q4;
        f32x4 hv[2][2], gv[2][2], sh[2][2], sc[2][2];
#define P5_LOAD(gn_, buf_) do { _Pragma("unroll") for (int uu = 0; uu < 2; ++uu) { const int c = 16 * (2 * (gn_) + uu); \
            hv[buf_][uu] = *(const f32x4*)(hrow + c); gv[buf_][uu] = *(const f32x4*)(gq + c); sh[buf_][uu] = *(const f32x4*)(modb + 3072 + c); sc[buf_][uu] = *(const f32x4*)(modb + 4096 + c); } } while (0)
        P5_LOAD(0, 0);
#define P5_COMP(gn_, bf_) do { u32x2 wst[2]; \
            _Pragma("unroll") for (int uu = 0; uu < 2; ++uu) { const int u = 2 * (gn_) + uu; f32x4 f; \
                _Pragma("unroll") for (int i = 0; i < 4; ++i) f[i] = (hv[bf_][uu][i] * rstd) * gv[bf_][uu][i] * (1.f + sc[bf_][uu][i]) + sh[bf_][uu][i]; \
                wst[uu].x = pk2(f[0], f[1]); wst[uu].y = pk2(f[2], f[3]); \
                const f32x4 w0 = *(const LAS f32x4*)(lds + ((4 * u + q4) * 32 + l15) * 16), w1 = *(const LAS f32x4*)(lds + ((4 * u + q4) * 32 + 16 + l15) * 16); \
                _Pragma("unroll") for (int e = 0; e < 4; ++e) { \
                    acc0 = __builtin_amdgcn_mfma_f32_16x16x4f32(f[e], w0[e], acc0, 0, 0, 0); \
                    acc1 = __builtin_amdgcn_mfma_f32_16x16x4f32(f[e], w1[e], acc1, 0, 0, 0); \
                    const f32x4 wg = *(const LAS f32x4*)(lds + P5_WG + (16 * u + 4 * q4 + e) * 16); \
                    lg[0] += f[e] * wg[0]; lg[1] += f[e] * wg[1]; lg[2] += f[e] * wg[2]; lg[3] += f[e] * wg[3]; } } \
            _Pragma("unroll") for (int uu = 0; uu < 2; ++uu) *(u32x2*)(flrow + 16 * (2 * (gn_) + uu)) = wst[uu]; } while (0)
#pragma unroll 1
        for (int g2 = 0; g2 < 16; ++g2) {
            P5_LOAD(2 * g2 + 1, 1);
            P5_COMP(2 * g2, 0);
            if (g2 < 15) P5_LOAD(2 * g2 + 2, 0);
            P5_COMP(2 * g2 + 1, 1);
        }
#undef P5_COMP
#undef P5_LOAD
#pragma unroll
        for (int e = 0; e < 4; ++e) { float v = lg[e]; v += __shfl_xor(v, 16); v += __shfl_xor(v, 32); lg[e] = v + BGR[e]; }
        __syncthreads();
        LAS float* sl = (LAS float*)(lds + wave * (16 * 33 * 4));
        LAS int* bcnt = (LAS int*)(lds + 32768);
        if (tid < 32) bcnt[tid] = 0;
#pragma unroll
        for (int r = 0; r < 4; ++r) { sl[(4 * q4 + r) * 33 + l15] = acc0[r]; sl[(4 * q4 + r) * 33 + 16 + l15] = acc1[r]; }
        __syncthreads();
        int x1 = 0, x2 = 0, lr1 = 0, lr2 = 0; float w1 = 0.f, w2 = 0.f;
        if (lane < 16) {
            int grp = 0; float gm = lg[0];
#pragma unroll
            for (int e = 1; e < 4; ++e) if (lg[e] > gm) { gm = lg[e]; grp = e; }
            float gs = 0.f;
#pragma unroll
            for (int e = 0; e < 4; ++e) gs += __expf(lg[e] - gm);
            const float pgrp = 1.f / gs;
            float l8[8];
#pragma unroll
            for (int e = 0; e < 8; ++e) l8[e] = sl[lane * 33 + grp * 8 + e] + BEX[grp * 8 + e];
            int i1 = 0; float m1 = l8[0];
#pragma unroll
            for (int e = 1; e < 8; ++e) if (l8[e] > m1) { m1 = l8[e]; i1 = e; }
            int i2 = -1; float m2 = -3.0e38f;
#pragma unroll
            for (int e = 0; e < 8; ++e) if (e != i1 && l8[e] > m2) { m2 = l8[e]; i2 = e; }
            const float e2 = __expf(m2 - m1);
            w1 = pgrp / (1.f + e2); w2 = pgrp * e2 / (1.f + e2);
            x1 = grp * 8 + i1; x2 = grp * 8 + i2;
            lr1 = __hip_atomic_fetch_add(bcnt + x1, 1, __ATOMIC_RELAXED, __HIP_MEMORY_SCOPE_WORKGROUP);
            lr2 = __hip_atomic_fetch_add(bcnt + x2, 1, __ATOMIC_RELAXED, __HIP_MEMORY_SCOPE_WORKGROUP);
        }
        __syncthreads();
        if (tid < 32) bcnt[32 + tid] = atomicAdd(&cnt[tid * 64], bcnt[tid]);
        __syncthreads();
        if (lane < 16) {
            int* ERT = (int*)(p.ws + WS_ERT); float* ERW = (float*)(p.ws + WS_ERW);
            const int i1 = x1 * ECAP + bcnt[32 + x1] + lr1, i2 = x2 * ECAP + bcnt[32 + x2] + lr2;
            ERT[i1] = tok * 2; ERW[i1] = w1; ERT[i2] = tok * 2 + 1; ERW[i2] = w2;
        }
        asm volatile("s_waitcnt lgkmcnt(0)" ::: "memory");
        if (tile0 + nb * 8 < TL / 16) {
            __syncthreads();
            for (int c = tid; c < 8192; c += NT) {
                const int k = c >> 3, o4 = c & 7;
                const f32x4 w = *(const f32x4*)(WEX + (size_t)k * 32 + 4 * o4);
#pragma unroll
                for (int i = 0; i < 4; ++i) *(LAS float*)(lds + ((((k >> 2) * 32 + 4 * o4 + i) * 4 + (k & 3)) * 4)) = w[i];
            }
            __syncthreads();
        }
    }
    __syncthreads();
}

__device__ void phase5b(const Params& p, float* lds, int bid, int nb) {
    const int lane = threadIdx.x & 63;
    const int gw = bid * 8 + (threadIdx.x >> 6), ngw = nb * 8;
    int* sstart = (int*)lds;
    if (threadIdx.x == 0) { const int* cnt = (const int*)(p.ws + WS_CTL) + CW_CNT; int a = 0; for (int e = 0; e < 32; ++e) { sstart[e] = a; a += ((cnt[e * 64] + 255) >> 8) << 8; } sstart[32] = a; }
    __syncthreads();
    const int* ROUTE = (const int*)(p.ws + WS_ROUTE);
    int* rowtok = (int*)(p.ws + WS_ROWTOK); float* roww = (float*)(p.ws + WS_ROWW);
    const bf16_t* FL = (const bf16_t*)(p.ws + WS_FL); bf16_t* XG = (bf16_t*)(p.ws + WS_XG);
    const int l15 = lane & 15, g4 = lane >> 4;
    for (int it4 = gw; it4 < TL * 2 / 4; it4 += ngw) {
        const int it = it4 * 4 + g4;
        const int tok = it >> 1, k = it & 1;
        const int* R = ROUTE + (size_t)tok * 8;
        const int e = R[k], rk = R[2 + k]; const float w = ((const float*)R)[4 + k];
        const int pos = sstart[e] + rk;
        if (l15 == 0) { rowtok[pos] = it; roww[pos] = w; }
        const u32x4* src = (const u32x4*)(FL + (size_t)tok * DM); u32x4* dst = (u32x4*)(XG + (size_t)pos * DM);
        u32x4 v[8];
#pragma unroll
        for (int q = 0; q < 8; ++q) v[q] = src[l15 + 16 * q];
#pragma unroll
        for (int q = 0; q < 8; ++q) dst[l15 + 16 * q] = v[q];
    }
    const int* cnt = (const int*)(p.ws + WS_CTL) + CW_CNT;
    for (int e = 0; e < 32; ++e) {
        const int c = cnt[e * 64], padn = (((c + 255) >> 8) << 8) - c;
        for (int r = gw; r < padn; r += ngw) { u32x4* dst = (u32x4*)(XG + (size_t)(sstart[e] + c + r) * DM); dst[lane] = (u32x4){0, 0, 0, 0}; dst[lane + 64] = (u32x4){0, 0, 0, 0}; }
    }
    __syncthreads();
}

struct SchedMoe {
    __device__ __forceinline__ void a_ready(const Unit&) const {}
    __device__ __forceinline__ void done(const Unit&) const {}
    const bf16_t* A; const bf16_t* B; int K; size_t bexp; const int* tstart;
    int G, c; bool gather;
    __device__ bool next(int i, Unit& u) const {
        const int ntile = __builtin_amdgcn_readfirstlane(tstart[32]);
        if ((G & 7) == 0) {
            const int t = i * (G >> 3) + (c >> 3);
            u.pm = 8 * (t >> 2) + (c & 7); u.pn = t & 3;
            if (u.pm >= ntile) return false;
        } else { const int L = i * G + c; if (L >= ntile * 4) return false; u.pm = L >> 2; u.pn = L & 3; }
        const int e = __builtin_amdgcn_readfirstlane(tstart[40 + u.pm]);
        const int j = u.pm - __builtin_amdgcn_readfirstlane(tstart[e]), ce = __builtin_amdgcn_readfirstlane(tstart[400 + e]);
        u.aux = e; u.rbase = e * ECAP + 256 * j; u.nvalid = min(256, ce - 256 * j);
        u.a = gather ? A : A + (size_t)u.pm * 256 * K; u.b = B + (size_t)e * bexp + (size_t)u.pn * 256 * K;
        return true;
    }
};
struct EpiGU {
    static constexpr bool PERM = false, AFTER_DRAIN = false;
    bf16_t* H;
    __device__ __forceinline__ void operator()(const f32x4 (&acc)[2][2][4][2], const Unit& u, int wr, int wc, int fr, int fq) const {
        const int row0 = u.pm * 256 + wr * 64 + fr, col0 = u.pn * 128 + wc * 32 + 4 * fq;
#pragma unroll
        for (int ai = 0; ai < 2; ++ai)
#pragma unroll
            for (int m = 0; m < 4; ++m)
#pragma unroll
                for (int n = 0; n < 2; ++n) {
                    const f32x4 g = acc[ai][0][m][n], up = acc[ai][1][m][n];
                    u32x2 w; w.x = pk2(siluf_(g[0]) * up[0], siluf_(g[1]) * up[1]); w.y = pk2(siluf_(g[2]) * up[2], siluf_(g[3]) * up[3]);
                    *(u32x2*)(H + (size_t)(row0 + ai * 128 + m * 16) * 512 + col0 + n * 16) = w;
                }
    }
};
struct EpiDown {
    static constexpr bool PERM = false, AFTER_DRAIN = false;
    bf16_t* YS; const int* rowtok; const float* roww;
    __device__ __forceinline__ void operator()(const f32x4 (&acc)[2][2][4][2], const Unit& u, int wr, int wc, int fr, int fq) const {
        const int row0 = u.pm * 256 + wr * 64 + fr, col0 = u.pn * 256 + wc * 32 + 4 * fq;
        int tsv[2][4]; float wv[2][4];
#pragma unroll
        for (int ai = 0; ai < 2; ++ai)
#pragma unroll
            for (int m = 0; m < 4; ++m) { const int rl = wr * 64 + fr + ai * 128 + m * 16; const bool ok = rl < u.nvalid; tsv[ai][m] = ok ? rowtok[u.rbase + rl] : -1; wv[ai][m] = ok ? roww[u.rbase + rl] : 0.f; }
#pragma unroll
        for (int ai = 0; ai < 2; ++ai)
#pragma unroll
            for (int m = 0; m < 4; ++m) {
                const int ts = tsv[ai][m]; const float w = wv[ai][m];
                if (ts >= 0) {
                    bf16_t* rp = YS + ((size_t)(ts & 1) * TL + (ts >> 1)) * 1024 + col0;
#pragma unroll
                    for (int bj = 0; bj < 2; ++bj)
#pragma unroll
                        for (int n = 0; n < 2; ++n) { const f32x4 v = acc[ai][bj][m][n] * w; u32x2 o; o.x = pk2(v[0], v[1]); o.y = pk2(v[2], v[3]); *(u32x2*)(rp + bj * 128 + n * 16) = o; }
                }
            }
    }
};
__device__ void moe_tiles(const Params& p, int* tstart) {
    if (threadIdx.x == 0) { const int* cnt = (const int*)(p.ws + WS_CTL) + CW_CNT; int a = 0;
        for (int e = 0; e < 32; ++e) { tstart[e] = a; const int n = (cnt[e * 64] + 255) >> 8; for (int j = 0; j < n; ++j) tstart[40 + a + j] = e; a += n; }
        tstart[32] = a; for (int e = 0; e < 32; ++e) tstart[400 + e] = cnt[e * 64]; }
    __syncthreads();
}

__device__ void phase7(const Params& p, int bid, int nb) {
    const int lane = threadIdx.x & 63;
    const int gw = bid * 8 + (threadIdx.x >> 6), ngw = nb * 8;
    const float* MOD = (const float*)(p.ws + WS_MOD); const float* HMID = (const float*)(p.ws + WS_HMID);
    const bf16_t* YS = (const bf16_t*)(p.ws + WS_YS);
    const float* G = p.in[I_FNG];
    for (int row = gw; row < TL; row += ngw) {
        const int b = row >> 11;
        f32x4 v[4]; float s = 0.f;
#pragma unroll
        for (int j = 0; j < 4; ++j) {
            const int c = 4 * lane + 256 * j;
            const f32x4 hm = *(const f32x4*)(HMID + (size_t)row * DM + c);
            const f32x4 g2 = *(const f32x4*)(MOD + b * 6144 + 5120 + c);
            const u32x2 y0 = *(const u32x2*)(YS + (size_t)row * DM + c), y1 = *(const u32x2*)(YS + ((size_t)TL + row) * DM + c);
            f32x4 y; y[0] = bflo(y0.x) + bflo(y1.x); y[1] = bfhi(y0.x) + bfhi(y1.x); y[2] = bflo(y0.y) + bflo(y1.y); y[3] = bfhi(y0.y) + bfhi(y1.y);
            v[j] = hm + g2 * y;
            s += v[j][0] * v[j][0] + v[j][1] * v[j][1] + v[j][2] * v[j][2] + v[j][3] * v[j][3];
        }
        const float rstd = rsqrtf(wave_sum(s) * (1.f / DM) + EPS);
#pragma unroll
        for (int j = 0; j < 4; ++j) { const int c = 4 * lane + 256 * j; const f32x4 g = *(const f32x4*)(G + c);
            *(f32x4*)(p.out + (size_t)row * DM + c) = (v[j] * rstd) * g; }
    }
}


#ifndef LAS
#define LAS __attribute__((address_space(3)))
#endif
#define XB_TMO      128
#define XB_XCNT(j)  (256  + 64 * (j))
#define XB_XSUB(j)  (1280 + 64 * (j))
#define XB_XGEN(j)  (2304 + 64 * (j))
#define XB_TOP      3328
#define XB_TOPGEN   3392
#define XCD_BAR_WORDS 3456
#define XB_SPIN_CAP (1u << 18)

__device__ __forceinline__ unsigned xb_ld(unsigned* p)              { return __hip_atomic_load(p, __ATOMIC_RELAXED, __HIP_MEMORY_SCOPE_AGENT); }
__device__ __forceinline__ unsigned xb_add(unsigned* p, unsigned v) { return __hip_atomic_fetch_add(p, v, __ATOMIC_RELAXED, __HIP_MEMORY_SCOPE_AGENT); }
__device__ __forceinline__ unsigned xb_xcc_id() { return (unsigned)__builtin_amdgcn_s_getreg((3 << 11) | 20) & 0xFu; }
#define XB_SPIN(cond, bar) do { unsigned _sp = 0; while (cond) { __builtin_amdgcn_s_sleep(1); \
    if ((++_sp & 255u) == 0u) { if (xb_ld(&(bar)[XB_TMO])) break; if (_sp > XB_SPIN_CAP) { atomicAdd(&(bar)[XB_TMO], 1u); break; } } } } while (0)

struct XcdBarrier {
    unsigned* bar; unsigned x;
    volatile LAS unsigned* st;
};

__device__ __forceinline__ XcdBarrier xcd_barrier_post(unsigned* bar, volatile LAS unsigned* st) {
    XcdBarrier b; b.bar = bar; b.x = xb_xcc_id(); b.st = st;
    if (threadIdx.x == 0) (void)xb_add(&bar[XB_XCNT(b.x)], 1u);
    return b;
}
__device__ __forceinline__ void xcd_barrier_complete(unsigned* bar, unsigned x, unsigned& nloc, unsigned& nx) {
    const unsigned G = gridDim.x * gridDim.y * gridDim.z;
    unsigned sum, cnt, mine, sp = 0u;
    for (;;) {
        sum = 0u; cnt = 0u; mine = 0u;
#pragma unroll
        for (unsigned j = 0; j < 16; ++j) { const unsigned c = xb_ld(&bar[XB_XCNT(j)]); sum += c; cnt += (c > 0u) ? 1u : 0u; mine = (j == x) ? c : mine; }
        if (sum == G) break;
        __builtin_amdgcn_s_sleep(1);
        if ((++sp & 255u) == 0u) { if (xb_ld(&bar[XB_TMO])) break; if (sp > XB_SPIN_CAP) { atomicAdd(&bar[XB_TMO], 1u); break; } }
    }
    nloc = mine > 0u ? mine : 1u; nx = cnt > 0u ? cnt : 1u;
}

__device__ __forceinline__ void xcd_barrier(const XcdBarrier& b) {
    asm volatile("s_waitcnt vmcnt(0)" ::: "memory");
    __syncthreads();
    if (threadIdx.x == 0) {
        unsigned* bar = b.bar;
        __builtin_amdgcn_s_waitcnt(0);
        unsigned nloc = b.st[0], nx = b.st[1];
        if (nloc == 0u) { xcd_barrier_complete(bar, b.x, nloc, nx); b.st[0] = nloc; b.st[1] = nx; }
        const unsigned old = xb_add(&bar[XB_XSUB(b.x)], 1u);
        const unsigned gen = old / nloc;
        if (old + 1u == (gen + 1u) * nloc) {
            __builtin_amdgcn_fence(__ATOMIC_RELEASE, "agent");
            asm volatile("s_waitcnt vmcnt(0)" ::: "memory");
            const unsigned og = xb_add(&bar[XB_TOP], 1u);
            const unsigned tg = og / nx;
            if (og + 1u == (tg + 1u) * nx) xb_add(&bar[XB_TOPGEN], 1u);
            else XB_SPIN(xb_ld(&bar[XB_TOPGEN]) == tg, bar);
            __builtin_amdgcn_fence(__ATOMIC_ACQUIRE, "agent");
            xb_add(&bar[XB_XGEN(b.x)], 1u);
            asm volatile("s_waitcnt vmcnt(0)" ::: "memory");
        } else {
            XB_SPIN(xb_ld(&bar[XB_XGEN(b.x)]) == gen, bar);
            __builtin_amdgcn_fence(__ATOMIC_ACQUIRE, "agent");
            asm volatile("s_waitcnt vmcnt(0)" ::: "memory");
        }
    }
    __syncthreads();
}


template <int PH>
__device__ __forceinline__ void run_phase(const Params& p, unsigned char* lds, int bid, int nb) {
    if constexpr (PH == 0) phase0(p, (float*)lds, bid, nb);
    if constexpr (PH == 1) phase1(p, bid, nb);
    if constexpr (PH == 2) { SchedIn S{(const bf16_t*)p.out, (const bf16_t*)(p.ws + WS_WIN), nb, bid}; EpiIn E{p.ws}; pg8::gemm_phase<decltype(E), decltype(S), true, true>((PG8_LAS unsigned char*)lds, 1024, S, E); }
    if constexpr (PH == 3) phase3(p, lds, bid, nb);
    if constexpr (PH == 4) phase4r(p, bid, nb);
    if constexpr (PH == 5) {
        SchedSq S{(const bf16_t*)(p.ws + WS_ONA), (const bf16_t*)(p.ws + WS_WNAO), 512, (const bf16_t*)(p.ws + WS_GG), (const bf16_t*)(p.ws + WS_WGLAO), 1024, 1, nb, bid};
        { EpiMerge E{p.ws, 0}; pg8::gemm_phase<decltype(E), decltype(S), true, true>((PG8_LAS unsigned char*)lds, 512, S, E); }
        { SchedSq S1{(const bf16_t*)(p.ws + WS_GG), (const bf16_t*)(p.ws + WS_WGLAO), 1024, nullptr, nullptr, 0, 1, nb, bid}; EpiMerge E{p.ws, 1}; pg8::gemm_phase<decltype(E), decltype(S1), true, true>((PG8_LAS unsigned char*)lds, 1024, S1, E); }
    }
    if constexpr (PH == 6) { SchedSq S{(const bf16_t*)(p.ws + WS_M8), (const bf16_t*)(p.ws + WS_WOUT), 1024, nullptr, nullptr, 0, 1, nb, bid};
        EpiOut E{p.in[I_X], (const float*)(p.ws + WS_MOD), (float*)(p.ws + WS_HMID), (float*)(p.ws + WS_ROWSS)}; pg8::gemm_phase<decltype(E), decltype(S), true, true>((PG8_LAS unsigned char*)lds, 1024, S, E); }
    if constexpr (PH == 7) { phase5(p, lds, bid, nb); prep_experts(p, (float*)lds, bid * 8 + (threadIdx.x >> 6), nb * 8); }
    if constexpr (PH == 9) { int* tstart = (int*)(lds + pg8::STAGE_BYTES); moe_tiles(p, tstart);
        SchedMoe S{(const bf16_t*)(p.ws + WS_FL), (const bf16_t*)((unsigned char*)p.out + OUT_WGU), 1024, (size_t)1024 * 1024, tstart, nb, bid, true};
        EpiGU E{(bf16_t*)(p.ws + WS_H)}; const pg8::NoGather GI{(const int*)(p.ws + WS_ERT), TL};
        pg8::gemm_phase<decltype(E), decltype(S), true, true, true>((PG8_LAS unsigned char*)lds, 1024, S, E, GI); }
    if constexpr (PH == 10) { int* tstart = (int*)(lds + pg8::STAGE_BYTES); moe_tiles(p, tstart);
        SchedMoe S{(const bf16_t*)(p.ws + WS_H), (const bf16_t*)((unsigned char*)p.out + OUT_WD), 512, (size_t)1024 * 512, tstart, nb, bid, false};
        EpiDown E{(bf16_t*)(p.ws + WS_YS), (const int*)(p.ws + WS_ERT), (const float*)(p.ws + WS_ERW)}; pg8::gemm_phase<decltype(E), decltype(S), true, true>((PG8_LAS unsigned char*)lds, 512, S, E); }
    if constexpr (PH == 11) phase7(p, bid, nb);
}
constexpr int LDS_BYTES = 155648;

template <int PH>
__global__ void __launch_bounds__(NT, 2) k_phase(Params p) {
    extern __shared__ __attribute__((aligned(16))) unsigned char lds[];
    run_phase<PH>(p, lds, blockIdx.x, gridDim.x);
}


constexpr int LDS_MISC = 155648 - 256;
__global__ void __launch_bounds__(NT, 2) k_mega(Params p) {
    extern __shared__ __attribute__((aligned(16))) unsigned char lds[];
    const int bid = blockIdx.x, nb = gridDim.x;
    volatile LAS unsigned* misc = (volatile LAS unsigned*)((LAS unsigned char*)lds + LDS_MISC);
    if (threadIdx.x < 64) misc[threadIdx.x] = 0u;
    __syncthreads();
    const XcdBarrier bar = xcd_barrier_post((unsigned*)(p.ws + WS_BAR), misc);
#define PHS(N) run_phase<N>(p, lds, bid, nb); if (PROBE_DUP == N) { xcd_barrier(bar); run_phase<N>(p, lds, bid, nb); } xcd_barrier(bar);
    PHS(0) PHS(1) PHS(2) PHS(3) PHS(4) PHS(5) PHS(6) PHS(7) PHS(9) PHS(10)
    run_phase<11>(p, lds, bid, nb);
}

template <int PH> static void launch_phase(const Params& p, int grid, hipStream_t stream) {
    static bool attr = false;
    if (!attr) { (void)hipFuncSetAttribute((const void*)k_phase<PH>, hipFuncAttributeMaxDynamicSharedMemorySize, LDS_BYTES); attr = true; }
    hipLaunchKernelGGL(k_phase<PH>, dim3(grid), dim3(NT), LDS_BYTES, stream, p);
}

extern "C" void kernel_launch(void* const* d_in, const int* in_sizes, int n_in, void* d_out, int out_size, void* d_ws, size_t ws_size, hipStream_t stream) {
    if (n_in != 24 || ws_size < WS_END) { fprintf(stderr, "kernel_launch: unexpected n_in %d / ws %zu\n", n_in, ws_size); return; }
    Params p{};
    for (int i = 0; i < 24; ++i) p.in[i] = (const float*)d_in[i];
    p.out = (float*)d_out; p.ws = (unsigned char*)d_ws;
#if MEGA
    static int grid = 0;
    if (grid == 0) {
        int dev = 0, cus = 0, per_cu = 0;
        (void)hipGetDevice(&dev);
        (void)hipDeviceGetAttribute(&cus, hipDeviceAttributeMultiprocessorCount, dev);
        (void)hipFuncSetAttribute((const void*)k_mega, hipFuncAttributeMaxDynamicSharedMemorySize, LDS_BYTES);
        if (hipOccupancyMaxActiveBlocksPerMultiprocessor(&per_cu, (const void*)k_mega, NT, LDS_BYTES) != hipSuccess || per_cu < 1) { fprintf(stderr, "occupancy query failed (%d)\n", per_cu); per_cu = 1; }
        if (per_cu > 1) per_cu = 1;
        grid = cus * per_cu;
    }
    (void)hipMemsetAsync((unsigned char*)d_ws + WS_BAR, 0, 16384, stream);
    hipLaunchKernelGGL(k_mega, dim3(grid), dim3(NT), LDS_BYTES, stream, p);
    const hipError_t e = hipPeekAtLastError();
    if (e != hipSuccess) fprintf(stderr, "launch failed: %s (grid %d)\n", hipGetErrorString(e), grid);
#else
    const int G = 256;
    launch_phase<0>(p, G, stream); launch_phase<1>(p, G, stream); launch_phase<2>(p, G, stream); launch_phase<3>(p, G, stream);
    launch_phase<4>(p, G, stream); launch_phase<5>(p, G, stream); launch_phase<6>(p, G, stream); launch_phase<7>(p, G, stream);
    launch_phase<8>(p, G, stream); launch_phase<9>(p, G, stream); launch_phase<10>(p, G, stream); launch_phase<11>(p, G, stream);
#endif
}
```

```cpp
#include <hip/hip_runtime.h>
#include <hip/hip_cooperative_groups.h>
#include <cstdint>
#include <cstdio>
namespace cg = cooperative_groups;

#ifndef MEGA
#define MEGA 1
#endif
#define PROBE_DUP -1

typedef unsigned short bf16_t;
typedef short bf16x8 __attribute__((ext_vector_type(8)));
typedef float f32x4 __attribute__((ext_vector_type(4)));
typedef float f32x2 __attribute__((ext_vector_type(2)));
typedef unsigned u32x4 __attribute__((ext_vector_type(4)));
typedef unsigned u32x2 __attribute__((ext_vector_type(2)));

constexpr int NB = 16, SEQ = 2048, DM = 1024, CTX = 256, GW = 64;
constexpr int TL = NB * SEQ;
constexpr int TC = NB * CTX;
constexpr int TA = TL + TC;
constexpr int NEXP = 32, DEXP = 512;
constexpr int NT = 512;
constexpr float EPS = 1e-6f;
constexpr int ECAP = 32768;
constexpr int MAXROWS = 73728;

constexpr size_t MiB = 1u << 20;
constexpr size_t WS_CTL = 0;
constexpr size_t WS_BAR = 64 * 1024;
constexpr size_t WS_MOD = 1 * MiB;
constexpr size_t WS_ROPE = 1 * MiB + 512 * 1024;
constexpr size_t WS_ROUTE = 2 * MiB;
constexpr size_t WS_ROWTOK = 3 * MiB;
constexpr size_t WS_ROWW = 3 * MiB + 512 * 1024;
constexpr size_t WS_WIN = 4 * MiB;
constexpr size_t WS_WNAO = WS_WIN + (size_t)6912 * 1024 * 2;
constexpr size_t WS_WGLAO = WS_WNAO + 1 * MiB;
constexpr size_t WS_WOUT = WS_WGLAO + 2 * MiB;
constexpr size_t WS_ALR = WS_WOUT + 2 * MiB;
constexpr size_t WS_QN = 28 * MiB;
constexpr size_t WS_KN = 60 * MiB;
constexpr size_t WS_VN = 96 * MiB;
constexpr size_t WS_QG = 132 * MiB;
constexpr size_t WS_KG = 164 * MiB;
constexpr size_t WS_VG = 200 * MiB;
constexpr size_t WS_ONA = 272 * MiB;
constexpr size_t WS_GG = 304 * MiB;
constexpr size_t WS_M8 = 368 * MiB;
constexpr size_t WS_M9 = 432 * MiB;
constexpr size_t WS_ROWSS = 496 * MiB;
constexpr size_t WS_ERT = 156 * MiB;
constexpr size_t WS_ERW = 160 * MiB;
constexpr size_t WS_END = 504 * MiB;
constexpr size_t WS_HMID = 28 * MiB;
constexpr size_t WS_FL = 200 * MiB;
constexpr size_t WS_H = 432 * MiB;
constexpr size_t WS_XG = 304 * MiB;
constexpr size_t WS_YS = 304 * MiB;
static_assert(WS_ALR + (size_t)TA * 32 * 4 <= WS_QN, "ws map");
constexpr size_t OUT_WGU = 0;
constexpr size_t OUT_WD = 64 * MiB;

constexpr int CW_CNT = 0;

__device__ __forceinline__ unsigned pk2(float lo, float hi);
__device__ __forceinline__ unsigned f2bf(float f);
typedef __bf16 bf16x2_hw __attribute__((ext_vector_type(2)));
__device__ __forceinline__ unsigned pk2(float lo, float hi) { const f32x2 v = {lo, hi}; return __builtin_bit_cast(unsigned, __builtin_convertvector(v, bf16x2_hw)); }
__device__ __forceinline__ unsigned f2bf(float f) { return pk2(f, 0.f) & 0xffffu; }
__device__ __forceinline__ float bf2f(unsigned short h) { return __builtin_bit_cast(float, (unsigned)h << 16); }
__device__ __forceinline__ float bflo(unsigned u) { return __builtin_bit_cast(float, u << 16); }
__device__ __forceinline__ float bfhi(unsigned u) { return __builtin_bit_cast(float, u & 0xffff0000u); }
__device__ __forceinline__ float wave_sum(float v) {
#pragma unroll
    for (int o = 1; o < 64; o <<= 1) v += __shfl_xor(v, o);
    return v;
}
__device__ __forceinline__ float sigmoidf_(float x) { return 1.f / (1.f + __expf(-x)); }
__device__ __forceinline__ float siluf_(float x) { return x / (1.f + __expf(-x)); }

struct Params {
    const float* in[24];
    float* out;
    unsigned char* ws;
};
enum { I_X = 0, I_C, I_CTX, I_CCTX, I_WMOD, I_BMOD, I_NAG, I_NFG, I_WIN, I_WA2, I_BA2, I_GNG, I_RPB, I_WNAO, I_WGLAO, I_WOUT,
       I_WGRP, I_BGRP, I_WEXP, I_BEXP, I_WG, I_WU, I_WD, I_FNG };

__device__ void p0_mod(const Params& p, float* lds, int blk) {
    const int tid = threadIdx.x;
    float* sc = lds;
    for (int i = tid; i < 17 * 1024; i += NT) {
        const int r = i >> 10, k = i & 1023;
        const float v = r < 16 ? p.in[I_C][r * 1024 + k] : p.in[I_CCTX][k];
        sc[i] = siluf_(v);
    }
    __syncthreads();
    const int cg4 = tid & 7, kr = tid >> 3;
    const int n0 = blk * 32 + cg4 * 4;
    float acc[17][4];
#pragma unroll
    for (int r = 0; r < 17; ++r) { acc[r][0] = 0.f; acc[r][1] = 0.f; acc[r][2] = 0.f; acc[r][3] = 0.f; }
    const float* W = p.in[I_WMOD];
#pragma unroll 2
    for (int kb = 0; kb < 1024; kb += 64) {
        const int k = kb + kr;
        const f32x4 w = *(const f32x4*)(W + (size_t)k * 6144 + n0);
#pragma unroll
        for (int r = 0; r < 17; ++r) { const float s = sc[r * 1024 + k]; acc[r][0] += s * w[0]; acc[r][1] += s * w[1]; acc[r][2] += s * w[2]; acc[r][3] += s * w[3]; }
    }
#pragma unroll
    for (int r = 0; r < 17; ++r)
#pragma unroll
        for (int j = 0; j < 4; ++j) { float v = acc[r][j]; v += __shfl_xor(v, 8); v += __shfl_xor(v, 16); v += __shfl_xor(v, 32); acc[r][j] = v; }
    __syncthreads();
    float* red = lds;
    const int wave = tid >> 6, lane = tid & 63;
    if (lane < 8) {
#pragma unroll
        for (int r = 0; r < 17; ++r)
#pragma unroll
            for (int j = 0; j < 4; ++j) red[(wave * 8 + lane) * 68 + r * 4 + j] = acc[r][j];
    }
    __syncthreads();
    float* MOD = (float*)(p.ws + WS_MOD);
    for (int i = tid; i < 8 * 68; i += NT) {
        const int c = i / 68, q = i % 68, r = q >> 2, j = q & 3;
        float s = 0.f;
#pragma unroll
        for (int w = 0; w < 8; ++w) s += red[(w * 8 + c) * 68 + q];
        const int n = blk * 32 + c * 4 + j;
        MOD[r * 6144 + n] = s + p.in[I_BMOD][n];
    }
    __syncthreads();
}

template <class ColMap>
__device__ __forceinline__ void transpose_item(const float* W, int ld, bf16_t* WT, int K, int k0, int n0, float* scr, int lane, const ColMap& cm) {
    const int sc = cm(n0 + (lane & 31));
    float tv[32];
    const float* wp = W + (size_t)(k0 + (lane >> 5)) * ld + (sc >= 0 ? sc : 0);
#pragma unroll
    for (int i = 0; i < 32; ++i) tv[i] = wp[(size_t)(2 * i) * ld];
#pragma unroll
    for (int i = 0; i < 32; ++i) { const int kk = 2 * i + (lane >> 5); scr[kk * 33 + (lane & 31)] = sc >= 0 ? tv[i] : 0.f; }
    asm volatile("s_waitcnt lgkmcnt(0)" ::: "memory");
    __builtin_amdgcn_wave_barrier();
    const int c = lane & 7;
#pragma unroll
    for (int j = 0; j < 4; ++j) { const int n = (lane >> 3) + 8 * j; const float* s = scr + (8 * c) * 33 + n;
        u32x4 o; o.x = pk2(s[0 * 33], s[1 * 33]); o.y = pk2(s[2 * 33], s[3 * 33]); o.z = pk2(s[4 * 33], s[5 * 33]); o.w = pk2(s[6 * 33], s[7 * 33]);
        *(u32x4*)(WT + (size_t)(n0 + n) * K + k0 + 8 * c) = o; }
    asm volatile("s_waitcnt lgkmcnt(0)" ::: "memory");
    __builtin_amdgcn_wave_barrier();
}
__device__ __forceinline__ int rope_perm(int pp) { const int wc = pp >> 5, n = (pp >> 4) & 1, r = pp & 15; return 64 * (wc >> 1) + 32 * n + 16 * (wc & 1) + r; }
struct CmIn { __device__ int operator()(int n) const {
    if (n < 1536) return n;
    if (n < 2560) return (n & ~127) + rope_perm(n & 127);
    if (n < 4608) return n;
    if (n < 6656) return n + 32;
    if (n < 6688) return n - 6656 + 4608;
    return -1; } };
struct CmId { __device__ int operator()(int n) const { return n; } };
struct CmGU { int which; __device__ int operator()(int n) const { const int t = n >> 8, q = n & 255; return ((q >> 7) == which) ? (128 * t + (q & 127)) : -2; } };

__device__ void p0_prep_small(const Params& p, float* lds, int gw, int ngw) {
    const int lane = threadIdx.x & 63, wave = threadIdx.x >> 6;
    float* scr = lds + wave * (64 * 33);
    constexpr int I_IN = 16 * 216, I_NAO = 8 * 32, I_GLAO = 16 * 32, I_OUT = 16 * 32;
    for (int it = gw; it < I_IN + I_NAO + I_GLAO + I_OUT; it += ngw) {
        int r = it;
        if (r < I_IN) { transpose_item(p.in[I_WIN], 6688, (bf16_t*)(p.ws + WS_WIN), 1024, 64 * (r / 216), 32 * (r % 216), scr, lane, CmIn()); continue; } r -= I_IN;
        if (r < I_NAO) { transpose_item(p.in[I_WNAO], 1024, (bf16_t*)(p.ws + WS_WNAO), 512, 64 * (r / 32), 32 * (r % 32), scr, lane, CmId()); continue; } r -= I_NAO;
        if (r < I_GLAO) { transpose_item(p.in[I_WGLAO], 1024, (bf16_t*)(p.ws + WS_WGLAO), 1024, 64 * (r / 32), 32 * (r % 32), scr, lane, CmId()); continue; } r -= I_GLAO;
        transpose_item(p.in[I_WOUT], 1024, (bf16_t*)(p.ws + WS_WOUT), 1024, 64 * (r / 32), 32 * (r % 32), scr, lane, CmId());
    }
}
__device__ void prep_experts(const Params& p, float* lds, int gw, int ngw) {
    const int lane = threadIdx.x & 63, wave = threadIdx.x >> 6;
    float* scr = lds + wave * (64 * 33);
    bf16_t* WGU = (bf16_t*)((unsigned char*)p.out + OUT_WGU);
    bf16_t* WDt = (bf16_t*)((unsigned char*)p.out + OUT_WD);
    constexpr int PER_GU = 16 * 32, PER_D = 8 * 32;
    for (int it = gw; it < NEXP * (PER_GU + PER_D); it += ngw) {
        const int e = it / (PER_GU + PER_D); int r = it % (PER_GU + PER_D);
        if (r < PER_GU) {
            const int k0 = 64 * (r / 32), n0 = 32 * (r % 32);
            const int t = n0 >> 8, q = n0 & 255, which = q >> 7;
            const float* src = (which == 0 ? p.in[I_WG] : p.in[I_WU]) + (size_t)e * 1024 * 512;
            struct Cm { int base, n0; __device__ int operator()(int n) const { return base + (n - n0); } } cm{128 * t + (q & 127), n0};
            transpose_item(src, 512, WGU + (size_t)e * 1024 * 1024, 1024, k0, n0, scr, lane, cm);
        } else {
            r -= PER_GU;
            transpose_item(p.in[I_WD] + (size_t)e * 512 * 1024, 1024, WDt + (size_t)e * 1024 * 512, 512, 64 * (r / 32), 32 * (r % 32), scr, lane, CmId());
        }
    }
}

__device__ void phase0(const Params& p, float* lds, int bid, int nb) {
    const int tid = threadIdx.x;
    if (bid == 0) {
        for (int i = tid; i < 32 * 64; i += NT) ((int*)(p.ws + WS_CTL))[i] = 0;
        f32x2* RT = (f32x2*)(p.ws + WS_ROPE);
        for (int i = tid; i < 64 * 32; i += NT) {
            const int pos = i >> 5, j = i & 31;
            const float inv = exp2f(-(float)j * 0.41524101186092029f);
            const float ang = (float)pos * inv;
            double rev = (double)ang * 0.15915494309189535; rev -= floor(rev);
            const float fr = (float)rev;
            RT[i] = (f32x2){__builtin_amdgcn_cosf(fr), __builtin_amdgcn_sinf(fr)};
        }
    }
    for (int b = bid; b < 192; b += nb) p0_mod(p, lds, b);
    p0_prep_small(p, lds, bid * 8 + (tid >> 6), nb * 8);
}

__device__ void phase1(const Params& p, int bid, int nb) {
    const int lane = threadIdx.x & 63;
    const int gw = bid * 8 + (threadIdx.x >> 6), ngw = nb * 8;
    const float* MOD = (const float*)(p.ws + WS_MOD);
    bf16_t* A1 = (bf16_t*)p.out;
    const float* G = p.in[I_NAG];
    for (int row = gw; row < TA; row += ngw) {
        const float* xr; int mr;
        if (row < TL) { xr = p.in[I_X] + (size_t)row * DM; mr = row >> 11; } else { xr = p.in[I_CTX] + (size_t)(row - TL) * DM; mr = 16; }
        f32x4 v[4]; float s = 0.f;
#pragma unroll
        for (int j = 0; j < 4; ++j) { v[j] = *(const f32x4*)(xr + 4 * lane + 256 * j); s += v[j][0] * v[j][0] + v[j][1] * v[j][1] + v[j][2] * v[j][2] + v[j][3] * v[j][3]; }
        const float rstd = rsqrtf(wave_sum(s) * (1.f / DM) + EPS);
#pragma unroll
        for (int j = 0; j < 4; ++j) {
            const int c = 4 * lane + 256 * j;
            const f32x4 g = *(const f32x4*)(G + c), sh = *(const f32x4*)(MOD + mr * 6144 + c), sc = *(const f32x4*)(MOD + mr * 6144 + 1024 + c);
            f32x4 o;
#pragma unroll
            for (int i = 0; i < 4; ++i) o[i] = (v[j][i] * rstd) * g[i] * (1.f + sc[i]) + sh[i];
            u32x2 w; w.x = pk2(o[0], o[1]); w.y = pk2(o[2], o[3]);
            *(u32x2*)(A1 + (size_t)row * DM + c) = w;
        }
    }
}


struct Unit { int pm, pn; const bf16_t* a; const bf16_t* b; int aux; int rbase, nvalid; };
namespace pg8 {
#define PG8_LAS __attribute__((address_space(3)))
constexpr int BM = 256, BK = 64, HALF = 128, HTB = HALF * BK * 2  , STAGE_BYTES = 8 * HTB;
__host__ __device__ __forceinline__ int lds_byte(int r, int c) { const int st = (r >> 4) * 2 + (c >> 5), rr = r & 15, cc = c & 31, ob = rr * 64 + cc * 2; return st * 1024 + (ob ^ (((ob >> 9) & 1) << 5)); }
__host__ __device__ __forceinline__ void stage_rc(int b, int& R, int& C) { const int st = b / 1024, sb = b % 1024, swz = sb ^ (((sb >> 9) & 1) << 5); R = (st >> 1) * 16 + swz / 64; C = (st & 1) * 32 + (swz % 64) / 2; }
__host__ __device__ __forceinline__ int perm32(int rho) { const int n = rho >> 4, i = rho & 15; return 8 * (i >> 2) + 4 * n + (i & 3); }
struct NoGather { const int* rowtok; int zero_row; };
template <class Epi, class Sched, bool ALIGN_EPI = false, bool SP2 = false, bool GATHER = false>
__device__ __forceinline__ void gemm_phase(PG8_LAS unsigned char* lds, const int Kdim, const Sched& S, const Epi& E, const NoGather G = NoGather{nullptr, 0}) {
    int tid_ = threadIdx.x; asm volatile("" : "+v"(tid_));
    const int tid = tid_, wid = __builtin_amdgcn_readfirstlane(tid >> 6), lane = tid & 63, wr = wid >> 2, wc = wid & 3, fr = lane & 15, fq = lane >> 4;
    const int K = Kdim, nt = K / BK;
    static_assert(!GATHER || SP2, "gathered A staging is wired into the two-super-phase loop only");
    unsigned voffA[2], voffB[2]; int gR[2], gC[2];
#pragma unroll
    for (int i = 0; i < 2; ++i) { int R, C; stage_rc(tid * 16 + i * 8192, R, C); const int Rb = Epi::PERM ? ((R & ~31) + perm32(R & 31)) : R;
        voffA[i] = (unsigned)(R * K + C) * 2u; voffB[i] = (unsigned)(Rb * K + C) * 2u; gR[i] = R; gC[i] = C; }
    const size_t kstep = (size_t)(BK * 2);
    const size_t hstep = (size_t)HALF * K * 2;
    const size_t tstep = 2 * hstep;
    const unsigned ldsw = (unsigned)wid * 1024u;
    const int aoff = lds_byte(wr * 64 + fr, fq * 8), boff = lds_byte(wc * 32 + fr, fq * 8);
#define PG8_SA(b, h) (((b) * 2 + (h)) * HTB)
#define PG8_SB(b, h) ((4 + (b) * 2 + (h)) * HTB)
#define PG8_STAGE(bufoff, gbase, voff) do { _Pragma("unroll") for (int _i = 0; _i < 2; ++_i) \
        __builtin_amdgcn_global_load_lds((const unsigned*)((const char*)(gbase) + (voff)[_i]), (PG8_LAS unsigned*)(lds + (bufoff) + ldsw + _i * 8192), 16, 0, 0); } while (0)
#define PG8_STAGE_A(bufoff, kbase, half, usenext) do { if constexpr (GATHER) { const bool un_ = (usenext); \
        const unsigned vs_[2] = {un_ ? aoffN[half][0] : aoffC[half][0], un_ ? aoffN[half][1] : aoffC[half][1]}; PG8_STAGE(bufoff, kbase, vs_); } \
    else { PG8_STAGE(bufoff, (kbase) + (half) * hstep, voffA); } } while (0)
#define PG8_GOFF(u_, o_) do { _Pragma("unroll") for (int h_ = 0; h_ < 2; ++h_) _Pragma("unroll") for (int i_ = 0; i_ < 2; ++i_) { \
        const int rl_ = 128 * h_ + gR[i_]; const int tk_ = rl_ < (u_).nvalid ? (G.rowtok[(u_).rbase + rl_] >> 1) : G.zero_row; \
        o_[h_][i_] = (unsigned)(tk_ * K + gC[i_]) * 2u; } } while (0)
#define PG8_LDA(dst, b, h) do { _Pragma("unroll") for (int m = 0; m < 4; ++m) _Pragma("unroll") for (int k = 0; k < 2; ++k) dst[m][k] = *(const PG8_LAS bf16x8*)(lds + PG8_SA(b, h) + aoff + m * 2048 + k * 1024); } while (0)
#define PG8_LDB(dst, b, h) do { _Pragma("unroll") for (int n = 0; n < 2; ++n) _Pragma("unroll") for (int k = 0; k < 2; ++k) dst[n][k] = *(const PG8_LAS bf16x8*)(lds + PG8_SB(b, h) + boff + n * 2048 + k * 1024); } while (0)
#define PG8_MMA(ai, bj, At, Bt) do { __builtin_amdgcn_s_setprio(1); _Pragma("unroll") for (int m = 0; m < 4; ++m) _Pragma("unroll") for (int n = 0; n < 2; ++n) _Pragma("unroll") for (int k = 0; k < 2; ++k) \
        acc[ai][bj][m][n] = __builtin_amdgcn_mfma_f32_16x16x32_bf16(Bt[n][k], At[m][k], acc[ai][bj][m][n], 0, 0, 0); __builtin_amdgcn_s_setprio(0); } while (0)
#define PG8_WAIT_V(n) asm volatile("s_waitcnt vmcnt(" #n ")" ::: "memory")
#define PG8_WAIT_L(n) asm volatile("s_waitcnt lgkmcnt(" #n ")" ::: "memory")
#define PG8_BAR __builtin_amdgcn_s_barrier()
#define PG8_SCHED __builtin_amdgcn_sched_barrier(0)
    Unit cur, nxt; int ui = 0;
    if (!S.next(0, cur)) return;
    f32x4 acc[2][2][4][2];
#pragma unroll
    for (int a = 0; a < 2; ++a)
#pragma unroll
        for (int b = 0; b < 2; ++b)
#pragma unroll
            for (int m = 0; m < 4; ++m)
#pragma unroll
                for (int n = 0; n < 2; ++n) acc[a][b][m][n] = (f32x4){0.f, 0.f, 0.f, 0.f};
    bf16x8 At[4][2], B0[2][2], B1[2][2];
    const char* cA = (const char*)cur.a; const char* cB = (const char*)cur.b;
    unsigned aoffC[2][2] = {{0u, 0u}, {0u, 0u}}, aoffN[2][2] = {{0u, 0u}, {0u, 0u}};
    if constexpr (GATHER) {
        PG8_GOFF(cur, aoffC); { Unit n1; if (S.next(1, n1)) PG8_GOFF(n1, aoffN); }
        asm volatile("s_waitcnt vmcnt(0)" ::: "memory");
    }
    S.a_ready(cur);
    if constexpr (SP2) {
        PG8_STAGE(PG8_SB(0, 0), cB, voffB); PG8_STAGE(PG8_SB(0, 1), cB + hstep, voffB); PG8_STAGE_A(PG8_SA(0, 0), cA, 0, false); PG8_STAGE_A(PG8_SA(0, 1), cA, 1, false);
        if (wr == 1) PG8_BAR;
        PG8_WAIT_V(2); PG8_BAR;
        PG8_STAGE(PG8_SB(1, 0), cB + kstep, voffB); PG8_STAGE_A(PG8_SA(1, 0), cA + kstep, 0, false); PG8_STAGE(PG8_SB(1, 1), cB + hstep + kstep, voffB);
        PG8_WAIT_V(6); PG8_BAR;
    } else {
        PG8_STAGE(PG8_SB(0, 0), cB, voffB); PG8_STAGE(PG8_SA(0, 0), cA, voffA); PG8_STAGE(PG8_SB(0, 1), cB + hstep, voffB); PG8_STAGE(PG8_SA(0, 1), cA + hstep, voffA);
        if (wr == 1) PG8_BAR;
        PG8_WAIT_V(4); PG8_BAR;
        PG8_STAGE(PG8_SB(1, 0), cB + kstep, voffB); PG8_STAGE(PG8_SA(1, 0), cA + kstep, voffA); PG8_STAGE(PG8_SB(1, 1), cB + hstep + kstep, voffB);
        PG8_WAIT_V(6); PG8_BAR;
    }
    for (;;) {
        const bool has_next = S.next(ui + 1, nxt);
        const char* nA = has_next ? (const char*)nxt.a : cA; const char* nB = has_next ? (const char*)nxt.b : cB;
        for (int t = 0; t < nt; t += 2) {
            const bool last = (t == nt - 2);
            const char* a1 = cA + (size_t)(t + 1) * kstep;
            const char* a2 = last ? nA : cA + (size_t)(t + 2) * kstep; const char* b2 = last ? nB : cB + (size_t)(t + 2) * kstep;
            const char* a3 = a2 + kstep; const char* b3 = b2 + kstep;
            if (last && has_next) S.a_ready(nxt);
            if constexpr (SP2) {
            PG8_LDB(B0, 0, 0); PG8_LDB(B1, 0, 1); PG8_SCHED; PG8_LDA(At, 0, 0); PG8_STAGE_A(PG8_SA(1, 1), a1, 1, false);
            PG8_WAIT_V(8); PG8_WAIT_L(0); PG8_BAR; PG8_MMA(0, 0, At, B0); PG8_MMA(0, 1, At, B1); PG8_BAR; PG8_SCHED;
            PG8_LDA(At, 0, 1); PG8_STAGE(PG8_SB(0, 0), b2, voffB); PG8_STAGE(PG8_SB(0, 1), b2 + hstep, voffB); PG8_STAGE_A(PG8_SA(0, 0), a2, 0, last && has_next);
            PG8_WAIT_V(8); PG8_WAIT_L(0); PG8_BAR; PG8_MMA(1, 0, At, B0); PG8_MMA(1, 1, At, B1); PG8_BAR; PG8_SCHED;
            PG8_LDB(B0, 1, 0); PG8_LDB(B1, 1, 1); PG8_SCHED; PG8_LDA(At, 1, 0); PG8_STAGE_A(PG8_SA(0, 1), a2, 1, last && has_next);
            PG8_WAIT_V(8); PG8_WAIT_L(0); PG8_BAR; PG8_MMA(0, 0, At, B0); PG8_MMA(0, 1, At, B1); PG8_BAR; PG8_SCHED;
            PG8_LDA(At, 1, 1); PG8_STAGE(PG8_SB(1, 0), b3, voffB); PG8_STAGE(PG8_SB(1, 1), b3 + hstep, voffB); PG8_STAGE_A(PG8_SA(1, 0), a3, 0, last && has_next);
            PG8_WAIT_V(8); PG8_WAIT_L(0); PG8_BAR; PG8_MMA(1, 0, At, B0); PG8_MMA(1, 1, At, B1); PG8_BAR; PG8_SCHED;
            } else {
            PG8_LDB(B0, 0, 0); PG8_SCHED; PG8_LDA(At, 0, 0); PG8_STAGE(PG8_SA(1, 1), a1 + hstep, voffA);
            PG8_WAIT_L(8); PG8_BAR; PG8_WAIT_L(0); PG8_MMA(0, 0, At, B0); PG8_BAR; PG8_SCHED;
            PG8_LDB(B1, 0, 1); PG8_STAGE(PG8_SB(0, 0), b2, voffB);
            PG8_BAR; PG8_WAIT_L(0); PG8_MMA(0, 1, At, B1); PG8_BAR;
            PG8_LDA(At, 0, 1); PG8_STAGE(PG8_SA(0, 0), a2, voffA);
            PG8_BAR; PG8_WAIT_L(0); PG8_MMA(1, 0, At, B0); PG8_BAR; PG8_SCHED;
            PG8_STAGE(PG8_SB(0, 1), b2 + hstep, voffB);
            PG8_WAIT_V(6); PG8_BAR; PG8_MMA(1, 1, At, B1); PG8_BAR;
            PG8_LDB(B0, 1, 0); PG8_SCHED; PG8_LDA(At, 1, 0); PG8_STAGE(PG8_SA(0, 1), a2 + hstep, voffA);
            PG8_WAIT_L(8); PG8_BAR; PG8_WAIT_L(0); PG8_MMA(0, 0, At, B0); PG8_BAR; PG8_SCHED;
            PG8_LDB(B1, 1, 1); PG8_STAGE(PG8_SB(1, 0), b3, voffB);
            PG8_BAR; PG8_WAIT_L(0); PG8_MMA(0, 1, At, B1); PG8_BAR;
            PG8_LDA(At, 1, 1); PG8_STAGE(PG8_SA(1, 0), a3, voffA);
            PG8_BAR; PG8_WAIT_L(0); PG8_MMA(1, 0, At, B0); PG8_BAR; PG8_SCHED;
            PG8_STAGE(PG8_SB(1, 1), b3 + hstep, voffB);
            PG8_WAIT_V(6); PG8_BAR; PG8_MMA(1, 1, At, B1); PG8_BAR;
            }
        }
        if constexpr (ALIGN_EPI) { if (wr == 0) PG8_BAR; }
        if constexpr (!Epi::AFTER_DRAIN) { E(acc, cur, wr, wc, fr, fq); S.done(cur); }
        if (!has_next) break;
#pragma unroll
        for (int a = 0; a < 2; ++a)
#pragma unroll
            for (int b = 0; b < 2; ++b)
#pragma unroll
                for (int m = 0; m < 4; ++m)
#pragma unroll
                    for (int n = 0; n < 2; ++n) acc[a][b][m][n] = (f32x4){0.f, 0.f, 0.f, 0.f};
        cur = nxt; cA = nA; cB = nB; ++ui;
        if constexpr (GATHER) {
#pragma unroll
            for (int h_ = 0; h_ < 2; ++h_) { aoffC[h_][0] = aoffN[h_][0]; aoffC[h_][1] = aoffN[h_][1]; }
            { Unit n2; if (S.next(ui + 1, n2)) PG8_GOFF(n2, aoffN); }
            asm volatile("s_waitcnt vmcnt(0)" ::: "memory");
        }
        if constexpr (ALIGN_EPI) { if (wr == 1) PG8_BAR; }
    }
    PG8_WAIT_V(0);
    if constexpr (!ALIGN_EPI) { if (wr == 0) PG8_BAR; }
    PG8_BAR;
    if constexpr (Epi::AFTER_DRAIN) { E.fused(acc, cur, wr, wc, fr, fq, lds, wid, lane); S.done(cur); }
#undef PG8_SA
#undef PG8_SB
#undef PG8_STAGE
#undef PG8_LDA
#undef PG8_STAGE_A
#undef PG8_GOFF
#undef PG8_LDB
#undef PG8_MMA
#undef PG8_WAIT_V
#undef PG8_WAIT_L
#undef PG8_BAR
#undef PG8_SCHED
}

}

struct SchedIn {
    __device__ __forceinline__ void a_ready(const Unit&) const {}
    __device__ __forceinline__ void done(const Unit&) const {}
    const bf16_t* A; const bf16_t* Bt; int G, c;
    __device__ bool next(int i, Unit& u) const {
        const int L = i * G + c;
        constexpr int NLAT = 128 * 27, NCTX = 16 * 11;
        if (L >= NLAT + NCTX) return false;
        if (L < NLAT) {
            const int w = (L & 7) * (NLAT / 8) + (L >> 3), gid = w / 216, rem = w % 216;
            u.pm = gid * 8 + (rem & 7); u.pn = rem >> 3; }
        else { const int q = L - NLAT; const int j = q % 11; u.pm = 128 + q / 11; u.pn = j < 4 ? 2 + j : (j < 10 ? 8 + (j - 4) : 26); }
        u.a = A + (size_t)u.pm * 256 * 1024; u.b = Bt + (size_t)u.pn * 256 * 1024; u.aux = 0; u.rbase = 0; u.nvalid = 0;
        return true;
    }
};
struct EpiIn {
    static constexpr bool PERM = false, AFTER_DRAIN = false;
    unsigned char* ws_;
    __device__ __forceinline__ void operator()(const f32x4 (&acc)[2][2][4][2], const Unit& u, int wr, int wc, int fr, int fq) const {
        unsigned zoff = 0; asm volatile("" : "+s"(zoff)); unsigned char* ws = ws_ + zoff;
        const int pn = u.pn;
        const int row0 = u.pm * 256 + wr * 64 + fr;
        if (pn == 26) {
            float* ALR = (float*)(ws + WS_ALR);
            if (wc == 0) {
#pragma unroll
                for (int ai = 0; ai < 2; ++ai)
#pragma unroll
                    for (int m = 0; m < 4; ++m) { const int row = row0 + ai * 128 + m * 16;
#pragma unroll
                        for (int n = 0; n < 2; ++n) *(f32x4*)(ALR + (size_t)row * 32 + 16 * n + 4 * fq) = acc[ai][0][m][n]; }
            }
            return;
        }
        if (pn >= 6 && pn < 10) {
            const bool isq = pn < 8;
            bf16_t* dst = (bf16_t*)(ws + (isq ? WS_QG : WS_KG));
            const float scale = isq ? 0.08838834764831845f : 1.0f;
            const f32x2* RT = (const f32x2*)(ws + WS_ROPE);
            const int half = wc >> 1, j0 = 16 * (wc & 1) + 4 * fq;
#pragma unroll
            for (int ai = 0; ai < 2; ++ai)
#pragma unroll
                for (int m = 0; m < 4; ++m) { const int row = row0 + ai * 128 + m * 16;
                    const bool lat = row < TL; const int t = row & 2047; const int pos = lat ? (half == 0 ? (t >> 6) : (t & 63)) : 0;
                    float cs[4], sn[4];
                    { const f32x4 va = *(const f32x4*)(RT + pos * 32 + j0), vb = *(const f32x4*)(RT + pos * 32 + j0 + 2);
                      cs[0] = va[0]; sn[0] = va[1]; cs[1] = va[2]; sn[1] = va[3]; cs[2] = vb[0]; sn[2] = vb[1]; cs[3] = vb[2]; sn[3] = vb[3]; }
#pragma unroll
                    for (int bj = 0; bj < 2; ++bj) {
                        const int head = (pn & 1) * 2 + bj;
                        const f32x4 x1 = acc[ai][bj][m][0] * scale, x2 = acc[ai][bj][m][1] * scale;
                        float o1[4], o2[4];
#pragma unroll
                        for (int i = 0; i < 4; ++i) { o1[i] = x1[i] * cs[i] - x2[i] * sn[i]; o2[i] = x1[i] * sn[i] + x2[i] * cs[i]; }
                        bf16_t* rp = dst + (size_t)row * 512 + head * 128 + 64 * half + j0;
                        u32x2 w1, w2; w1.x = pk2(o1[0], o1[1]); w1.y = pk2(o1[2], o1[3]); w2.x = pk2(o2[0], o2[1]); w2.y = pk2(o2[2], o2[3]);
                        *(u32x2*)rp = w1; *(u32x2*)(rp + 32) = w2;
                    }
                    asm volatile("" ::: "memory"); }
            return;
        }
        if (pn == 4 || pn == 5) {
            bf16_t* VT = (bf16_t*)(ws + WS_VN);
#pragma unroll
            for (int ai = 0; ai < 2; ++ai)
#pragma unroll
                for (int m = 0; m < 4; ++m) { const int row = row0 + ai * 128 + m * 16;
                    size_t base; int ldt;
                    if (row < TL) { base = (size_t)(row >> 11) * 512 * 2048 + (row & 2047); ldt = 2048; }
                    else { const int rc = row - TL; base = (size_t)32 * MiB / 2 + (size_t)(rc >> 8) * 512 * 256 + (rc & 255); ldt = 256; }
#pragma unroll
                    for (int bj = 0; bj < 2; ++bj)
#pragma unroll
                        for (int n = 0; n < 2; ++n) { const int c = (pn - 4) * 256 + bj * 128 + wc * 32 + n * 16 + 4 * fq;
#pragma unroll
                            for (int i = 0; i < 4; ++i) VT[base + (size_t)(c + i) * ldt] = (bf16_t)f2bf(acc[ai][bj][m][n][i]); }
                    asm volatile("" ::: "memory"); }
            return;
        }
        bf16_t* dst; int ld, cbase; float scale = 1.f;
        if (pn < 2) { dst = (bf16_t*)(ws + WS_QN); ld = 512; cbase = pn * 256; scale = 0.125f; }
        else if (pn < 4) { dst = (bf16_t*)(ws + WS_KN); ld = 512; cbase = (pn - 2) * 256; }
        else if (pn < 14) { dst = (bf16_t*)(ws + WS_VG); ld = 1024; cbase = (pn - 10) * 256; }
        else if (pn < 18) { dst = (bf16_t*)(ws + WS_GG); ld = 1024; cbase = (pn - 14) * 256; }
        else if (pn < 22) { dst = (bf16_t*)(ws + WS_M8); ld = 1024; cbase = (pn - 18) * 256; }
        else { dst = (bf16_t*)(ws + WS_M9); ld = 1024; cbase = (pn - 22) * 256; }
#pragma unroll
        for (int ai = 0; ai < 2; ++ai)
#pragma unroll
            for (int m = 0; m < 4; ++m) { bf16_t* rp = dst + (size_t)(row0 + ai * 128 + m * 16) * ld + cbase + wc * 32 + 4 * fq;
#pragma unroll
                for (int bj = 0; bj < 2; ++bj)
#pragma unroll
                    for (int n = 0; n < 2; ++n) { const f32x4 v = acc[ai][bj][m][n] * scale; u32x2 w; w.x = pk2(v[0], v[1]); w.y = pk2(v[2], v[3]);
                        *(u32x2*)(rp + bj * 128 + n * 16) = w; } }
    }
};

constexpr int NL_RPB = 0;
constexpr int NL_KW = 2048;
constexpr int NL_VW = 75776;
constexpr int NL_K = 2048;
constexpr int NL_VT = 38912;
__device__ __forceinline__ int na_swz(int col) { return (((col >> 3) & 3) << 1) | ((col >> 1) & 1); }
__device__ void na_item(const Params& p, unsigned char* ldsg, int b, int r, int j, int h, int rsb) {
    const int lane = threadIdx.x & 63, l15 = lane & 15, q4 = lane >> 4;
    unsigned lzo = 0; asm volatile("" : "+v"(lzo));
    unsigned char __attribute__((address_space(3)))* lds = (unsigned char __attribute__((address_space(3)))*)ldsg + lzo;
    b = __builtin_amdgcn_readfirstlane(b); r = __builtin_amdgcn_readfirstlane(r); j = __builtin_amdgcn_readfirstlane(j); h = __builtin_amdgcn_readfirstlane(h); rsb = __builtin_amdgcn_readfirstlane(rsb);
    const bf16_t* QN = (const bf16_t*)(p.ws + WS_QN); const bf16_t* KN = (const bf16_t*)(p.ws + WS_KN);
    const bf16_t* VT = (const bf16_t*)(p.ws + WS_VN);
    const int rs = min(max(r - 4, 0), 24), kc0 = min(max(16 * j - 8, 0), 32);
    const int qc = 16 * j + l15, cs = min(max(qc - 8, 0), 48);
    const int qtok = b * SEQ + r * GW + qc;
    bf16x8 qf[2];
    qf[0] = *(const bf16x8*)(QN + (size_t)qtok * 512 + h * 64 + 8 * q4);
    qf[1] = *(const bf16x8*)(QN + (size_t)qtok * 512 + h * 64 + 32 + 8 * q4);
    const float __attribute__((address_space(3)))* rp = (const float __attribute__((address_space(3)))*)(lds + NL_RPB);
    const int kid = 8 * (l15 >> 2) + (l15 & 3);
    const auto krs = __builtin_amdgcn_make_buffer_rsrc((void*)KN, 0, TA * 512 * 2, 0x00020000);
    const auto vrs = __builtin_amdgcn_make_buffer_rsrc((void*)VT, 0, TA * 512 * 2, 0x00020000);
    const unsigned kwin = (unsigned)((b * SEQ + rs * GW + kc0) * 512 + h * 64) * 2u;
    const unsigned klane = (unsigned)(kid * 512 + 8 * q4) * 2u;
    const unsigned vth = (unsigned)(((b * 8 + h) * 64) * 2048 + rs * GW + kc0) * 2u;
    const unsigned vlw = (unsigned)(l15 * 2048 + 8 * q4) * 2u;
    bf16x8 fb[2][8];
    f32x4 sc[16];
    f32x4 o[4];
#pragma unroll
    for (int dt = 0; dt < 4; ++dt) o[dt] = (f32x4){0.f, 0.f, 0.f, 0.f};
#define NA_LOAD(n_) do { constexpr int n = (n_); constexpr int bq = n & 3; constexpr bool isv = (n & 4) != 0, isc = n >= 8; \
        if (!isv) { _Pragma("unroll") for (int u = 0; u < 4; ++u) { const int ti = bq * 4 + u, g = ti >> 1, T = ti & 1; \
            if (isc) { fb[n & 1][2 * u] = *(const __attribute__((address_space(3))) bf16x8*)(lds + NL_K + (32 * g + 4 * T + kid) * 144 + q4 * 16); \
                       fb[n & 1][2 * u + 1] = *(const __attribute__((address_space(3))) bf16x8*)(lds + NL_K + (32 * g + 4 * T + kid) * 144 + q4 * 16 + 64); } \
            else { const int col_ = kc0 + 4 * T + kid, fx_ = na_swz(col_); const int ro_ = NL_KW + ((rs - rsb + g) * 64 + col_) * 128; \
                fb[n & 1][2 * u] = *(const __attribute__((address_space(3))) bf16x8*)(lds + ro_ + ((q4 ^ fx_) * 16)); \
                fb[n & 1][2 * u + 1] = *(const __attribute__((address_space(3))) bf16x8*)(lds + ro_ + (((q4 + 4) ^ fx_) * 16)); } } } \
        else { _Pragma("unroll") for (int u = 0; u < 2; ++u) { const int ks = bq * 2 + u; _Pragma("unroll") for (int dt = 0; dt < 4; ++dt) \
            { if (isc) fb[n & 1][4 * u + dt] = *(const __attribute__((address_space(3))) bf16x8*)(lds + NL_VT + (16 * dt + l15) * 528 + (32 * ks + 8 * q4) * 2); \
              else fb[n & 1][4 * u + dt] = *(const __attribute__((address_space(3))) bf16x8*)(lds + NL_VW + (16 * dt + l15) * 1168 + ((rs - rsb + ks) * 64 + kc0 + 8 * q4) * 2); } } } } while (0)
#define NA_QK(n_) do { constexpr int n = (n_); constexpr int bq = n & 3; constexpr bool isc = n >= 8; \
        _Pragma("unroll") for (int u = 0; u < 4; ++u) { const int ti = bq * 4 + u; \
            f32x4 acc = (f32x4){0.f, 0.f, 0.f, 0.f}; \
            acc = __builtin_amdgcn_mfma_f32_16x16x32_bf16(fb[n & 1][2 * u], qf[0], acc, 0, 0, 0); \
            acc = __builtin_amdgcn_mfma_f32_16x16x32_bf16(fb[n & 1][2 * u + 1], qf[1], acc, 0, 0, 0); \
            if (!isc) { const int i = ti >> 1, T = ti & 1, ri = rs + i - r + 7; \
                _Pragma("unroll") for (int e = 0; e < 4; ++e) { const int kcol = kc0 + 8 * q4 + 4 * T + e; const bool valid = kcol >= cs && kcol < cs + 16; \
                    const int ci = min(max(kcol - qc + 15, 0), 30); acc[e] = valid ? acc[e] + rp[ri * 31 + ci] : -1e30f; } } \
            sc[ti] = acc; } } while (0)
#define NA_PV(n_) do { constexpr int n = (n_); constexpr int bq = n & 3; \
        _Pragma("unroll") for (int u = 0; u < 2; ++u) { const int ks = bq * 2 + u; \
            u32x4 bw; bw.x = pk2(sc[2 * ks][0], sc[2 * ks][1]); bw.y = pk2(sc[2 * ks][2], sc[2 * ks][3]); bw.z = pk2(sc[2 * ks + 1][0], sc[2 * ks + 1][1]); bw.w = pk2(sc[2 * ks + 1][2], sc[2 * ks + 1][3]); \
            const bf16x8 B = __builtin_bit_cast(bf16x8, bw); \
            _Pragma("unroll") for (int dt = 0; dt < 4; ++dt) o[dt] = __builtin_amdgcn_mfma_f32_16x16x32_bf16(fb[n & 1][4 * u + dt], B, o[dt], 0, 0, 0); } } while (0)
    NA_LOAD(0);
    NA_LOAD(1); NA_QK(0);
    NA_LOAD(2); NA_QK(1);
    NA_LOAD(3); NA_QK(2);
    NA_LOAD(4); NA_QK(3);
    float m1 = -1e30f;
#pragma unroll
    for (int ti = 0; ti < 16; ++ti) m1 = fmaxf(fmaxf(fmaxf(m1, sc[ti][0]), fmaxf(sc[ti][1], sc[ti][2])), sc[ti][3]);
    m1 = fmaxf(m1, __shfl_xor(m1, 16)); m1 = fmaxf(m1, __shfl_xor(m1, 32));
    float l = 0.f;
#pragma unroll
    for (int ti = 0; ti < 16; ++ti) {
#pragma unroll
        for (int e = 0; e < 4; ++e) { const float pe = __expf(sc[ti][e] - m1); sc[ti][e] = pe; l += pe; }
    }
    NA_LOAD(5); NA_PV(4);
    NA_LOAD(6); NA_PV(5);
    NA_LOAD(7); NA_PV(6);
    NA_PV(7);
    __syncthreads();
    { int tl = threadIdx.x; asm volatile("" : "+v"(tl));
      const bf16_t* VTC = VT + (size_t)32 * MiB / 2;
#pragma unroll
      for (int q = 0; q < 4; ++q) { const int c = tl + NT * q;
          const u32x4 kv = *(const u32x4*)(KN + ((size_t)TL + b * CTX + (c >> 3)) * 512 + h * 64 + (c & 7) * 8);
          const u32x4 vv = *(const u32x4*)(VTC + ((size_t)(b * 8 + h) * 64 + (c >> 5)) * 256 + (c & 31) * 8);
          *(__attribute__((address_space(3))) u32x4*)(lds + NL_K + (c >> 3) * 144 + (c & 7) * 16) = kv;
          *(__attribute__((address_space(3))) u32x4*)(lds + NL_VT + (c >> 5) * 528 + (c & 31) * 16) = vv; } }
    __syncthreads();
    NA_LOAD(8);
    NA_LOAD(9); NA_QK(8);
    NA_LOAD(10); NA_QK(9);
    NA_LOAD(11); NA_QK(10);
    NA_LOAD(12); NA_QK(11);
    float m2 = -1e30f;
#pragma unroll
    for (int ti = 0; ti < 16; ++ti) m2 = fmaxf(fmaxf(fmaxf(m2, sc[ti][0]), fmaxf(sc[ti][1], sc[ti][2])), sc[ti][3]);
    m2 = fmaxf(m2, __shfl_xor(m2, 16)); m2 = fmaxf(m2, __shfl_xor(m2, 32));
    const float mm = fmaxf(m1, m2), al = __expf(m1 - mm);
    l *= al;
#pragma unroll
    for (int dt = 0; dt < 4; ++dt) o[dt] = o[dt] * al;
#pragma unroll
    for (int ti = 0; ti < 16; ++ti) {
#pragma unroll
        for (int e = 0; e < 4; ++e) { const float pe = __expf(sc[ti][e] - mm); sc[ti][e] = pe; l += pe; }
    }
    NA_LOAD(13); NA_PV(12);
    NA_LOAD(14); NA_PV(13);
    NA_LOAD(15); NA_PV(14);
    NA_PV(15);
#undef NA_LOAD
#undef NA_QK
#undef NA_PV
    l += __shfl_xor(l, 16); l += __shfl_xor(l, 32);
    const float il = 1.f / l;
    bf16_t* ONA = (bf16_t*)(p.ws + WS_ONA);
#pragma unroll
    for (int dt = 0; dt < 4; ++dt) { u32x2 w; w.x = pk2(o[dt][0] * il, o[dt][1] * il); w.y = pk2(o[dt][2] * il, o[dt][3] * il);
        *(u32x2*)(ONA + (size_t)qtok * 512 + h * 64 + 16 * dt + 4 * q4) = w; }
}

#ifndef LAS
#define LAS __attribute__((address_space(3)))
#endif
constexpr int GL_Q = 0;
constexpr int GL_K = 17408;
constexpr int GL_KT = 34816;
constexpr int GL_VR = 53248;
constexpr int GL_VT = 69632;
constexpr int GL_ATT = 88064;
constexpr int GL_O = 97280;
constexpr int GL_ALR = 114688;
constexpr int GL_SEG = 118784;
constexpr int GL_D = 120832;
__device__ __forceinline__ int gla_row0(int b, int dir, int n) {
    if (n < 4) return TL + b * CTX + (dir == 0 ? n : 3 - n) * 64;
    return b * SEQ + (dir == 0 ? n - 4 : 35 - n) * 64;
}
__device__ void gla_chain(const Params& p, unsigned char* ldsg, int item) {
    LAS unsigned char* lds = (LAS unsigned char*)ldsg;
    const int tid = threadIdx.x, lane = tid & 63, wave = tid >> 6;
    const int slice = item & 1, dir = (item >> 1) & 1, h = (item >> 2) & 3, b = item >> 4;
    const int d_ = tid & 127, seg = tid >> 7, l15 = lane & 15, q4 = lane >> 4;
    const bf16_t* QG = (const bf16_t*)(p.ws + WS_QG); const bf16_t* KG = (const bf16_t*)(p.ws + WS_KG); const bf16_t* VG = (const bf16_t*)(p.ws + WS_VG);
    const float* ALR = (const float*)(p.ws + WS_ALR);
    bf16_t* OX = (bf16_t*)((unsigned char*)p.out + (dir == 0 ? 0 : (size_t)64 * MiB));
    float w2[16];
#pragma unroll
    for (int r = 0; r < 16; ++r) w2[r] = p.in[I_WA2][(dir * 16 + r) * 512 + h * 128 + d_];
    const float b2 = p.in[I_BA2][dir * 512 + h * 128 + d_];
    f32x4 S[8];
#pragma unroll
    for (int i = 0; i < 8; ++i) S[i] = (f32x4){0.f, 0.f, 0.f, 0.f};
    u32x4 pq[2], pk[2], pv[2], pa;
    {
        const int r0 = gla_row0(b, dir, 0);
#pragma unroll
        for (int j = 0; j < 2; ++j) { const int c = tid + 512 * j, row = c >> 4, c16 = c & 15;
            pq[j] = (u32x4){0u, 0u, 0u, 0u};
            pk[j] = *(const u32x4*)(KG + (size_t)(r0 + row) * 512 + h * 128 + c16 * 8);
            pv[j] = *(const u32x4*)(VG + (size_t)(r0 + row) * 1024 + h * 256 + slice * 128 + c16 * 8); }
        pa = (u32x4){0u, 0u, 0u, 0u};
        if (tid < 256) pa = *(const u32x4*)(ALR + (size_t)(r0 + (tid >> 2)) * 32 + dir * 16 + (tid & 3) * 4);
    }
    for (int n = 0; n < 36; ++n) {
        const bool lat = n >= 4;
        const int r0 = gla_row0(b, dir, n);
#pragma unroll
        for (int j = 0; j < 2; ++j) { const int c = tid + 512 * j, row = c >> 4, c16 = c & 15;
            *(LAS u32x4*)(lds + GL_Q + row * 272 + c16 * 16) = pq[j];
            *(LAS u32x4*)(lds + GL_K + row * 272 + c16 * 16) = pk[j];
            *(LAS u32x4*)(lds + GL_VR + row * 256 + c16 * 16) = pv[j]; }
        if (tid < 256) *(LAS u32x4*)(lds + GL_ALR + (tid >> 2) * 64 + (tid & 3) * 16) = pa;
        if (n + 1 < 36) {
            const int r1 = gla_row0(b, dir, n + 1); const bool lat1 = n + 1 >= 4;
#pragma unroll
            for (int j = 0; j < 2; ++j) { const int c = tid + 512 * j, row = c >> 4, c16 = c & 15;
                if (lat1) pq[j] = *(const u32x4*)(QG + (size_t)(r1 + row) * 512 + h * 128 + c16 * 8);
                pk[j] = *(const u32x4*)(KG + (size_t)(r1 + row) * 512 + h * 128 + c16 * 8);
                pv[j] = *(const u32x4*)(VG + (size_t)(r1 + row) * 1024 + h * 256 + slice * 128 + c16 * 8); }
            if (tid < 256) pa = *(const u32x4*)(ALR + (size_t)(r1 + (tid >> 2)) * 32 + dir * 16 + (tid & 3) * 4);
        }
        __syncthreads();
        float g[16];
#pragma unroll
        for (int i = 0; i < 16; ++i) {
            const int t = 16 * seg + i;
            float z = b2;
#pragma unroll
            for (int r4 = 0; r4 < 4; ++r4) { const f32x4 a = *(const LAS f32x4*)(lds + GL_ALR + t * 64 + r4 * 16);
                z += a[0] * w2[4 * r4] + a[1] * w2[4 * r4 + 1] + a[2] * w2[4 * r4 + 2] + a[3] * w2[4 * r4 + 3]; }
            const float ls = fminf(z, 0.f) - __logf(1.f + __expf(-fabsf(z)));
            g[i] = ls * (1.f / 16.f);
        }
        if (dir == 0) {
#pragma unroll
            for (int i = 1; i < 16; ++i) g[i] += g[i - 1];
        } else {
#pragma unroll
            for (int i = 14; i >= 0; --i) g[i] += g[i + 1];
        }
        *(LAS float*)(lds + GL_SEG + (seg * 128 + d_) * 4) = dir == 0 ? g[15] : g[0];
        __syncthreads();
        {
            const float s0 = *(const LAS float*)(lds + GL_SEG + (0 * 128 + d_) * 4), s1 = *(const LAS float*)(lds + GL_SEG + (1 * 128 + d_) * 4),
                        s2 = *(const LAS float*)(lds + GL_SEG + (2 * 128 + d_) * 4), s3 = *(const LAS float*)(lds + GL_SEG + (3 * 128 + d_) * 4);
            float off;
            if (dir == 0) off = (seg > 0 ? s0 : 0.f) + (seg > 1 ? s1 : 0.f) + (seg > 2 ? s2 : 0.f);
            else off = (seg < 1 ? s1 : 0.f) + (seg < 2 ? s2 : 0.f) + (seg < 3 ? s3 : 0.f);
            if (seg == 0) *(LAS float*)(lds + GL_D + d_ * 4) = __expf((s0 + s1) + (s2 + s3));
            unsigned kt[8], vt[8];
#pragma unroll
            for (int i = 0; i < 16; ++i) {
                const int t = 16 * seg + i;
                const float bb = g[i] + off, e1 = __expf(bb), e2 = __builtin_amdgcn_rcpf(e1);
                if (lat) { LAS unsigned short* qp = (LAS unsigned short*)(lds + GL_Q + t * 272 + d_ * 2); *qp = (unsigned short)f2bf(bf2f(*qp) * e1); }
                LAS unsigned short* kp = (LAS unsigned short*)(lds + GL_K + t * 272 + d_ * 2);
                const unsigned kb = f2bf(bf2f(*kp) * e2);
                if (lat) *kp = (unsigned short)kb;
                const unsigned vb = *(const LAS unsigned short*)(lds + GL_VR + t * 256 + d_ * 2);
                if (i & 1) { kt[i >> 1] |= kb << 16; vt[i >> 1] |= vb << 16; } else { kt[i >> 1] = kb; vt[i >> 1] = vb; }
            }
            *(LAS u32x4*)(lds + GL_KT + d_ * 144 + seg * 32) = (u32x4){kt[0], kt[1], kt[2], kt[3]};
            *(LAS u32x4*)(lds + GL_KT + d_ * 144 + seg * 32 + 16) = (u32x4){kt[4], kt[5], kt[6], kt[7]};
            *(LAS u32x4*)(lds + GL_VT + d_ * 144 + seg * 32) = (u32x4){vt[0], vt[1], vt[2], vt[3]};
            *(LAS u32x4*)(lds + GL_VT + d_ * 144 + seg * 32 + 16) = (u32x4){vt[4], vt[5], vt[6], vt[7]};
        }
        __syncthreads();
        if (lat) {
            const int tt = wave >> 1, ss0 = (wave & 1) * 2;
            f32x4 a0 = (f32x4){0.f, 0.f, 0.f, 0.f}, a1 = (f32x4){0.f, 0.f, 0.f, 0.f};
#pragma unroll
            for (int kk = 0; kk < 4; ++kk) {
                const bf16x8 A = *(const LAS bf16x8*)(lds + GL_Q + (16 * tt + l15) * 272 + (32 * kk + 8 * q4) * 2);
                const bf16x8 B0 = *(const LAS bf16x8*)(lds + GL_K + (16 * ss0 + l15) * 272 + (32 * kk + 8 * q4) * 2);
                const bf16x8 B1 = *(const LAS bf16x8*)(lds + GL_K + (16 * (ss0 + 1) + l15) * 272 + (32 * kk + 8 * q4) * 2);
                a0 = __builtin_amdgcn_mfma_f32_16x16x32_bf16(A, B0, a0, 0, 0, 0);
                a1 = __builtin_amdgcn_mfma_f32_16x16x32_bf16(A, B1, a1, 0, 0, 0);
            }
#pragma unroll
            for (int r = 0; r < 4; ++r) {
                const int t = 16 * tt + 4 * q4 + r, sA = 16 * ss0 + l15, sB = sA + 16;
                const bool kA = dir == 0 ? (sA <= t) : (sA >= t), kB = dir == 0 ? (sB <= t) : (sB >= t);
                *(LAS unsigned short*)(lds + GL_ATT + t * 144 + sA * 2) = (unsigned short)f2bf(kA ? a0[r] : 0.f);
                *(LAS unsigned short*)(lds + GL_ATT + t * 144 + sB * 2) = (unsigned short)f2bf(kB ? a1[r] : 0.f);
            }
        }
        __syncthreads();
        {
            bf16x8 vB[2];
#pragma unroll
            for (int kk = 0; kk < 2; ++kk) vB[kk] = *(const LAS bf16x8*)(lds + GL_VT + (16 * wave + l15) * 144 + (32 * kk + 8 * q4) * 2);
            if (lat) {
                f32x4 o[4];
#pragma unroll
                for (int tt = 0; tt < 4; ++tt) o[tt] = (f32x4){0.f, 0.f, 0.f, 0.f};
#pragma unroll
                for (int tt = 0; tt < 4; ++tt)
#pragma unroll
                    for (int kk = 0; kk < 2; ++kk) { const bf16x8 A = *(const LAS bf16x8*)(lds + GL_ATT + (16 * tt + l15) * 144 + (32 * kk + 8 * q4) * 2);
                        o[tt] = __builtin_amdgcn_mfma_f32_16x16x32_bf16(A, vB[kk], o[tt], 0, 0, 0); }
#pragma unroll
                for (int kk = 0; kk < 4; ++kk) {
                    const f32x4 sa = S[2 * kk], sb = S[2 * kk + 1];
                    u32x4 bw; bw.x = pk2(sa[0], sa[1]); bw.y = pk2(sa[2], sa[3]); bw.z = pk2(sb[0], sb[1]); bw.w = pk2(sb[2], sb[3]);
                    const bf16x8 Bs = __builtin_bit_cast(bf16x8, bw);
#pragma unroll
                    for (int tt = 0; tt < 4; ++tt) {
                        const u32x2 lo = *(const LAS u32x2*)(lds + GL_Q + (16 * tt + l15) * 272 + (32 * kk + 4 * q4) * 2);
                        const u32x2 hi = *(const LAS u32x2*)(lds + GL_Q + (16 * tt + l15) * 272 + (32 * kk + 16 + 4 * q4) * 2);
                        const bf16x8 A = __builtin_bit_cast(bf16x8, (u32x4){lo.x, lo.y, hi.x, hi.y});
                        o[tt] = __builtin_amdgcn_mfma_f32_16x16x32_bf16(A, Bs, o[tt], 0, 0, 0);
                    }
                }
#pragma unroll
                for (int tt = 0; tt < 4; ++tt)
#pragma unroll
                    for (int r = 0; r < 4; ++r) *(LAS unsigned short*)(lds + GL_O + (16 * tt + 4 * q4 + r) * 272 + (16 * wave + l15) * 2) = (unsigned short)f2bf(o[tt][r]);
            }
#pragma unroll
            for (int dt = 0; dt < 8; ++dt) {
#pragma unroll
                for (int kk = 0; kk < 2; ++kk) { const bf16x8 A = *(const LAS bf16x8*)(lds + GL_KT + (16 * dt + l15) * 144 + (32 * kk + 8 * q4) * 2);
                    S[dt] = __builtin_amdgcn_mfma_f32_16x16x32_bf16(A, vB[kk], S[dt], 0, 0, 0); }
                const f32x4 Dv = *(const LAS f32x4*)(lds + GL_D + (16 * dt + 4 * q4) * 4);
                S[dt] = S[dt] * Dv;
            }
        }
        __syncthreads();
        if (lat) {
#pragma unroll
            for (int j = 0; j < 2; ++j) { const int c = tid + 512 * j, row = c >> 4, c16 = c & 15;
                const u32x4 v = *(const LAS u32x4*)(lds + GL_O + row * 272 + c16 * 16);
                *(u32x4*)(OX + (size_t)(r0 + row) * 1024 + h * 256 + slice * 128 + c16 * 8) = v; }
        }
    }
    __syncthreads();
}

__device__ void phase3(const Params& p, unsigned char* lds, int bid, int nb) {
    for (int it = bid; it < 256; it += nb) gla_chain(p, lds, it);
    {
        const bool xm = (nb & 7) == 0;
        const int wv = __builtin_amdgcn_readfirstlane(threadIdx.x >> 6), tid = threadIdx.x;
        const int s0 = xm ? (bid >> 3) : bid, ds = xm ? (nb >> 3) : nb, smax = xm ? 32 : 256;
        const bf16_t* KN = (const bf16_t*)(p.ws + WS_KN); const bf16_t* VTW = (const bf16_t*)(p.ws + WS_VN);
        const float* RPB = p.in[I_RPB];
        for (int sl = s0; sl < smax; sl += ds) {
            const int slab = xm ? ((((bid & 7) + 8 * (sl >> 4)) << 4) | (sl & 15)) : sl;
            const int b = slab >> 4, h = (slab >> 1) & 7, half = slab & 1;
            __syncthreads();
            for (int i = tid; i < 465; i += NT) ((float*)(lds + NL_RPB))[i] = RPB[h * 465 + i];
            _Pragma("nounroll") for (int it = 0; it < 8; ++it) {
                const int r0 = 16 * half + 2 * it, rsb = min(max(r0 - 4, 0), 24), nrows = min(9, 32 - rsb);
                __syncthreads();
                int t2 = tid; asm volatile("" : "+v"(t2));
#pragma unroll
                for (int q = 0; q < 9; ++q) { const int c = t2 + NT * q, slot = c >> 9, tok = (c >> 3) & 63, ch = c & 7;
                    if (slot < nrows) { const u32x4 kv = *(const u32x4*)(KN + ((size_t)b * SEQ + (rsb + slot) * GW + tok) * 512 + h * 64 + ch * 8);
                        *(u32x4*)(lds + NL_KW + (slot * 64 + tok) * 128 + ((ch ^ na_swz(tok)) * 16)) = kv;
                        const u32x4 vv = *(const u32x4*)(VTW + ((size_t)(b * 8 + h) * 64 + tok) * 2048 + (rsb + slot) * GW + ch * 8);
                        *(u32x4*)(lds + NL_VW + tok * 1168 + (slot * 64 + ch * 8) * 2) = vv; } }
                __syncthreads();
                const int idx = it * 8 + wv; na_item(p, lds, b, 16 * half + (idx >> 2), idx & 3, h, rsb);
            }
        }
    }
    __syncthreads();
}

__device__ void phase4r(const Params& p, int bid, int nb) {
    const int lane = threadIdx.x & 63;
    const int gw = bid * 8 + (threadIdx.x >> 6), ngw = nb * 8;
    const bf16_t* OF = (const bf16_t*)p.out; const bf16_t* OB = (const bf16_t*)((const unsigned char*)p.out + (size_t)64 * MiB); bf16_t* GG = (bf16_t*)(p.ws + WS_GG);
    const float* gng = p.in[I_GNG];
    for (int row = gw; row < TL; row += ngw) {
        f32x4 v[4]; float s = 0.f;
        {
            const u32x4* fp = (const u32x4*)(OF + (size_t)row * 1024 + 16 * lane); const u32x4* bp = (const u32x4*)(OB + (size_t)row * 1024 + 16 * lane);
            const u32x4 f0 = fp[0], f1 = fp[1], b0 = bp[0], b1 = bp[1];
            v[0] = (f32x4){bflo(f0.x) + bflo(b0.x), bfhi(f0.x) + bfhi(b0.x), bflo(f0.y) + bflo(b0.y), bfhi(f0.y) + bfhi(b0.y)};
            v[1] = (f32x4){bflo(f0.z) + bflo(b0.z), bfhi(f0.z) + bfhi(b0.z), bflo(f0.w) + bflo(b0.w), bfhi(f0.w) + bfhi(b0.w)};
            v[2] = (f32x4){bflo(f1.x) + bflo(b1.x), bfhi(f1.x) + bfhi(b1.x), bflo(f1.y) + bflo(b1.y), bfhi(f1.y) + bfhi(b1.y)};
            v[3] = (f32x4){bflo(f1.z) + bflo(b1.z), bfhi(f1.z) + bfhi(b1.z), bflo(f1.w) + bflo(b1.w), bfhi(f1.w) + bfhi(b1.w)};
#pragma unroll
            for (int j = 0; j < 4; ++j) s += v[j][0] * v[j][0] + v[j][1] * v[j][1] + v[j][2] * v[j][2] + v[j][3] * v[j][3];
        }
        s += __shfl_xor(s, 1); s += __shfl_xor(s, 2); s += __shfl_xor(s, 4); s += __shfl_xor(s, 8);
        const float rstd = rsqrtf(s * (1.f / 256.f) + EPS);
        u32x4* gp = (u32x4*)(GG + (size_t)row * 1024 + 16 * lane);
        const u32x4 g0 = gp[0], g1 = gp[1];
        const unsigned gu[8] = {g0.x, g0.y, g0.z, g0.w, g1.x, g1.y, g1.z, g1.w};
        unsigned ou[8];
#pragma unroll
        for (int j = 0; j < 8; ++j) {
            const int c = (16 * lane + 2 * j) & 255;
            const float a0 = v[j >> 1][(2 * j) & 3] * rstd * gng[c] * siluf_(bflo(gu[j]));
            const float a1 = v[j >> 1][(2 * j + 1) & 3] * rstd * gng[c + 1] * siluf_(bfhi(gu[j]));
            ou[j] = pk2(a0, a1);
        }
        gp[0] = (u32x4){ou[0], ou[1], ou[2], ou[3]}; gp[1] = (u32x4){ou[4], ou[5], ou[6], ou[7]};
    }
}

struct SchedSq {
    __device__ __forceinline__ void a_ready(const Unit&) const {}
    __device__ __forceinline__ void done(const Unit&) const {}
    const bf16_t* A0; const bf16_t* B0; int K0; const bf16_t* A1; const bf16_t* B1; int K1; int passes; int G, c;
    __device__ bool next(int i, Unit& u) const {
        const int s = i % passes;
        if ((G & 7) == 0) {
            const int t = (i / passes) * (G >> 3) + (c >> 3); if (t >= 64) return false;
            u.pm = 16 * (c & 7) + (t >> 2); u.pn = t & 3;
        } else { const int L = (i / passes) * G + c; if (L >= 512) return false; u.pm = L >> 2; u.pn = L & 3; }
        u.aux = s; u.rbase = 0; u.nvalid = 0;
        if (s == 0) { u.a = A0 + (size_t)u.pm * 256 * K0; u.b = B0 + (size_t)u.pn * 256 * K0; }
        else { u.a = A1 + (size_t)u.pm * 256 * K1; u.b = B1 + (size_t)u.pn * 256 * K1; }
        return true;
    }
};
struct EpiMerge {
    static constexpr bool PERM = false, AFTER_DRAIN = false;
    unsigned char* ws; int pass;
    __device__ __forceinline__ void operator()(const f32x4 (&acc)[2][2][4][2], const Unit& u, int wr, int wc, int fr, int fq) const {
        bf16_t* M8 = (bf16_t*)(ws + WS_M8); const bf16_t* M9 = (const bf16_t*)(ws + WS_M9);
        const int row0 = u.pm * 256 + wr * 64 + fr, col0 = u.pn * 256 + wc * 32 + 4 * fq;
        u32x2 g8[2][2][2], g9[2][2][2];
#define EM_LOAD(k_, buf_) do { _Pragma("unroll") for (int bj = 0; bj < 2; ++bj) _Pragma("unroll") for (int n = 0; n < 2; ++n) { \
            const size_t off = (size_t)(row0 + ((k_) >> 2) * 128 + ((k_) & 3) * 16) * 1024 + col0 + bj * 128 + n * 16; \
            g8[buf_][bj][n] = *(const u32x2*)(M8 + off); if (pass != 0) g9[buf_][bj][n] = *(const u32x2*)(M9 + off); } } while (0)
#define EM_STORE(k_, buf_) do { _Pragma("unroll") for (int bj = 0; bj < 2; ++bj) _Pragma("unroll") for (int n = 0; n < 2; ++n) { \
            const int ai = (k_) >> 2, m = (k_) & 3; \
            const size_t off = (size_t)(row0 + ai * 128 + m * 16) * 1024 + col0 + bj * 128 + n * 16; \
            const f32x4 v = acc[ai][bj][m][n]; const u32x2 g = g8[buf_][bj][n]; u32x2 w; \
            if (pass == 0) { w.x = pk2(v[0] * sigmoidf_(bflo(g.x)), v[1] * sigmoidf_(bfhi(g.x))); w.y = pk2(v[2] * sigmoidf_(bflo(g.y)), v[3] * sigmoidf_(bfhi(g.y))); } \
            else { const u32x2 q9 = g9[buf_][bj][n]; \
                w.x = pk2(bflo(g.x) + v[0] * sigmoidf_(bflo(q9.x)), bfhi(g.x) + v[1] * sigmoidf_(bfhi(q9.x))); \
                w.y = pk2(bflo(g.y) + v[2] * sigmoidf_(bflo(q9.y)), bfhi(g.y) + v[3] * sigmoidf_(bfhi(q9.y))); } \
            *(u32x2*)(M8 + off) = w; } } while (0)
        EM_LOAD(0, 0); EM_LOAD(1, 1);
        EM_STORE(0, 0); EM_LOAD(2, 0);
        EM_STORE(1, 1); EM_LOAD(3, 1);
        EM_STORE(2, 0); EM_LOAD(4, 0);
        EM_STORE(3, 1); EM_LOAD(5, 1);
        EM_STORE(4, 0); EM_LOAD(6, 0);
        EM_STORE(5, 1); EM_LOAD(7, 1);
        EM_STORE(6, 0);
        EM_STORE(7, 1);
#undef EM_LOAD
#undef EM_STORE
    }
};
struct EpiOut {
    static constexpr bool PERM = false, AFTER_DRAIN = false;
    const float* x; const float* MOD; bf16_t* HMID; float* ROWSS;
    __device__ __forceinline__ void operator()(const f32x4 (&acc)[2][2][4][2], const Unit& u, int wr, int wc, int fr, int fq) const {
        const int row0 = u.pm * 256 + wr * 64 + fr, col0 = u.pn * 256 + wc * 32 + 4 * fq;
        const int b = (u.pm * 256) >> 11;
        float ss[2][4];
#pragma unroll
        for (int ai = 0; ai < 2; ++ai)
#pragma unroll
            for (int m = 0; m < 4; ++m) ss[ai][m] = 0.f;
#pragma unroll
        for (int bj = 0; bj < 2; ++bj)
#pragma unroll
            for (int n = 0; n < 2; ++n) {
                const int c = col0 + bj * 128 + n * 16;
                const f32x4 g1 = *(const f32x4*)(MOD + b * 6144 + 2048 + c);
                f32x4 xin[2][4];
#pragma unroll
                for (int ai = 0; ai < 2; ++ai)
#pragma unroll
                    for (int m = 0; m < 4; ++m) xin[ai][m] = *(const f32x4*)(x + (size_t)(row0 + ai * 128 + m * 16) * 1024 + c);
#pragma unroll
                for (int ai = 0; ai < 2; ++ai)
#pragma unroll
                    for (int m = 0; m < 4; ++m) { const size_t off = (size_t)(row0 + ai * 128 + m * 16) * 1024 + c;
                        const f32x4 hv = xin[ai][m] + g1 * acc[ai][bj][m][n];
                        { u32x2 hw; hw.x = pk2(hv[0], hv[1]); hw.y = pk2(hv[2], hv[3]); *(u32x2*)(HMID + off) = hw; }
                        ss[ai][m] += (hv[0] * hv[0] + hv[1] * hv[1]) + (hv[2] * hv[2] + hv[3] * hv[3]); }
            }
#pragma unroll
        for (int ai = 0; ai < 2; ++ai)
#pragma unroll
            for (int m = 0; m < 4; ++m) { float v = ss[ai][m]; v += __shfl_xor(v, 16); v += __shfl_xor(v, 32);
                if (fq == 0) ROWSS[(size_t)(row0 + ai * 128 + m * 16) * 16 + u.pn * 4 + wc] = v; }
    }
};

constexpr int P5_WG = 131072;
__device__ void phase5(const Params& p, unsigned char* ldsg, int bid, int nb) {
    LAS unsigned char* lds = (LAS unsigned char*)ldsg;
    const int tid = threadIdx.x, lane = tid & 63, wave = tid >> 6, l15 = lane & 15, q4 = lane >> 4;
    const float* MOD = (const float*)(p.ws + WS_MOD); const bf16_t* HMID = (const bf16_t*)(p.ws + WS_HMID); const float* ROWSS = (const float*)(p.ws + WS_ROWSS);
    bf16_t* FL = (bf16_t*)(p.ws + WS_FL);
    const float* G = p.in[I_NFG]; const float* WGR = p.in[I_WGRP]; const float* WEX = p.in[I_WEXP]; const float* BGR = p.in[I_BGRP]; const float* BEX = p.in[I_BEXP];
    int* cnt = (int*)(p.ws + WS_CTL) + CW_CNT;
    if (bid == 0 && tid < 128) *(u32x4*)(FL + (size_t)TL * DM + tid * 8) = (u32x4){0u, 0u, 0u, 0u};
    for (int c = tid; c < 8192; c += NT) {
        const int k = c >> 3, o4 = c & 7;
        const f32x4 w = *(const f32x4*)(WEX + (size_t)k * 32 + 4 * o4);
#pragma unroll
        for (int i = 0; i < 4; ++i) *(LAS float*)(lds + ((((k >> 2) * 32 + 4 * o4 + i) * 4 + (k & 3)) * 4)) = w[i];
    }
    for (int c = tid; c < 1024; c += NT) *(LAS f32x4*)(lds + P5_WG + c * 16) = *(const f32x4*)(WGR + (size_t)c * 4);
    __syncthreads();
    for (int tile0 = bid * 8; tile0 < TL / 16; tile0 += nb * 8) {
        const int tile = tile0 + wave;
        const int tok = tile * 16 + l15, b = (tile * 16) >> 11;
        float rstd;
        { const f32x4 r4 = *(const f32x4*)(ROWSS + (size_t)tok * 16 + 4 * q4); float v = (r4[0] + r4[1]) + (r4[2] + r4[3]); v += __shfl_xor(v, 16); v += __shfl_xor(v, 32);
          rstd = rsqrtf(v * (1.f / DM) + EPS); }
        f32x4 acc0 = (f32x4){0.f, 0.f, 0.f, 0.f}, acc1 = (f32x4){0.f, 0.f, 0.f, 0.f};
        float lg[4] = {0.f, 0.f, 0.f, 0.f};
        const bf16_t* hrow = HMID + (size_t)tok * DM + 4 * q4; const float* modb = MOD + b * 6144 + 4 * q4; const float* gq = G + 4 * q4;
        bf16_t* flrow = FL + (size_t)tok * DM + 4 * q4;
        f32x4 hv[2][2], gv[2][2], sh[2][2], sc[2][2];
#define P5_LOAD(gn_, buf_) do { _Pragma("unroll") for (int uu = 0; uu < 2; ++uu) { const int c = 16 * (2 * (gn_) + uu); \
            { const u32x2 hw = *(const u32x2*)(hrow + c); hv[buf_][uu] = (f32x4){bflo(hw.x), bfhi(hw.x), bflo(hw.y), bfhi(hw.y)}; } gv[buf_][uu] = *(const f32x4*)(gq + c); sh[buf_][uu] = *(const f32x4*)(modb + 3072 + c); sc[buf_][uu] = *(const f32x4*)(modb + 4096 + c); } } while (0)
        P5_LOAD(0, 0);
#define P5_COMP(gn_, bf_) do { u32x2 wst[2]; \
            _Pragma("unroll") for (int uu = 0; uu < 2; ++uu) { const int u = 2 * (gn_) + uu; f32x4 f; \
                _Pragma("unroll") for (int i = 0; i < 4; ++i) f[i] = (hv[bf_][uu][i] * rstd) * gv[bf_][uu][i] * (1.f + sc[bf_][uu][i]) + sh[bf_][uu][i]; \
                wst[uu].x = pk2(f[0], f[1]); wst[uu].y = pk2(f[2], f[3]); \
                const f32x4 w0 = *(const LAS f32x4*)(lds + ((4 * u + q4) * 32 + l15) * 16), w1 = *(const LAS f32x4*)(lds + ((4 * u + q4) * 32 + 16 + l15) * 16); \
                _Pragma("unroll") for (int e = 0; e < 4; ++e) { \
                    acc0 = __builtin_amdgcn_mfma_f32_16x16x4f32(f[e], w0[e], acc0, 0, 0, 0); \
                    acc1 = __builtin_amdgcn_mfma_f32_16x16x4f32(f[e], w1[e], acc1, 0, 0, 0); \
                    const f32x4 wg = *(const LAS f32x4*)(lds + P5_WG + (16 * u + 4 * q4 + e) * 16); \
                    lg[0] += f[e] * wg[0]; lg[1] += f[e] * wg[1]; lg[2] += f[e] * wg[2]; lg[3] += f[e] * wg[3]; } } \
            _Pragma("unroll") for (int uu = 0; uu < 2; ++uu) *(u32x2*)(flrow + 16 * (2 * (gn_) + uu)) = wst[uu]; } while (0)
#pragma unroll 1
        for (int g2 = 0; g2 < 16; ++g2) {
            P5_LOAD(2 * g2 + 1, 1);
            P5_COMP(2 * g2, 0);
            if (g2 < 15) P5_LOAD(2 * g2 + 2, 0);
            P5_COMP(2 * g2 + 1, 1);
        }
#undef P5_COMP
#undef P5_LOAD
#pragma unroll
        for (int e = 0; e < 4; ++e) { float v = lg[e]; v += __shfl_xor(v, 16); v += __shfl_xor(v, 32); lg[e] = v + BGR[e]; }
        __syncthreads();
        LAS float* sl = (LAS float*)(lds + wave * (16 * 33 * 4));
        LAS int* bcnt = (LAS int*)(lds + 32768);
        if (tid < 32) bcnt[tid] = 0;
#pragma unroll
        for (int r = 0; r < 4; ++r) { sl[(4 * q4 + r) * 33 + l15] = acc0[r]; sl[(4 * q4 + r) * 33 + 16 + l15] = acc1[r]; }
        __syncthreads();
        int x1 = 0, x2 = 0, lr1 = 0, lr2 = 0; float w1 = 0.f, w2 = 0.f;
        if (lane < 16) {
            int grp = 0; float gm = lg[0];
#pragma unroll
            for (int e = 1; e < 4; ++e) if (lg[e] > gm) { gm = lg[e]; grp = e; }
            float gs = 0.f;
#pragma unroll
            for (int e = 0; e < 4; ++e) gs += __expf(lg[e] - gm);
            const float pgrp = 1.f / gs;
            float l8[8];
#pragma unroll
            for (int e = 0; e < 8; ++e) l8[e] = sl[lane * 33 + grp * 8 + e] + BEX[grp * 8 + e];
            int i1 = 0; float m1 = l8[0];
#pragma unroll
            for (int e = 1; e < 8; ++e) if (l8[e] > m1) { m1 = l8[e]; i1 = e; }
            int i2 = -1; float m2 = -3.0e38f;
#pragma unroll
            for (int e = 0; e < 8; ++e) if (e != i1 && l8[e] > m2) { m2 = l8[e]; i2 = e; }
            const float e2 = __expf(m2 - m1);
            w1 = pgrp / (1.f + e2); w2 = pgrp * e2 / (1.f + e2);
            x1 = grp * 8 + i1; x2 = grp * 8 + i2;
            lr1 = __hip_atomic_fetch_add(bcnt + x1, 1, __ATOMIC_RELAXED, __HIP_MEMORY_SCOPE_WORKGROUP);
            lr2 = __hip_atomic_fetch_add(bcnt + x2, 1, __ATOMIC_RELAXED, __HIP_MEMORY_SCOPE_WORKGROUP);
        }
        __syncthreads();
        if (tid < 32) bcnt[32 + tid] = atomicAdd(&cnt[tid * 64], bcnt[tid]);
        __syncthreads();
        if (lane < 16) {
            int* ERT = (int*)(p.ws + WS_ERT); float* ERW = (float*)(p.ws + WS_ERW);
            const int i1 = x1 * ECAP + bcnt[32 + x1] + lr1, i2 = x2 * ECAP + bcnt[32 + x2] + lr2;
            ERT[i1] = tok * 2; ERW[i1] = w1; ERT[i2] = tok * 2 + 1; ERW[i2] = w2;
        }
        asm volatile("s_waitcnt lgkmcnt(0)" ::: "memory");
        if (tile0 + nb * 8 < TL / 16) {
            __syncthreads();
            for (int c = tid; c < 8192; c += NT) {
                const int k = c >> 3, o4 = c & 7;
                const f32x4 w = *(const f32x4*)(WEX + (size_t)k * 32 + 4 * o4);
#pragma unroll
                for (int i = 0; i < 4; ++i) *(LAS float*)(lds + ((((k >> 2) * 32 + 4 * o4 + i) * 4 + (k & 3)) * 4)) = w[i];
            }
            __syncthreads();
        }
    }
    __syncthreads();
}

__device__ void phase5b(const Params& p, float* lds, int bid, int nb) {
    const int lane = threadIdx.x & 63;
    const int gw = bid * 8 + (threadIdx.x >> 6), ngw = nb * 8;
    int* sstart = (int*)lds;
    if (threadIdx.x == 0) { const int* cnt = (const int*)(p.ws + WS_CTL) + CW_CNT; int a = 0; for (int e = 0; e < 32; ++e) { sstart[e] = a; a += ((cnt[e * 64] + 255) >> 8) << 8; } sstart[32] = a; }
    __syncthreads();
    const int* ROUTE = (const int*)(p.ws + WS_ROUTE);
    int* rowtok = (int*)(p.ws + WS_ROWTOK); float* roww = (float*)(p.ws + WS_ROWW);
    const bf16_t* FL = (const bf16_t*)(p.ws + WS_FL); bf16_t* XG = (bf16_t*)(p.ws + WS_XG);
    const int l15 = lane & 15, g4 = lane >> 4;
    for (int it4 = gw; it4 < TL * 2 / 4; it4 += ngw) {
        const int it = it4 * 4 + g4;
        const int tok = it >> 1, k = it & 1;
        const int* R = ROUTE + (size_t)tok * 8;
        const int e = R[k], rk = R[2 + k]; const float w = ((const float*)R)[4 + k];
        const int pos = sstart[e] + rk;
        if (l15 == 0) { rowtok[pos] = it; roww[pos] = w; }
        const u32x4* src = (const u32x4*)(FL + (size_t)tok * DM); u32x4* dst = (u32x4*)(XG + (size_t)pos * DM);
        u32x4 v[8];
#pragma unroll
        for (int q = 0; q < 8; ++q) v[q] = src[l15 + 16 * q];
#pragma unroll
        for (int q = 0; q < 8; ++q) dst[l15 + 16 * q] = v[q];
    }
    const int* cnt = (const int*)(p.ws + WS_CTL) + CW_CNT;
    for (int e = 0; e < 32; ++e) {
        const int c = cnt[e * 64], padn = (((c + 255) >> 8) << 8) - c;
        for (int r = gw; r < padn; r += ngw) { u32x4* dst = (u32x4*)(XG + (size_t)(sstart[e] + c + r) * DM); dst[lane] = (u32x4){0, 0, 0, 0}; dst[lane + 64] = (u32x4){0, 0, 0, 0}; }
    }
    __syncthreads();
}

struct SchedMoe {
    __device__ __forceinline__ void a_ready(const Unit&) const {}
    __device__ __forceinline__ void done(const Unit&) const {}
    const bf16_t* A; const bf16_t* B; int K; size_t bexp; const int* tstart;
    int G, c; bool gather;
    __device__ bool next(int i, Unit& u) const {
        const int ntile = __builtin_amdgcn_readfirstlane(tstart[32]);
        if ((G & 7) == 0) {
            const int t = i * (G >> 3) + (c >> 3);
            u.pm = 8 * (t >> 2) + (c & 7); u.pn = t & 3;
            if (u.pm >= ntile) return false;
        } else { const int L = i * G + c; if (L >= ntile * 4) return false; u.pm = L >> 2; u.pn = L & 3; }
        const int e = __builtin_amdgcn_readfirstlane(tstart[40 + u.pm]);
        const int j = u.pm - __builtin_amdgcn_readfirstlane(tstart[e]), ce = __builtin_amdgcn_readfirstlane(tstart[400 + e]);
        u.aux = e; u.rbase = e * ECAP + 256 * j; u.nvalid = min(256, ce - 256 * j);
        u.a = gather ? A : A + (size_t)u.pm * 256 * K; u.b = B + (size_t)e * bexp + (size_t)u.pn * 256 * K;
        return true;
    }
};
struct EpiGU {
    static constexpr bool PERM = false, AFTER_DRAIN = false;
    bf16_t* H;
    __device__ __forceinline__ void operator()(const f32x4 (&acc)[2][2][4][2], const Unit& u, int wr, int wc, int fr, int fq) const {
        const int row0 = u.pm * 256 + wr * 64 + fr, col0 = u.pn * 128 + wc * 32 + 4 * fq;
#pragma unroll
        for (int ai = 0; ai < 2; ++ai)
#pragma unroll
            for (int m = 0; m < 4; ++m)
#pragma unroll
                for (int n = 0; n < 2; ++n) {
                    const f32x4 g = acc[ai][0][m][n], up = acc[ai][1][m][n];
                    u32x2 w; w.x = pk2(siluf_(g[0]) * up[0], siluf_(g[1]) * up[1]); w.y = pk2(siluf_(g[2]) * up[2], siluf_(g[3]) * up[3]);
                    *(u32x2*)(H + (size_t)(row0 + ai * 128 + m * 16) * 512 + col0 + n * 16) = w;
                }
    }
};
struct EpiDown {
    static constexpr bool PERM = false, AFTER_DRAIN = false;
    bf16_t* YS; const int* rowtok; const float* roww;
    __device__ __forceinline__ void operator()(const f32x4 (&acc)[2][2][4][2], const Unit& u, int wr, int wc, int fr, int fq) const {
        const int row0 = u.pm * 256 + wr * 64 + fr, col0 = u.pn * 256 + wc * 32 + 4 * fq;
        int tsv[2][4]; float wv[2][4];
#pragma unroll
        for (int ai = 0; ai < 2; ++ai)
#pragma unroll
            for (int m = 0; m < 4; ++m) { const int rl = wr * 64 + fr + ai * 128 + m * 16; const bool ok = rl < u.nvalid; tsv[ai][m] = ok ? rowtok[u.rbase + rl] : -1; wv[ai][m] = ok ? roww[u.rbase + rl] : 0.f; }
#pragma unroll
        for (int ai = 0; ai < 2; ++ai)
#pragma unroll
            for (int m = 0; m < 4; ++m) {
                const int ts = tsv[ai][m]; const float w = wv[ai][m];
                if (ts >= 0) {
                    bf16_t* rp = YS + ((size_t)(ts & 1) * TL + (ts >> 1)) * 1024 + col0;
#pragma unroll
                    for (int bj = 0; bj < 2; ++bj)
#pragma unroll
                        for (int n = 0; n < 2; ++n) { const f32x4 v = acc[ai][bj][m][n] * w; u32x2 o; o.x = pk2(v[0], v[1]); o.y = pk2(v[2], v[3]); *(u32x2*)(rp + bj * 128 + n * 16) = o; }
                }
            }
    }
};
__device__ void moe_tiles(const Params& p, int* tstart) {
    if (threadIdx.x == 0) { const int* cnt = (const int*)(p.ws + WS_CTL) + CW_CNT; int a = 0;
        for (int e = 0; e < 32; ++e) { tstart[e] = a; const int n = (cnt[e * 64] + 255) >> 8; for (int j = 0; j < n; ++j) tstart[40 + a + j] = e; a += n; }
        tstart[32] = a; for (int e = 0; e < 32; ++e) tstart[400 + e] = cnt[e * 64]; }
    __syncthreads();
}

__device__ void phase7(const Params& p, int bid, int nb) {
    const int lane = threadIdx.x & 63;
    const int gw = bid * 8 + (threadIdx.x >> 6), ngw = nb * 8;
    const float* MOD = (const float*)(p.ws + WS_MOD); const bf16_t* HMID = (const bf16_t*)(p.ws + WS_HMID);
    const bf16_t* YS = (const bf16_t*)(p.ws + WS_YS);
    const float* G = p.in[I_FNG];
    for (int row = gw; row < TL; row += ngw) {
        const int b = row >> 11;
        f32x4 v[4]; float s = 0.f;
#pragma unroll
        for (int j = 0; j < 4; ++j) {
            const int c = 4 * lane + 256 * j;
            const u32x2 hw = *(const u32x2*)(HMID + (size_t)row * DM + c); const f32x4 hm = (f32x4){bflo(hw.x), bfhi(hw.x), bflo(hw.y), bfhi(hw.y)};
            const f32x4 g2 = *(const f32x4*)(MOD + b * 6144 + 5120 + c);
            const u32x2 y0 = *(const u32x2*)(YS + (size_t)row * DM + c), y1 = *(const u32x2*)(YS + ((size_t)TL + row) * DM + c);
            f32x4 y; y[0] = bflo(y0.x) + bflo(y1.x); y[1] = bfhi(y0.x) + bfhi(y1.x); y[2] = bflo(y0.y) + bflo(y1.y); y[3] = bfhi(y0.y) + bfhi(y1.y);
            v[j] = hm + g2 * y;
            s += v[j][0] * v[j][0] + v[j][1] * v[j][1] + v[j][2] * v[j][2] + v[j][3] * v[j][3];
        }
        const float rstd = rsqrtf(wave_sum(s) * (1.f / DM) + EPS);
#pragma unroll
        for (int j = 0; j < 4; ++j) { const int c = 4 * lane + 256 * j; const f32x4 g = *(const f32x4*)(G + c);
            *(f32x4*)(p.out + (size_t)row * DM + c) = (v[j] * rstd) * g; }
    }
}


#ifndef LAS
#define LAS __attribute__((address_space(3)))
#endif
#define XB_TMO      128
#define XB_XCNT(j)  (256  + 64 * (j))
#define XB_XSUB(j)  (1280 + 64 * (j))
#define XB_XGEN(j)  (2304 + 64 * (j))
#define XB_TOP      3328
#define XB_TOPGEN   3392
#define XCD_BAR_WORDS 3456
#define XB_SPIN_CAP (1u << 18)

__device__ __forceinline__ unsigned xb_ld(unsigned* p)              { return __hip_atomic_load(p, __ATOMIC_RELAXED, __HIP_MEMORY_SCOPE_AGENT); }
__device__ __forceinline__ unsigned xb_add(unsigned* p, unsigned v) { return __hip_atomic_fetch_add(p, v, __ATOMIC_RELAXED, __HIP_MEMORY_SCOPE_AGENT); }
__device__ __forceinline__ unsigned xb_xcc_id() { return (unsigned)__builtin_amdgcn_s_getreg((3 << 11) | 20) & 0xFu; }
#define XB_SPIN(cond, bar) do { unsigned _sp = 0; while (cond) { __builtin_amdgcn_s_sleep(1); \
    if ((++_sp & 255u) == 0u) { if (xb_ld(&(bar)[XB_TMO])) break; if (_sp > XB_SPIN_CAP) { atomicAdd(&(bar)[XB_TMO], 1u); break; } } } } while (0)

struct XcdBarrier {
    unsigned* bar; unsigned x;
    volatile LAS unsigned* st;
};

__device__ __forceinline__ XcdBarrier xcd_barrier_post(unsigned* bar, volatile LAS unsigned* st) {
    XcdBarrier b; b.bar = bar; b.x = xb_xcc_id(); b.st = st;
    if (threadIdx.x == 0) (void)xb_add(&bar[XB_XCNT(b.x)], 1u);
    return b;
}
__device__ __forceinline__ void xcd_barrier_complete(unsigned* bar, unsigned x, unsigned& nloc, unsigned& nx) {
    const unsigned G = gridDim.x * gridDim.y * gridDim.z;
    unsigned sum, cnt, mine, sp = 0u;
    for (;;) {
        sum = 0u; cnt = 0u; mine = 0u;
#pragma unroll
        for (unsigned j = 0; j < 16; ++j) { const unsigned c = xb_ld(&bar[XB_XCNT(j)]); sum += c; cnt += (c > 0u) ? 1u : 0u; mine = (j == x) ? c : mine; }
        if (sum == G) break;
        __builtin_amdgcn_s_sleep(1);
        if ((++sp & 255u) == 0u) { if (xb_ld(&bar[XB_TMO])) break; if (sp > XB_SPIN_CAP) { atomicAdd(&bar[XB_TMO], 1u); break; } }
    }
    nloc = mine > 0u ? mine : 1u; nx = cnt > 0u ? cnt : 1u;
}

__device__ __forceinline__ void xcd_barrier(const XcdBarrier& b) {
    asm volatile("s_waitcnt vmcnt(0)" ::: "memory");
    __syncthreads();
    if (threadIdx.x == 0) {
        unsigned* bar = b.bar;
        __builtin_amdgcn_s_waitcnt(0);
        unsigned nloc = b.st[0], nx = b.st[1];
        if (nloc == 0u) { xcd_barrier_complete(bar, b.x, nloc, nx); b.st[0] = nloc; b.st[1] = nx; }
        const unsigned old = xb_add(&bar[XB_XSUB(b.x)], 1u);
        const unsigned gen = old / nloc;
        if (old + 1u == (gen + 1u) * nloc) {
            __builtin_amdgcn_fence(__ATOMIC_RELEASE, "agent");
            asm volatile("s_waitcnt vmcnt(0)" ::: "memory");
            const unsigned og = xb_add(&bar[XB_TOP], 1u);
            const unsigned tg = og / nx;
            if (og + 1u == (tg + 1u) * nx) xb_add(&bar[XB_TOPGEN], 1u);
            else XB_SPIN(xb_ld(&bar[XB_TOPGEN]) == tg, bar);
            __builtin_amdgcn_fence(__ATOMIC_ACQUIRE, "agent");
            xb_add(&bar[XB_XGEN(b.x)], 1u);
            asm volatile("s_waitcnt vmcnt(0)" ::: "memory");
        } else {
            XB_SPIN(xb_ld(&bar[XB_XGEN(b.x)]) == gen, bar);
            __builtin_amdgcn_fence(__ATOMIC_ACQUIRE, "agent");
            asm volatile("s_waitcnt vmcnt(0)" ::: "memory");
        }
    }
    __syncthreads();
}


template <int PH>
__device__ __forceinline__ void run_phase(const Params& p, unsigned char* lds, int bid, int nb) {
    if constexpr (PH == 0) phase0(p, (float*)lds, bid, nb);
    if constexpr (PH == 1) phase1(p, bid, nb);
    if constexpr (PH == 2) { SchedIn S{(const bf16_t*)p.out, (const bf16_t*)(p.ws + WS_WIN), nb, bid}; EpiIn E{p.ws}; pg8::gemm_phase<decltype(E), decltype(S), true, true>((PG8_LAS unsigned char*)lds, 1024, S, E); }
    if constexpr (PH == 3) phase3(p, lds, bid, nb);
    if constexpr (PH == 4) phase4r(p, bid, nb);
    if constexpr (PH == 5) {
        SchedSq S{(const bf16_t*)(p.ws + WS_ONA), (const bf16_t*)(p.ws + WS_WNAO), 512, (const bf16_t*)(p.ws + WS_GG), (const bf16_t*)(p.ws + WS_WGLAO), 1024, 1, nb, bid};
        { EpiMerge E{p.ws, 0}; pg8::gemm_phase<decltype(E), decltype(S), true, true>((PG8_LAS unsigned char*)lds, 512, S, E); }
        { SchedSq S1{(const bf16_t*)(p.ws + WS_GG), (const bf16_t*)(p.ws + WS_WGLAO), 1024, nullptr, nullptr, 0, 1, nb, bid}; EpiMerge E{p.ws, 1}; pg8::gemm_phase<decltype(E), decltype(S1), true, true>((PG8_LAS unsigned char*)lds, 1024, S1, E); }
    }
    if constexpr (PH == 6) { SchedSq S{(const bf16_t*)(p.ws + WS_M8), (const bf16_t*)(p.ws + WS_WOUT), 1024, nullptr, nullptr, 0, 1, nb, bid};
        EpiOut E{p.in[I_X], (const float*)(p.ws + WS_MOD), (bf16_t*)(p.ws + WS_HMID), (float*)(p.ws + WS_ROWSS)}; pg8::gemm_phase<decltype(E), decltype(S), true, true>((PG8_LAS unsigned char*)lds, 1024, S, E); }
    if constexpr (PH == 7) { phase5(p, lds, bid, nb); prep_experts(p, (float*)lds, bid * 8 + (threadIdx.x >> 6), nb * 8); }
    if constexpr (PH == 9) { int* tstart = (int*)(lds + pg8::STAGE_BYTES); moe_tiles(p, tstart);
        SchedMoe S{(const bf16_t*)(p.ws + WS_FL), (const bf16_t*)((unsigned char*)p.out + OUT_WGU), 1024, (size_t)1024 * 1024, tstart, nb, bid, true};
        EpiGU E{(bf16_t*)(p.ws + WS_H)}; const pg8::NoGather GI{(const int*)(p.ws + WS_ERT), TL};
        pg8::gemm_phase<decltype(E), decltype(S), true, true, true>((PG8_LAS unsigned char*)lds, 1024, S, E, GI); }
    if constexpr (PH == 10) { int* tstart = (int*)(lds + pg8::STAGE_BYTES); moe_tiles(p, tstart);
        SchedMoe S{(const bf16_t*)(p.ws + WS_H), (const bf16_t*)((unsigned char*)p.out + OUT_WD), 512, (size_t)1024 * 512, tstart, nb, bid, false};
        EpiDown E{(bf16_t*)(p.ws + WS_YS), (const int*)(p.ws + WS_ERT), (const float*)(p.ws + WS_ERW)}; pg8::gemm_phase<decltype(E), decltype(S), true, true>((PG8_LAS unsigned char*)lds, 512, S, E); }
    if constexpr (PH == 11) phase7(p, bid, nb);
}
constexpr int LDS_BYTES = 155648;

template <int PH>
__global__ void __launch_bounds__(NT, 2) k_phase(Params p) {
    extern __shared__ __attribute__((aligned(16))) unsigned char lds[];
    run_phase<PH>(p, lds, blockIdx.x, gridDim.x);
}


constexpr int LDS_MISC = 155648 - 256;
__global__ void __launch_bounds__(NT, 2) k_mega(Params p) {
    extern __shared__ __attribute__((aligned(16))) unsigned char lds[];
    const int bid = blockIdx.x, nb = gridDim.x;
    volatile LAS unsigned* misc = (volatile LAS unsigned*)((LAS unsigned char*)lds + LDS_MISC);
    if (threadIdx.x < 64) misc[threadIdx.x] = 0u;
    __syncthreads();
    const XcdBarrier bar = xcd_barrier_post((unsigned*)(p.ws + WS_BAR), misc);
#define PHS(N) run_phase<N>(p, lds, bid, nb); if (PROBE_DUP == N) { xcd_barrier(bar); run_phase<N>(p, lds, bid, nb); } xcd_barrier(bar);
    PHS(0) PHS(1) PHS(2) PHS(3) PHS(4) PHS(5) PHS(6) PHS(7) PHS(9) PHS(10)
    run_phase<11>(p, lds, bid, nb);
}

template <int PH> static void launch_phase(const Params& p, int grid, hipStream_t stream) {
    static bool attr = false;
    if (!attr) { (void)hipFuncSetAttribute((const void*)k_phase<PH>, hipFuncAttributeMaxDynamicSharedMemorySize, LDS_BYTES); attr = true; }
    hipLaunchKernelGGL(k_phase<PH>, dim3(grid), dim3(NT), LDS_BYTES, stream, p);
}

extern "C" void kernel_launch(void* const* d_in, const int* in_sizes, int n_in, void* d_out, int out_size, void* d_ws, size_t ws_size, hipStream_t stream) {
    if (n_in != 24 || ws_size < WS_END) { fprintf(stderr, "kernel_launch: unexpected n_in %d / ws %zu\n", n_in, ws_size); return; }
    Params p{};
    for (int i = 0; i < 24; ++i) p.in[i] = (const float*)d_in[i];
    p.out = (float*)d_out; p.ws = (unsigned char*)d_ws;
#if MEGA
    static int grid = 0;
    if (grid == 0) {
        int dev = 0, cus = 0, per_cu = 0;
        (void)hipGetDevice(&dev);
        (void)hipDeviceGetAttribute(&cus, hipDeviceAttributeMultiprocessorCount, dev);
        (void)hipFuncSetAttribute((const void*)k_mega, hipFuncAttributeMaxDynamicSharedMemorySize, LDS_BYTES);
        if (hipOccupancyMaxActiveBlocksPerMultiprocessor(&per_cu, (const void*)k_mega, NT, LDS_BYTES) != hipSuccess || per_cu < 1) { fprintf(stderr, "occupancy query failed (%d)\n", per_cu); per_cu = 1; }
        if (per_cu > 1) per_cu = 1;
        grid = cus * per_cu;
    }
    (void)hipMemsetAsync((unsigned char*)d_ws + WS_BAR, 0, 16384, stream);
    hipLaunchKernelGGL(k_mega, dim3(grid), dim3(NT), LDS_BYTES, stream, p);
    const hipError_t e = hipPeekAtLastError();
    if (e != hipSuccess) fprintf(stderr, "launch failed: %s (grid %d)\n", hipGetErrorString(e), grid);
#else
    const int G = 256;
    launch_phase<0>(p, G, stream); launch_phase<1>(p, G, stream); launch_phase<2>(p, G, stream); launch_phase<3>(p, G, stream);
    launch_phase<4>(p, G, stream); launch_phase<5>(p, G, stream); launch_phase<6>(p, G, stream); launch_phase<7>(p, G, stream);
    launch_phase<8>(p, G, stream); launch_phase<9>(p, G, stream); launch_phase<10>(p, G, stream); launch_phase<11>(p, G, stream);
#endif
}
```

```cpp
#include <hip/hip_runtime.h>
#include <hip/hip_cooperative_groups.h>
#include <cstdint>
#include <cstdio>
namespace cg = cooperative_groups;

#ifndef MEGA
#define MEGA 1
#endif
#define PROBE_DUP -1

typedef unsigned short bf16_t;
typedef short bf16x8 __attribute__((ext_vector_type(8)));
typedef float f32x4 __attribute__((ext_vector_type(4)));
typedef float f32x2 __attribute__((ext_vector_type(2)));
typedef unsigned u32x4 __attribute__((ext_vector_type(4)));
typedef unsigned u32x2 __attribute__((ext_vector_type(2)));

constexpr int NB = 16, SEQ = 2048, DM = 1024, CTX = 256, GW = 64;
constexpr int TL = NB * SEQ;
constexpr int TC = NB * CTX;
constexpr int TA = TL + TC;
constexpr int NEXP = 32, DEXP = 512;
constexpr int NT = 512;
constexpr float EPS = 1e-6f;
constexpr int ECAP = 32768;
constexpr int MAXROWS = 73728;

constexpr size_t MiB = 1u << 20;
constexpr size_t WS_CTL = 0;
constexpr size_t WS_BAR = 64 * 1024;
constexpr size_t WS_MOD = 1 * MiB;
constexpr size_t WS_ROPE = 1 * MiB + 512 * 1024;
constexpr size_t WS_ROUTE = 2 * MiB;
constexpr size_t WS_ROWTOK = 3 * MiB;
constexpr size_t WS_ROWW = 3 * MiB + 512 * 1024;
constexpr size_t WS_WIN = 4 * MiB;
constexpr size_t WS_WNAO = WS_WIN + (size_t)6912 * 1024 * 2;
constexpr size_t WS_WGLAO = WS_WNAO + 1 * MiB;
constexpr size_t WS_WOUT = WS_WGLAO + 2 * MiB;
constexpr size_t WS_ALR = WS_WOUT + 2 * MiB;
constexpr size_t WS_QN = 28 * MiB;
constexpr size_t WS_KN = 60 * MiB;
constexpr size_t WS_VN = 96 * MiB;
constexpr size_t WS_QG = 132 * MiB;
constexpr size_t WS_KG = 164 * MiB;
constexpr size_t WS_VG = 200 * MiB;
constexpr size_t WS_ONA = 272 * MiB;
constexpr size_t WS_GG = 304 * MiB;
constexpr size_t WS_M8 = 368 * MiB;
constexpr size_t WS_M9 = 432 * MiB;
constexpr size_t WS_ROWSS = 496 * MiB;
constexpr size_t WS_ERT = 156 * MiB;
constexpr size_t WS_ERW = 160 * MiB;
constexpr size_t WS_END = 504 * MiB;
constexpr size_t WS_HMID = 28 * MiB;
constexpr size_t WS_FL = 200 * MiB;
constexpr size_t WS_H = 432 * MiB;
constexpr size_t WS_XG = 304 * MiB;
constexpr size_t WS_YS = 304 * MiB;
static_assert(WS_ALR + (size_t)TA * 32 * 4 <= WS_QN, "ws map");
constexpr size_t OUT_WGU = 0;
constexpr size_t OUT_WD = 64 * MiB;

constexpr int CW_CNT = 0;

__device__ __forceinline__ unsigned pk2(float lo, float hi);
__device__ __forceinline__ unsigned f2bf(float f);
typedef __bf16 bf16x2_hw __attribute__((ext_vector_type(2)));
__device__ __forceinline__ unsigned pk2(float lo, float hi) { const f32x2 v = {lo, hi}; return __builtin_bit_cast(unsigned, __builtin_convertvector(v, bf16x2_hw)); }
__device__ __forceinline__ unsigned f2bf(float f) { return pk2(f, 0.f) & 0xffffu; }
__device__ __forceinline__ float bf2f(unsigned short h) { return __builtin_bit_cast(float, (unsigned)h << 16); }
__device__ __forceinline__ float bflo(unsigned u) { return __builtin_bit_cast(float, u << 16); }
__device__ __forceinline__ float bfhi(unsigned u) { return __builtin_bit_cast(float, u & 0xffff0000u); }
__device__ __forceinline__ float wave_sum(float v) {
#pragma unroll
    for (int o = 1; o < 64; o <<= 1) v += __shfl_xor(v, o);
    return v;
}
__device__ __forceinline__ float sigmoidf_(float x) { return 1.f / (1.f + __expf(-x)); }
__device__ __forceinline__ float siluf_(float x) { return x / (1.f + __expf(-x)); }

struct Params {
    const float* in[24];
    float* out;
    unsigned char* ws;
};
enum { I_X = 0, I_C, I_CTX, I_CCTX, I_WMOD, I_BMOD, I_NAG, I_NFG, I_WIN, I_WA2, I_BA2, I_GNG, I_RPB, I_WNAO, I_WGLAO, I_WOUT,
       I_WGRP, I_BGRP, I_WEXP, I_BEXP, I_WG, I_WU, I_WD, I_FNG };

__device__ void p0_mod(const Params& p, float* lds, int blk) {
    const int tid = threadIdx.x;
    float* sc = lds;
    for (int i = tid; i < 17 * 1024; i += NT) {
        const int r = i >> 10, k = i & 1023;
        const float v = r < 16 ? p.in[I_C][r * 1024 + k] : p.in[I_CCTX][k];
        sc[i] = siluf_(v);
    }
    __syncthreads();
    const int cg4 = tid & 7, kr = tid >> 3;
    const int n0 = blk * 32 + cg4 * 4;
    float acc[17][4];
#pragma unroll
    for (int r = 0; r < 17; ++r) { acc[r][0] = 0.f; acc[r][1] = 0.f; acc[r][2] = 0.f; acc[r][3] = 0.f; }
    const float* W = p.in[I_WMOD];
#pragma unroll 2
    for (int kb = 0; kb < 1024; kb += 64) {
        const int k = kb + kr;
        const f32x4 w = __builtin_nontemporal_load((const f32x4*)(W + (size_t)k * 6144 + n0));
#pragma unroll
        for (int r = 0; r < 17; ++r) { const float s = sc[r * 1024 + k]; acc[r][0] += s * w[0]; acc[r][1] += s * w[1]; acc[r][2] += s * w[2]; acc[r][3] += s * w[3]; }
    }
#pragma unroll
    for (int r = 0; r < 17; ++r)
#pragma unroll
        for (int j = 0; j < 4; ++j) { float v = acc[r][j]; v += __shfl_xor(v, 8); v += __shfl_xor(v, 16); v += __shfl_xor(v, 32); acc[r][j] = v; }
    __syncthreads();
    float* red = lds;
    const int wave = tid >> 6, lane = tid & 63;
    if (lane < 8) {
#pragma unroll
        for (int r = 0; r < 17; ++r)
#pragma unroll
            for (int j = 0; j < 4; ++j) red[(wave * 8 + lane) * 68 + r * 4 + j] = acc[r][j];
    }
    __syncthreads();
    float* MOD = (float*)(p.ws + WS_MOD);
    for (int i = tid; i < 8 * 68; i += NT) {
        const int c = i / 68, q = i % 68, r = q >> 2, j = q & 3;
        float s = 0.f;
#pragma unroll
        for (int w = 0; w < 8; ++w) s += red[(w * 8 + c) * 68 + q];
        const int n = blk * 32 + c * 4 + j;
        MOD[r * 6144 + n] = s + p.in[I_BMOD][n];
    }
    __syncthreads();
}

template <class ColMap>
__device__ __forceinline__ void transpose_item(const float* W, int ld, bf16_t* WT, int K, int k0, int n0, float* scr, int lane, const ColMap& cm) {
    const int sc = cm(n0 + (lane & 31));
    float tv[32];
    const float* wp = W + (size_t)(k0 + (lane >> 5)) * ld + (sc >= 0 ? sc : 0);
#pragma unroll
    for (int i = 0; i < 32; ++i) tv[i] = __builtin_nontemporal_load(wp + (size_t)(2 * i) * ld);
#pragma unroll
    for (int i = 0; i < 32; ++i) { const int kk = 2 * i + (lane >> 5); scr[kk * 33 + (lane & 31)] = sc >= 0 ? tv[i] : 0.f; }
    asm volatile("s_waitcnt lgkmcnt(0)" ::: "memory");
    __builtin_amdgcn_wave_barrier();
    const int c = lane & 7;
#pragma unroll
    for (int j = 0; j < 4; ++j) { const int n = (lane >> 3) + 8 * j; const float* s = scr + (8 * c) * 33 + n;
        u32x4 o; o.x = pk2(s[0 * 33], s[1 * 33]); o.y = pk2(s[2 * 33], s[3 * 33]); o.z = pk2(s[4 * 33], s[5 * 33]); o.w = pk2(s[6 * 33], s[7 * 33]);
        *(u32x4*)(WT + (size_t)(n0 + n) * K + k0 + 8 * c) = o; }
    asm volatile("s_waitcnt lgkmcnt(0)" ::: "memory");
    __builtin_amdgcn_wave_barrier();
}
__device__ __forceinline__ int rope_perm(int pp) { const int wc = pp >> 5, n = (pp >> 4) & 1, r = pp & 15; return 64 * (wc >> 1) + 32 * n + 16 * (wc & 1) + r; }
struct CmIn { __device__ int operator()(int n) const {
    if (n < 1536) return n;
    if (n < 2560) return (n & ~127) + rope_perm(n & 127);
    if (n < 4608) return n;
    if (n < 6656) return n + 32;
    if (n < 6688) return n - 6656 + 4608;
    return -1; } };
struct CmId { __device__ int operator()(int n) const { return n; } };
struct CmGU { int which; __device__ int operator()(int n) const { const int t = n >> 8, q = n & 255; return ((q >> 7) == which) ? (128 * t + (q & 127)) : -2; } };

__device__ void p0_prep_small(const Params& p, float* lds, int gw, int ngw) {
    const int lane = threadIdx.x & 63, wave = threadIdx.x >> 6;
    float* scr = lds + wave * (64 * 33);
    constexpr int I_IN = 16 * 216, I_NAO = 8 * 32, I_GLAO = 16 * 32, I_OUT = 16 * 32;
    for (int it = gw; it < I_IN + I_NAO + I_GLAO + I_OUT; it += ngw) {
        int r = it;
        if (r < I_IN) { transpose_item(p.in[I_WIN], 6688, (bf16_t*)(p.ws + WS_WIN), 1024, 64 * (r / 216), 32 * (r % 216), scr, lane, CmIn()); continue; } r -= I_IN;
        if (r < I_NAO) { transpose_item(p.in[I_WNAO], 1024, (bf16_t*)(p.ws + WS_WNAO), 512, 64 * (r / 32), 32 * (r % 32), scr, lane, CmId()); continue; } r -= I_NAO;
        if (r < I_GLAO) { transpose_item(p.in[I_WGLAO], 1024, (bf16_t*)(p.ws + WS_WGLAO), 1024, 64 * (r / 32), 32 * (r % 32), scr, lane, CmId()); continue; } r -= I_GLAO;
        transpose_item(p.in[I_WOUT], 1024, (bf16_t*)(p.ws + WS_WOUT), 1024, 64 * (r / 32), 32 * (r % 32), scr, lane, CmId());
    }
}
__device__ void prep_experts(const Params& p, float* lds, int gw, int ngw) {
    const int lane = threadIdx.x & 63, wave = threadIdx.x >> 6;
    float* scr = lds + wave * (64 * 33);
    bf16_t* WGU = (bf16_t*)((unsigned char*)p.out + OUT_WGU);
    bf16_t* WDt = (bf16_t*)((unsigned char*)p.out + OUT_WD);
    constexpr int PER_GU = 16 * 32, PER_D = 8 * 32;
    for (int it = gw; it < NEXP * (PER_GU + PER_D); it += ngw) {
        const int e = it / (PER_GU + PER_D); int r = it % (PER_GU + PER_D);
        if (r < PER_GU) {
            const int k0 = 64 * (r / 32), n0 = 32 * (r % 32);
            const int t = n0 >> 8, q = n0 & 255, which = q >> 7;
            const float* src = (which == 0 ? p.in[I_WG] : p.in[I_WU]) + (size_t)e * 1024 * 512;
            struct Cm { int base, n0; __device__ int operator()(int n) const { return base + (n - n0); } } cm{128 * t + (q & 127), n0};
            transpose_item(src, 512, WGU + (size_t)e * 1024 * 1024, 1024, k0, n0, scr, lane, cm);
        } else {
            r -= PER_GU;
            transpose_item(p.in[I_WD] + (size_t)e * 512 * 1024, 1024, WDt + (size_t)e * 1024 * 512, 512, 64 * (r / 32), 32 * (r % 32), scr, lane, CmId());
        }
    }
}

__device__ void phase0(const Params& p, float* lds, int bid, int nb) {
    const int tid = threadIdx.x;
    if (bid == 0) {
        for (int i = tid; i < 32 * 64; i += NT) ((int*)(p.ws + WS_CTL))[i] = 0;
        f32x2* RT = (f32x2*)(p.ws + WS_ROPE);
        for (int i = tid; i < 64 * 32; i += NT) {
            const int pos = i >> 5, j = i & 31;
            const float inv = exp2f(-(float)j * 0.41524101186092029f);
            const float ang = (float)pos * inv;
            double rev = (double)ang * 0.15915494309189535; rev -= floor(rev);
            const float fr = (float)rev;
            RT[i] = (f32x2){__builtin_amdgcn_cosf(fr), __builtin_amdgcn_sinf(fr)};
        }
    }
    for (int b = bid; b < 192; b += nb) p0_mod(p, lds, b);
    p0_prep_small(p, lds, bid * 8 + (tid >> 6), nb * 8);
}

__device__ void phase1(const Params& p, int bid, int nb) {
    const int lane = threadIdx.x & 63;
    const int gw = bid * 8 + (threadIdx.x >> 6), ngw = nb * 8;
    const float* MOD = (const float*)(p.ws + WS_MOD);
    bf16_t* A1 = (bf16_t*)p.out;
    const float* G = p.in[I_NAG];
    for (int row = gw; row < TA; row += ngw) {
        const float* xr; int mr;
        if (row < TL) { xr = p.in[I_X] + (size_t)row * DM; mr = row >> 11; } else { xr = p.in[I_CTX] + (size_t)(row - TL) * DM; mr = 16; }
        f32x4 v[4]; float s = 0.f;
#pragma unroll
        for (int j = 0; j < 4; ++j) { v[j] = __builtin_nontemporal_load((const f32x4*)(xr + 4 * lane + 256 * j)); s += v[j][0] * v[j][0] + v[j][1] * v[j][1] + v[j][2] * v[j][2] + v[j][3] * v[j][3]; }
        const float rstd = rsqrtf(wave_sum(s) * (1.f / DM) + EPS);
#pragma unroll
        for (int j = 0; j < 4; ++j) {
            const int c = 4 * lane + 256 * j;
            const f32x4 g = *(const f32x4*)(G + c), sh = *(const f32x4*)(MOD + mr * 6144 + c), sc = *(const f32x4*)(MOD + mr * 6144 + 1024 + c);
            f32x4 o;
#pragma unroll
            for (int i = 0; i < 4; ++i) o[i] = (v[j][i] * rstd) * g[i] * (1.f + sc[i]) + sh[i];
            u32x2 w; w.x = pk2(o[0], o[1]); w.y = pk2(o[2], o[3]);
            *(u32x2*)(A1 + (size_t)row * DM + c) = w;
        }
    }
}


struct Unit { int pm, pn; const bf16_t* a; const bf16_t* b; int aux; int rbase, nvalid; };
namespace pg8 {
#define PG8_LAS __attribute__((address_space(3)))
constexpr int BM = 256, BK = 64, HALF = 128, HTB = HALF * BK * 2  , STAGE_BYTES = 8 * HTB;
__host__ __device__ __forceinline__ int lds_byte(int r, int c) { const int st = (r >> 4) * 2 + (c >> 5), rr = r & 15, cc = c & 31, ob = rr * 64 + cc * 2; return st * 1024 + (ob ^ (((ob >> 9) & 1) << 5)); }
__host__ __device__ __forceinline__ void stage_rc(int b, int& R, int& C) { const int st = b / 1024, sb = b % 1024, swz = sb ^ (((sb >> 9) & 1) << 5); R = (st >> 1) * 16 + swz / 64; C = (st & 1) * 32 + (swz % 64) / 2; }
__host__ __device__ __forceinline__ int perm32(int rho) { const int n = rho >> 4, i = rho & 15; return 8 * (i >> 2) + 4 * n + (i & 3); }
struct NoGather { const int* rowtok; int zero_row; };
template <class Epi, class Sched, bool ALIGN_EPI = false, bool SP2 = false, bool GATHER = false>
__device__ __forceinline__ void gemm_phase(PG8_LAS unsigned char* lds, const int Kdim, const Sched& S, const Epi& E, const NoGather G = NoGather{nullptr, 0}) {
    int tid_ = threadIdx.x; asm volatile("" : "+v"(tid_));
    const int tid = tid_, wid = __builtin_amdgcn_readfirstlane(tid >> 6), lane = tid & 63, wr = wid >> 2, wc = wid & 3, fr = lane & 15, fq = lane >> 4;
    const int K = Kdim, nt = K / BK;
    static_assert(!GATHER || SP2, "gathered A staging is wired into the two-super-phase loop only");
    unsigned voffA[2], voffB[2]; int gR[2], gC[2];
#pragma unroll
    for (int i = 0; i < 2; ++i) { int R, C; stage_rc(tid * 16 + i * 8192, R, C); const int Rb = Epi::PERM ? ((R & ~31) + perm32(R & 31)) : R;
        voffA[i] = (unsigned)(R * K + C) * 2u; voffB[i] = (unsigned)(Rb * K + C) * 2u; gR[i] = R; gC[i] = C; }
    const size_t kstep = (size_t)(BK * 2);
    const size_t hstep = (size_t)HALF * K * 2;
    const size_t tstep = 2 * hstep;
    const unsigned ldsw = (unsigned)wid * 1024u;
    const int aoff = lds_byte(wr * 64 + fr, fq * 8), boff = lds_byte(wc * 32 + fr, fq * 8);
#define PG8_SA(b, h) (((b) * 2 + (h)) * HTB)
#define PG8_SB(b, h) ((4 + (b) * 2 + (h)) * HTB)
#define PG8_STAGE(bufoff, gbase, voff) do { _Pragma("unroll") for (int _i = 0; _i < 2; ++_i) \
        __builtin_amdgcn_global_load_lds((const unsigned*)((const char*)(gbase) + (voff)[_i]), (PG8_LAS unsigned*)(lds + (bufoff) + ldsw + _i * 8192), 16, 0, 0); } while (0)
#define PG8_STAGE_A(bufoff, kbase, half, usenext) do { if constexpr (GATHER) { const bool un_ = (usenext); \
        const unsigned vs_[2] = {un_ ? aoffN[half][0] : aoffC[half][0], un_ ? aoffN[half][1] : aoffC[half][1]}; PG8_STAGE(bufoff, kbase, vs_); } \
    else { PG8_STAGE(bufoff, (kbase) + (half) * hstep, voffA); } } while (0)
#define PG8_GOFF(u_, o_) do { _Pragma("unroll") for (int h_ = 0; h_ < 2; ++h_) _Pragma("unroll") for (int i_ = 0; i_ < 2; ++i_) { \
        const int rl_ = 128 * h_ + gR[i_]; const int tk_ = rl_ < (u_).nvalid ? (G.rowtok[(u_).rbase + rl_] >> 1) : G.zero_row; \
        o_[h_][i_] = (unsigned)(tk_ * K + gC[i_]) * 2u; } } while (0)
#define PG8_LDA(dst, b, h) do { _Pragma("unroll") for (int m = 0; m < 4; ++m) _Pragma("unroll") for (int k = 0; k < 2; ++k) dst[m][k] = *(const PG8_LAS bf16x8*)(lds + PG8_SA(b, h) + aoff + m * 2048 + k * 1024); } while (0)
#define PG8_LDB(dst, b, h) do { _Pragma("unroll") for (int n = 0; n < 2; ++n) _Pragma("unroll") for (int k = 0; k < 2; ++k) dst[n][k] = *(const PG8_LAS bf16x8*)(lds + PG8_SB(b, h) + boff + n * 2048 + k * 1024); } while (0)
#define PG8_MMA(ai, bj, At, Bt) do { __builtin_amdgcn_s_setprio(1); _Pragma("unroll") for (int m = 0; m < 4; ++m) _Pragma("unroll") for (int n = 0; n < 2; ++n) _Pragma("unroll") for (int k = 0; k < 2; ++k) \
        acc[ai][bj][m][n] = __builtin_amdgcn_mfma_f32_16x16x32_bf16(Bt[n][k], At[m][k], acc[ai][bj][m][n], 0, 0, 0); __builtin_amdgcn_s_setprio(0); } while (0)
#define PG8_WAIT_V(n) asm volatile("s_waitcnt vmcnt(" #n ")" ::: "memory")
#define PG8_WAIT_L(n) asm volatile("s_waitcnt lgkmcnt(" #n ")" ::: "memory")
#define PG8_BAR __builtin_amdgcn_s_barrier()
#define PG8_SCHED __builtin_amdgcn_sched_barrier(0)
    Unit cur, nxt; int ui = 0;
    if (!S.next(0, cur)) return;
    f32x4 acc[2][2][4][2];
#pragma unroll
    for (int a = 0; a < 2; ++a)
#pragma unroll
        for (int b = 0; b < 2; ++b)
#pragma unroll
            for (int m = 0; m < 4; ++m)
#pragma unroll
                for (int n = 0; n < 2; ++n) acc[a][b][m][n] = (f32x4){0.f, 0.f, 0.f, 0.f};
    bf16x8 At[4][2], B0[2][2], B1[2][2];
    const char* cA = (const char*)cur.a; const char* cB = (const char*)cur.b;
    unsigned aoffC[2][2] = {{0u, 0u}, {0u, 0u}}, aoffN[2][2] = {{0u, 0u}, {0u, 0u}};
    if constexpr (GATHER) {
        PG8_GOFF(cur, aoffC); { Unit n1; if (S.next(1, n1)) PG8_GOFF(n1, aoffN); }
        asm volatile("s_waitcnt vmcnt(0)" ::: "memory");
    }
    S.a_ready(cur);
    if constexpr (SP2) {
        PG8_STAGE(PG8_SB(0, 0), cB, voffB); PG8_STAGE(PG8_SB(0, 1), cB + hstep, voffB); PG8_STAGE_A(PG8_SA(0, 0), cA, 0, false); PG8_STAGE_A(PG8_SA(0, 1), cA, 1, false);
        if (wr == 1) PG8_BAR;
        PG8_WAIT_V(2); PG8_BAR;
        PG8_STAGE(PG8_SB(1, 0), cB + kstep, voffB); PG8_STAGE_A(PG8_SA(1, 0), cA + kstep, 0, false); PG8_STAGE(PG8_SB(1, 1), cB + hstep + kstep, voffB);
        PG8_WAIT_V(6); PG8_BAR;
    } else {
        PG8_STAGE(PG8_SB(0, 0), cB, voffB); PG8_STAGE(PG8_SA(0, 0), cA, voffA); PG8_STAGE(PG8_SB(0, 1), cB + hstep, voffB); PG8_STAGE(PG8_SA(0, 1), cA + hstep, voffA);
        if (wr == 1) PG8_BAR;
        PG8_WAIT_V(4); PG8_BAR;
        PG8_STAGE(PG8_SB(1, 0), cB + kstep, voffB); PG8_STAGE(PG8_SA(1, 0), cA + kstep, voffA); PG8_STAGE(PG8_SB(1, 1), cB + hstep + kstep, voffB);
        PG8_WAIT_V(6); PG8_BAR;
    }
    for (;;) {
        const bool has_next = S.next(ui + 1, nxt);
        const char* nA = has_next ? (const char*)nxt.a : cA; const char* nB = has_next ? (const char*)nxt.b : cB;
        for (int t = 0; t < nt; t += 2) {
            const bool last = (t == nt - 2);
            const char* a1 = cA + (size_t)(t + 1) * kstep;
            const char* a2 = last ? nA : cA + (size_t)(t + 2) * kstep; const char* b2 = last ? nB : cB + (size_t)(t + 2) * kstep;
            const char* a3 = a2 + kstep; const char* b3 = b2 + kstep;
            if (last && has_next) S.a_ready(nxt);
            if constexpr (SP2) {
            PG8_LDB(B0, 0, 0); PG8_LDB(B1, 0, 1); PG8_SCHED; PG8_LDA(At, 0, 0); PG8_STAGE_A(PG8_SA(1, 1), a1, 1, false);
            PG8_WAIT_V(8); PG8_WAIT_L(0); PG8_BAR; PG8_MMA(0, 0, At, B0); PG8_MMA(0, 1, At, B1); PG8_BAR; PG8_SCHED;
            PG8_LDA(At, 0, 1); PG8_STAGE(PG8_SB(0, 0), b2, voffB); PG8_STAGE(PG8_SB(0, 1), b2 + hstep, voffB); PG8_STAGE_A(PG8_SA(0, 0), a2, 0, last && has_next);
            PG8_WAIT_V(8); PG8_WAIT_L(0); PG8_BAR; PG8_MMA(1, 0, At, B0); PG8_MMA(1, 1, At, B1); PG8_BAR; PG8_SCHED;
            PG8_LDB(B0, 1, 0); PG8_LDB(B1, 1, 1); PG8_SCHED; PG8_LDA(At, 1, 0); PG8_STAGE_A(PG8_SA(0, 1), a2, 1, last && has_next);
            PG8_WAIT_V(8); PG8_WAIT_L(0); PG8_BAR; PG8_MMA(0, 0, At, B0); PG8_MMA(0, 1, At, B1); PG8_BAR; PG8_SCHED;
            PG8_LDA(At, 1, 1); PG8_STAGE(PG8_SB(1, 0), b3, voffB); PG8_STAGE(PG8_SB(1, 1), b3 + hstep, voffB); PG8_STAGE_A(PG8_SA(1, 0), a3, 0, last && has_next);
            PG8_WAIT_V(8); PG8_WAIT_L(0); PG8_BAR; PG8_MMA(1, 0, At, B0); PG8_MMA(1, 1, At, B1); PG8_BAR; PG8_SCHED;
            } else {
            PG8_LDB(B0, 0, 0); PG8_SCHED; PG8_LDA(At, 0, 0); PG8_STAGE(PG8_SA(1, 1), a1 + hstep, voffA);
            PG8_WAIT_L(8); PG8_BAR; PG8_WAIT_L(0); PG8_MMA(0, 0, At, B0); PG8_BAR; PG8_SCHED;
            PG8_LDB(B1, 0, 1); PG8_STAGE(PG8_SB(0, 0), b2, voffB);
            PG8_BAR; PG8_WAIT_L(0); PG8_MMA(0, 1, At, B1); PG8_BAR;
            PG8_LDA(At, 0, 1); PG8_STAGE(PG8_SA(0, 0), a2, voffA);
            PG8_BAR; PG8_WAIT_L(0); PG8_MMA(1, 0, At, B0); PG8_BAR; PG8_SCHED;
            PG8_STAGE(PG8_SB(0, 1), b2 + hstep, voffB);
            PG8_WAIT_V(6); PG8_BAR; PG8_MMA(1, 1, At, B1); PG8_BAR;
            PG8_LDB(B0, 1, 0); PG8_SCHED; PG8_LDA(At, 1, 0); PG8_STAGE(PG8_SA(0, 1), a2 + hstep, voffA);
            PG8_WAIT_L(8); PG8_BAR; PG8_WAIT_L(0); PG8_MMA(0, 0, At, B0); PG8_BAR; PG8_SCHED;
            PG8_LDB(B1, 1, 1); PG8_STAGE(PG8_SB(1, 0), b3, voffB);
            PG8_BAR; PG8_WAIT_L(0); PG8_MMA(0, 1, At, B1); PG8_BAR;
            PG8_LDA(At, 1, 1); PG8_STAGE(PG8_SA(1, 0), a3, voffA);
            PG8_BAR; PG8_WAIT_L(0); PG8_MMA(1, 0, At, B0); PG8_BAR; PG8_SCHED;
            PG8_STAGE(PG8_SB(1, 1), b3 + hstep, voffB);
            PG8_WAIT_V(6); PG8_BAR; PG8_MMA(1, 1, At, B1); PG8_BAR;
            }
        }
        if constexpr (ALIGN_EPI) { if (wr == 0) PG8_BAR; }
        if constexpr (!Epi::AFTER_DRAIN) { E(acc, cur, wr, wc, fr, fq); S.done(cur); }
        if (!has_next) break;
#pragma unroll
        for (int a = 0; a < 2; ++a)
#pragma unroll
            for (int b = 0; b < 2; ++b)
#pragma unroll
                for (int m = 0; m < 4; ++m)
#pragma unroll
                    for (int n = 0; n < 2; ++n) acc[a][b][m][n] = (f32x4){0.f, 0.f, 0.f, 0.f};
        cur = nxt; cA = nA; cB = nB; ++ui;
        if constexpr (GATHER) {
#pragma unroll
            for (int h_ = 0; h_ < 2; ++h_) { aoffC[h_][0] = aoffN[h_][0]; aoffC[h_][1] = aoffN[h_][1]; }
            { Unit n2; if (S.next(ui + 1, n2)) PG8_GOFF(n2, aoffN); }
            asm volatile("s_waitcnt vmcnt(0)" ::: "memory");
        }
        if constexpr (ALIGN_EPI) { if (wr == 1) PG8_BAR; }
    }
    PG8_WAIT_V(0);
    if constexpr (!ALIGN_EPI) { if (wr == 0) PG8_BAR; }
    PG8_BAR;
    if constexpr (Epi::AFTER_DRAIN) { E.fused(acc, cur, wr, wc, fr, fq, lds, wid, lane); S.done(cur); }
#undef PG8_SA
#undef PG8_SB
#undef PG8_STAGE
#undef PG8_LDA
#undef PG8_STAGE_A
#undef PG8_GOFF
#undef PG8_LDB
#undef PG8_MMA
#undef PG8_WAIT_V
#undef PG8_WAIT_L
#undef PG8_BAR
#undef PG8_SCHED
}

}

struct SchedIn {
    __device__ __forceinline__ void a_ready(const Unit&) const {}
    __device__ __forceinline__ void done(const Unit&) const {}
    const bf16_t* A; const bf16_t* Bt; int G, c;
    __device__ bool next(int i, Unit& u) const {
        const int L = i * G + c;
        constexpr int NLAT = 128 * 27, NCTX = 16 * 11;
        if (L >= NLAT + NCTX) return false;
        if (L < NLAT) {
            const int w = (L & 7) * (NLAT / 8) + (L >> 3), gid = w / 216, rem = w % 216;
            u.pm = gid * 8 + (rem & 7); u.pn = rem >> 3; }
        else { const int q = L - NLAT; const int j = q % 11; u.pm = 128 + q / 11; u.pn = j < 4 ? 2 + j : (j < 10 ? 8 + (j - 4) : 26); }
        u.a = A + (size_t)u.pm * 256 * 1024; u.b = Bt + (size_t)u.pn * 256 * 1024; u.aux = 0; u.rbase = 0; u.nvalid = 0;
        return true;
    }
};
struct EpiIn {
    static constexpr bool PERM = false, AFTER_DRAIN = false;
    unsigned char* ws_;
    __device__ __forceinline__ void operator()(const f32x4 (&acc)[2][2][4][2], const Unit& u, int wr, int wc, int fr, int fq) const {
        unsigned zoff = 0; asm volatile("" : "+s"(zoff)); unsigned char* ws = ws_ + zoff;
        const int pn = u.pn;
        const int row0 = u.pm * 256 + wr * 64 + fr;
        if (pn == 26) {
            float* ALR = (float*)(ws + WS_ALR);
            if (wc == 0) {
#pragma unroll
                for (int ai = 0; ai < 2; ++ai)
#pragma unroll
                    for (int m = 0; m < 4; ++m) { const int row = row0 + ai * 128 + m * 16;
#pragma unroll
                        for (int n = 0; n < 2; ++n) *(f32x4*)(ALR + (size_t)row * 32 + 16 * n + 4 * fq) = acc[ai][0][m][n]; }
            }
            return;
        }
        if (pn >= 6 && pn < 10) {
            const bool isq = pn < 8;
            bf16_t* dst = (bf16_t*)(ws + (isq ? WS_QG : WS_KG));
            const float scale = isq ? 0.08838834764831845f : 1.0f;
            const f32x2* RT = (const f32x2*)(ws + WS_ROPE);
            const int half = wc >> 1, j0 = 16 * (wc & 1) + 4 * fq;
#pragma unroll
            for (int ai = 0; ai < 2; ++ai)
#pragma unroll
                for (int m = 0; m < 4; ++m) { const int row = row0 + ai * 128 + m * 16;
                    const bool lat = row < TL; const int t = row & 2047; const int pos = lat ? (half == 0 ? (t >> 6) : (t & 63)) : 0;
                    float cs[4], sn[4];
                    { const f32x4 va = *(const f32x4*)(RT + pos * 32 + j0), vb = *(const f32x4*)(RT + pos * 32 + j0 + 2);
                      cs[0] = va[0]; sn[0] = va[1]; cs[1] = va[2]; sn[1] = va[3]; cs[2] = vb[0]; sn[2] = vb[1]; cs[3] = vb[2]; sn[3] = vb[3]; }
#pragma unroll
                    for (int bj = 0; bj < 2; ++bj) {
                        const int head = (pn & 1) * 2 + bj;
                        const f32x4 x1 = acc[ai][bj][m][0] * scale, x2 = acc[ai][bj][m][1] * scale;
                        float o1[4], o2[4];
#pragma unroll
                        for (int i = 0; i < 4; ++i) { o1[i] = x1[i] * cs[i] - x2[i] * sn[i]; o2[i] = x1[i] * sn[i] + x2[i] * cs[i]; }
                        bf16_t* rp = dst + (size_t)row * 512 + head * 128 + 64 * half + j0;
                        u32x2 w1, w2; w1.x = pk2(o1[0], o1[1]); w1.y = pk2(o1[2], o1[3]); w2.x = pk2(o2[0], o2[1]); w2.y = pk2(o2[2], o2[3]);
                        *(u32x2*)rp = w1; *(u32x2*)(rp + 32) = w2;
                    }
                    asm volatile("" ::: "memory"); }
            return;
        }
        if (pn == 4 || pn == 5) {
            bf16_t* VT = (bf16_t*)(ws + WS_VN);
#pragma unroll
            for (int ai = 0; ai < 2; ++ai)
#pragma unroll
                for (int m = 0; m < 4; ++m) { const int row = row0 + ai * 128 + m * 16;
                    size_t base; int ldt;
                    if (row < TL) { base = (size_t)(row >> 11) * 512 * 2048 + (row & 2047); ldt = 2048; }
                    else { const int rc = row - TL; base = (size_t)32 * MiB / 2 + (size_t)(rc >> 8) * 512 * 256 + (rc & 255); ldt = 256; }
#pragma unroll
                    for (int bj = 0; bj < 2; ++bj)
#pragma unroll
                        for (int n = 0; n < 2; ++n) { const int c = (pn - 4) * 256 + bj * 128 + wc * 32 + n * 16 + 4 * fq;
#pragma unroll
                            for (int i = 0; i < 4; ++i) VT[base + (size_t)(c + i) * ldt] = (bf16_t)f2bf(acc[ai][bj][m][n][i]); }
                    asm volatile("" ::: "memory"); }
            return;
        }
        bf16_t* dst; int ld, cbase; float scale = 1.f;
        if (pn < 2) { dst = (bf16_t*)(ws + WS_QN); ld = 512; cbase = pn * 256; scale = 0.125f; }
        else if (pn < 4) { dst = (bf16_t*)(ws + WS_KN); ld = 512; cbase = (pn - 2) * 256; }
        else if (pn < 14) { dst = (bf16_t*)(ws + WS_VG); ld = 1024; cbase = (pn - 10) * 256; }
        else if (pn < 18) { dst = (bf16_t*)(ws + WS_GG); ld = 1024; cbase = (pn - 14) * 256; }
        else if (pn < 22) { dst = (bf16_t*)(ws + WS_M8); ld = 1024; cbase = (pn - 18) * 256; }
        else { dst = (bf16_t*)(ws + WS_M9); ld = 1024; cbase = (pn - 22) * 256; }
#pragma unroll
        for (int ai = 0; ai < 2; ++ai)
#pragma unroll
            for (int m = 0; m < 4; ++m) { bf16_t* rp = dst + (size_t)(row0 + ai * 128 + m * 16) * ld + cbase + wc * 32 + 4 * fq;
#pragma unroll
                for (int bj = 0; bj < 2; ++bj)
#pragma unroll
                    for (int n = 0; n < 2; ++n) { const f32x4 v = acc[ai][bj][m][n] * scale; u32x2 w; w.x = pk2(v[0], v[1]); w.y = pk2(v[2], v[3]);
                        *(u32x2*)(rp + bj * 128 + n * 16) = w; } }
    }
};

constexpr int NL_RPB = 0;
constexpr int NL_KW = 2048;
constexpr int NL_VW = 75776;
constexpr int NL_K = 2048;
constexpr int NL_VT = 38912;
__device__ __forceinline__ int na_swz(int col) { return (((col >> 3) & 3) << 1) | ((col >> 1) & 1); }
__device__ void na_item(const Params& p, unsigned char* ldsg, int b, int r, int j, int h, int rsb) {
    const int lane = threadIdx.x & 63, l15 = lane & 15, q4 = lane >> 4;
    unsigned lzo = 0; asm volatile("" : "+v"(lzo));
    unsigned char __attribute__((address_space(3)))* lds = (unsigned char __attribute__((address_space(3)))*)ldsg + lzo;
    b = __builtin_amdgcn_readfirstlane(b); r = __builtin_amdgcn_readfirstlane(r); j = __builtin_amdgcn_readfirstlane(j); h = __builtin_amdgcn_readfirstlane(h); rsb = __builtin_amdgcn_readfirstlane(rsb);
    const bf16_t* QN = (const bf16_t*)(p.ws + WS_QN); const bf16_t* KN = (const bf16_t*)(p.ws + WS_KN);
    const bf16_t* VT = (const bf16_t*)(p.ws + WS_VN);
    const int rs = min(max(r - 4, 0), 24), kc0 = min(max(16 * j - 8, 0), 32);
    const int qc = 16 * j + l15, cs = min(max(qc - 8, 0), 48);
    const int qtok = b * SEQ + r * GW + qc;
    bf16x8 qf[2];
    qf[0] = *(const bf16x8*)(QN + (size_t)qtok * 512 + h * 64 + 8 * q4);
    qf[1] = *(const bf16x8*)(QN + (size_t)qtok * 512 + h * 64 + 32 + 8 * q4);
    const float __attribute__((address_space(3)))* rp = (const float __attribute__((address_space(3)))*)(lds + NL_RPB);
    const int kid = 8 * (l15 >> 2) + (l15 & 3);
    const auto krs = __builtin_amdgcn_make_buffer_rsrc((void*)KN, 0, TA * 512 * 2, 0x00020000);
    const auto vrs = __builtin_amdgcn_make_buffer_rsrc((void*)VT, 0, TA * 512 * 2, 0x00020000);
    const unsigned kwin = (unsigned)((b * SEQ + rs * GW + kc0) * 512 + h * 64) * 2u;
    const unsigned klane = (unsigned)(kid * 512 + 8 * q4) * 2u;
    const unsigned vth = (unsigned)(((b * 8 + h) * 64) * 2048 + rs * GW + kc0) * 2u;
    const unsigned vlw = (unsigned)(l15 * 2048 + 8 * q4) * 2u;
    bf16x8 fb[2][8];
    f32x4 sc[16];
    f32x4 o[4];
#pragma unroll
    for (int dt = 0; dt < 4; ++dt) o[dt] = (f32x4){0.f, 0.f, 0.f, 0.f};
#define NA_LOAD(n_) do { constexpr int n = (n_); constexpr int bq = n & 3; constexpr bool isv = (n & 4) != 0, isc = n >= 8; \
        if (!isv) { _Pragma("unroll") for (int u = 0; u < 4; ++u) { const int ti = bq * 4 + u, g = ti >> 1, T = ti & 1; \
            if (isc) { fb[n & 1][2 * u] = *(const __attribute__((address_space(3))) bf16x8*)(lds + NL_K + (32 * g + 4 * T + kid) * 144 + q4 * 16); \
                       fb[n & 1][2 * u + 1] = *(const __attribute__((address_space(3))) bf16x8*)(lds + NL_K + (32 * g + 4 * T + kid) * 144 + q4 * 16 + 64); } \
            else { const int col_ = kc0 + 4 * T + kid, fx_ = na_swz(col_); const int ro_ = NL_KW + ((rs - rsb + g) * 64 + col_) * 128; \
                fb[n & 1][2 * u] = *(const __attribute__((address_space(3))) bf16x8*)(lds + ro_ + ((q4 ^ fx_) * 16)); \
                fb[n & 1][2 * u + 1] = *(const __attribute__((address_space(3))) bf16x8*)(lds + ro_ + (((q4 + 4) ^ fx_) * 16)); } } } \
        else { _Pragma("unroll") for (int u = 0; u < 2; ++u) { const int ks = bq * 2 + u; _Pragma("unroll") for (int dt = 0; dt < 4; ++dt) \
            { if (isc) fb[n & 1][4 * u + dt] = *(const __attribute__((address_space(3))) bf16x8*)(lds + NL_VT + (16 * dt + l15) * 528 + (32 * ks + 8 * q4) * 2); \
              else fb[n & 1][4 * u + dt] = *(const __attribute__((address_space(3))) bf16x8*)(lds + NL_VW + (16 * dt + l15) * 1168 + ((rs - rsb + ks) * 64 + kc0 + 8 * q4) * 2); } } } } while (0)
#define NA_QK(n_) do { constexpr int n = (n_); constexpr int bq = n & 3; constexpr bool isc = n >= 8; \
        _Pragma("unroll") for (int u = 0; u < 4; ++u) { const int ti = bq * 4 + u; \
            f32x4 acc = (f32x4){0.f, 0.f, 0.f, 0.f}; \
            acc = __builtin_amdgcn_mfma_f32_16x16x32_bf16(fb[n & 1][2 * u], qf[0], acc, 0, 0, 0); \
            acc = __builtin_amdgcn_mfma_f32_16x16x32_bf16(fb[n & 1][2 * u + 1], qf[1], acc, 0, 0, 0); \
            if (!isc) { const int i = ti >> 1, T = ti & 1, ri = rs + i - r + 7; \
                _Pragma("unroll") for (int e = 0; e < 4; ++e) { const int kcol = kc0 + 8 * q4 + 4 * T + e; const bool valid = kcol >= cs && kcol < cs + 16; \
                    const int ci = min(max(kcol - qc + 15, 0), 30); acc[e] = valid ? acc[e] + rp[ri * 31 + ci] : -1e30f; } } \
            sc[ti] = acc; } } while (0)
#define NA_PV(n_) do { constexpr int n = (n_); constexpr int bq = n & 3; \
        _Pragma("unroll") for (int u = 0; u < 2; ++u) { const int ks = bq * 2 + u; \
            u32x4 bw; bw.x = pk2(sc[2 * ks][0], sc[2 * ks][1]); bw.y = pk2(sc[2 * ks][2], sc[2 * ks][3]); bw.z = pk2(sc[2 * ks + 1][0], sc[2 * ks + 1][1]); bw.w = pk2(sc[2 * ks + 1][2], sc[2 * ks + 1][3]); \
            const bf16x8 B = __builtin_bit_cast(bf16x8, bw); \
            _Pragma("unroll") for (int dt = 0; dt < 4; ++dt) o[dt] = __builtin_amdgcn_mfma_f32_16x16x32_bf16(fb[n & 1][4 * u + dt], B, o[dt], 0, 0, 0); } } while (0)
    NA_LOAD(0);
    NA_LOAD(1); NA_QK(0);
    NA_LOAD(2); NA_QK(1);
    NA_LOAD(3); NA_QK(2);
    NA_LOAD(4); NA_QK(3);
    float m1 = -1e30f;
#pragma unroll
    for (int ti = 0; ti < 16; ++ti) m1 = fmaxf(fmaxf(fmaxf(m1, sc[ti][0]), fmaxf(sc[ti][1], sc[ti][2])), sc[ti][3]);
    m1 = fmaxf(m1, __shfl_xor(m1, 16)); m1 = fmaxf(m1, __shfl_xor(m1, 32));
    float l = 0.f;
#pragma unroll
    for (int ti = 0; ti < 16; ++ti) {
#pragma unroll
        for (int e = 0; e < 4; ++e) { const float pe = __expf(sc[ti][e] - m1); sc[ti][e] = pe; l += pe; }
    }
    NA_LOAD(5); NA_PV(4);
    NA_LOAD(6); NA_PV(5);
    NA_LOAD(7); NA_PV(6);
    NA_PV(7);
    __syncthreads();
    { int tl = threadIdx.x; asm volatile("" : "+v"(tl));
      const bf16_t* VTC = VT + (size_t)32 * MiB / 2;
#pragma unroll
      for (int q = 0; q < 4; ++q) { const int c = tl + NT * q;
          const u32x4 kv = *(const u32x4*)(KN + ((size_t)TL + b * CTX + (c >> 3)) * 512 + h * 64 + (c & 7) * 8);
          const u32x4 vv = *(const u32x4*)(VTC + ((size_t)(b * 8 + h) * 64 + (c >> 5)) * 256 + (c & 31) * 8);
          *(__attribute__((address_space(3))) u32x4*)(lds + NL_K + (c >> 3) * 144 + (c & 7) * 16) = kv;
          *(__attribute__((address_space(3))) u32x4*)(lds + NL_VT + (c >> 5) * 528 + (c & 31) * 16) = vv; } }
    __syncthreads();
    NA_LOAD(8);
    NA_LOAD(9); NA_QK(8);
    NA_LOAD(10); NA_QK(9);
    NA_LOAD(11); NA_QK(10);
    NA_LOAD(12); NA_QK(11);
    float m2 = -1e30f;
#pragma unroll
    for (int ti = 0; ti < 16; ++ti) m2 = fmaxf(fmaxf(fmaxf(m2, sc[ti][0]), fmaxf(sc[ti][1], sc[ti][2])), sc[ti][3]);
    m2 = fmaxf(m2, __shfl_xor(m2, 16)); m2 = fmaxf(m2, __shfl_xor(m2, 32));
    const float mm = fmaxf(m1, m2), al = __expf(m1 - mm);
    l *= al;
#pragma unroll
    for (int dt = 0; dt < 4; ++dt) o[dt] = o[dt] * al;
#pragma unroll
    for (int ti = 0; ti < 16; ++ti) {
#pragma unroll
        for (int e = 0; e < 4; ++e) { const float pe = __expf(sc[ti][e] - mm); sc[ti][e] = pe; l += pe; }
    }
    NA_LOAD(13); NA_PV(12);
    NA_LOAD(14); NA_PV(13);
    NA_LOAD(15); NA_PV(14);
    NA_PV(15);
#undef NA_LOAD
#undef NA_QK
#undef NA_PV
    l += __shfl_xor(l, 16); l += __shfl_xor(l, 32);
    const float il = 1.f / l;
    bf16_t* ONA = (bf16_t*)(p.ws + WS_ONA);
#pragma unroll
    for (int dt = 0; dt < 4; ++dt) { u32x2 w; w.x = pk2(o[dt][0] * il, o[dt][1] * il); w.y = pk2(o[dt][2] * il, o[dt][3] * il);
        *(u32x2*)(ONA + (size_t)qtok * 512 + h * 64 + 16 * dt + 4 * q4) = w; }
}

#ifndef LAS
#define LAS __attribute__((address_space(3)))
#endif
constexpr int GL_Q = 0;
constexpr int GL_K = 17408;
constexpr int GL_KT = 34816;
constexpr int GL_VR = 53248;
constexpr int GL_VT = 69632;
constexpr int GL_ATT = 88064;
constexpr int GL_O = 97280;
constexpr int GL_ALR = 114688;
constexpr int GL_SEG = 118784;
constexpr int GL_D = 120832;
__device__ __forceinline__ int gla_row0(int b, int dir, int n) {
    if (n < 4) return TL + b * CTX + (dir == 0 ? n : 3 - n) * 64;
    return b * SEQ + (dir == 0 ? n - 4 : 35 - n) * 64;
}
__device__ void gla_chain(const Params& p, unsigned char* ldsg, int item) {
    LAS unsigned char* lds = (LAS unsigned char*)ldsg;
    const int tid = threadIdx.x, lane = tid & 63, wave = tid >> 6;
    const int slice = item & 1, dir = (item >> 1) & 1, h = (item >> 2) & 3, b = item >> 4;
    const int d_ = tid & 127, seg = tid >> 7, l15 = lane & 15, q4 = lane >> 4;
    const bf16_t* QG = (const bf16_t*)(p.ws + WS_QG); const bf16_t* KG = (const bf16_t*)(p.ws + WS_KG); const bf16_t* VG = (const bf16_t*)(p.ws + WS_VG);
    const float* ALR = (const float*)(p.ws + WS_ALR);
    bf16_t* OX = (bf16_t*)((unsigned char*)p.out + (dir == 0 ? 0 : (size_t)64 * MiB));
    float w2[16];
#pragma unroll
    for (int r = 0; r < 16; ++r) w2[r] = p.in[I_WA2][(dir * 16 + r) * 512 + h * 128 + d_];
    const float b2 = p.in[I_BA2][dir * 512 + h * 128 + d_];
    f32x4 S[8];
#pragma unroll
    for (int i = 0; i < 8; ++i) S[i] = (f32x4){0.f, 0.f, 0.f, 0.f};
    u32x4 pq[2], pk[2], pv[2], pa;
    {
        const int r0 = gla_row0(b, dir, 0);
#pragma unroll
        for (int j = 0; j < 2; ++j) { const int c = tid + 512 * j, row = c >> 4, c16 = c & 15;
            pq[j] = (u32x4){0u, 0u, 0u, 0u};
            pk[j] = *(const u32x4*)(KG + (size_t)(r0 + row) * 512 + h * 128 + c16 * 8);
            pv[j] = *(const u32x4*)(VG + (size_t)(r0 + row) * 1024 + h * 256 + slice * 128 + c16 * 8); }
        pa = (u32x4){0u, 0u, 0u, 0u};
        if (tid < 256) pa = *(const u32x4*)(ALR + (size_t)(r0 + (tid >> 2)) * 32 + dir * 16 + (tid & 3) * 4);
    }
    for (int n = 0; n < 36; ++n) {
        const bool lat = n >= 4;
        const int r0 = gla_row0(b, dir, n);
#pragma unroll
        for (int j = 0; j < 2; ++j) { const int c = tid + 512 * j, row = c >> 4, c16 = c & 15;
            *(LAS u32x4*)(lds + GL_Q + row * 272 + c16 * 16) = pq[j];
            *(LAS u32x4*)(lds + GL_K + row * 272 + c16 * 16) = pk[j];
            *(LAS u32x4*)(lds + GL_VR + row * 256 + c16 * 16) = pv[j]; }
        if (tid < 256) *(LAS u32x4*)(lds + GL_ALR + (tid >> 2) * 64 + (tid & 3) * 16) = pa;
        if (n + 1 < 36) {
            const int r1 = gla_row0(b, dir, n + 1); const bool lat1 = n + 1 >= 4;
#pragma unroll
            for (int j = 0; j < 2; ++j) { const int c = tid + 512 * j, row = c >> 4, c16 = c & 15;
                if (lat1) pq[j] = *(const u32x4*)(QG + (size_t)(r1 + row) * 512 + h * 128 + c16 * 8);
                pk[j] = *(const u32x4*)(KG + (size_t)(r1 + row) * 512 + h * 128 + c16 * 8);
                pv[j] = *(const u32x4*)(VG + (size_t)(r1 + row) * 1024 + h * 256 + slice * 128 + c16 * 8); }
            if (tid < 256) pa = *(const u32x4*)(ALR + (size_t)(r1 + (tid >> 2)) * 32 + dir * 16 + (tid & 3) * 4);
        }
        __syncthreads();
        float g[16];
#pragma unroll
        for (int i = 0; i < 16; ++i) {
            const int t = 16 * seg + i;
            float z = b2;
#pragma unroll
            for (int r4 = 0; r4 < 4; ++r4) { const f32x4 a = *(const LAS f32x4*)(lds + GL_ALR + t * 64 + r4 * 16);
                z += a[0] * w2[4 * r4] + a[1] * w2[4 * r4 + 1] + a[2] * w2[4 * r4 + 2] + a[3] * w2[4 * r4 + 3]; }
            const float ls = fminf(z, 0.f) - __logf(1.f + __expf(-fabsf(z)));
            g[i] = ls * (1.f / 16.f);
        }
        if (dir == 0) {
#pragma unroll
            for (int i = 1; i < 16; ++i) g[i] += g[i - 1];
        } else {
#pragma unroll
            for (int i = 14; i >= 0; --i) g[i] += g[i + 1];
        }
        *(LAS float*)(lds + GL_SEG + (seg * 128 + d_) * 4) = dir == 0 ? g[15] : g[0];
        __syncthreads();
        {
            const float s0 = *(const LAS float*)(lds + GL_SEG + (0 * 128 + d_) * 4), s1 = *(const LAS float*)(lds + GL_SEG + (1 * 128 + d_) * 4),
                        s2 = *(const LAS float*)(lds + GL_SEG + (2 * 128 + d_) * 4), s3 = *(const LAS float*)(lds + GL_SEG + (3 * 128 + d_) * 4);
            float off;
            if (dir == 0) off = (seg > 0 ? s0 : 0.f) + (seg > 1 ? s1 : 0.f) + (seg > 2 ? s2 : 0.f);
            else off = (seg < 1 ? s1 : 0.f) + (seg < 2 ? s2 : 0.f) + (seg < 3 ? s3 : 0.f);
            if (seg == 0) *(LAS float*)(lds + GL_D + d_ * 4) = __expf((s0 + s1) + (s2 + s3));
            unsigned kt[8], vt[8];
#pragma unroll
            for (int i = 0; i < 16; ++i) {
                const int t = 16 * seg + i;
                const float bb = g[i] + off, e1 = __expf(bb), e2 = __builtin_amdgcn_rcpf(e1);
                if (lat) { LAS unsigned short* qp = (LAS unsigned short*)(lds + GL_Q + t * 272 + d_ * 2); *qp = (unsigned short)f2bf(bf2f(*qp) * e1); }
                LAS unsigned short* kp = (LAS unsigned short*)(lds + GL_K + t * 272 + d_ * 2);
                const unsigned kb = f2bf(bf2f(*kp) * e2);
                if (lat) *kp = (unsigned short)kb;
                const unsigned vb = *(const LAS unsigned short*)(lds + GL_VR + t * 256 + d_ * 2);
                if (i & 1) { kt[i >> 1] |= kb << 16; vt[i >> 1] |= vb << 16; } else { kt[i >> 1] = kb; vt[i >> 1] = vb; }
            }
            *(LAS u32x4*)(lds + GL_KT + d_ * 144 + seg * 32) = (u32x4){kt[0], kt[1], kt[2], kt[3]};
            *(LAS u32x4*)(lds + GL_KT + d_ * 144 + seg * 32 + 16) = (u32x4){kt[4], kt[5], kt[6], kt[7]};
            *(LAS u32x4*)(lds + GL_VT + d_ * 144 + seg * 32) = (u32x4){vt[0], vt[1], vt[2], vt[3]};
            *(LAS u32x4*)(lds + GL_VT + d_ * 144 + seg * 32 + 16) = (u32x4){vt[4], vt[5], vt[6], vt[7]};
        }
        __syncthreads();
        if (lat) {
            const int tt = wave >> 1, ss0 = (wave & 1) * 2;
            f32x4 a0 = (f32x4){0.f, 0.f, 0.f, 0.f}, a1 = (f32x4){0.f, 0.f, 0.f, 0.f};
#pragma unroll
            for (int kk = 0; kk < 4; ++kk) {
                const bf16x8 A = *(const LAS bf16x8*)(lds + GL_Q + (16 * tt + l15) * 272 + (32 * kk + 8 * q4) * 2);
                const bf16x8 B0 = *(const LAS bf16x8*)(lds + GL_K + (16 * ss0 + l15) * 272 + (32 * kk + 8 * q4) * 2);
                const bf16x8 B1 = *(const LAS bf16x8*)(lds + GL_K + (16 * (ss0 + 1) + l15) * 272 + (32 * kk + 8 * q4) * 2);
                a0 = __builtin_amdgcn_mfma_f32_16x16x32_bf16(A, B0, a0, 0, 0, 0);
                a1 = __builtin_amdgcn_mfma_f32_16x16x32_bf16(A, B1, a1, 0, 0, 0);
            }
#pragma unroll
            for (int r = 0; r < 4; ++r) {
                const int t = 16 * tt + 4 * q4 + r, sA = 16 * ss0 + l15, sB = sA + 16;
                const bool kA = dir == 0 ? (sA <= t) : (sA >= t), kB = dir == 0 ? (sB <= t) : (sB >= t);
                *(LAS unsigned short*)(lds + GL_ATT + t * 144 + sA * 2) = (unsigned short)f2bf(kA ? a0[r] : 0.f);
                *(LAS unsigned short*)(lds + GL_ATT + t * 144 + sB * 2) = (unsigned short)f2bf(kB ? a1[r] : 0.f);
            }
        }
        __syncthreads();
        {
            bf16x8 vB[2];
#pragma unroll
            for (int kk = 0; kk < 2; ++kk) vB[kk] = *(const LAS bf16x8*)(lds + GL_VT + (16 * wave + l15) * 144 + (32 * kk + 8 * q4) * 2);
            if (lat) {
                f32x4 o[4];
#pragma unroll
                for (int tt = 0; tt < 4; ++tt) o[tt] = (f32x4){0.f, 0.f, 0.f, 0.f};
#pragma unroll
                for (int tt = 0; tt < 4; ++tt)
#pragma unroll
                    for (int kk = 0; kk < 2; ++kk) { const bf16x8 A = *(const LAS bf16x8*)(lds + GL_ATT + (16 * tt + l15) * 144 + (32 * kk + 8 * q4) * 2);
                        o[tt] = __builtin_amdgcn_mfma_f32_16x16x32_bf16(A, vB[kk], o[tt], 0, 0, 0); }
#pragma unroll
                for (int kk = 0; kk < 4; ++kk) {
                    const f32x4 sa = S[2 * kk], sb = S[2 * kk + 1];
                    u32x4 bw; bw.x = pk2(sa[0], sa[1]); bw.y = pk2(sa[2], sa[3]); bw.z = pk2(sb[0], sb[1]); bw.w = pk2(sb[2], sb[3]);
                    const bf16x8 Bs = __builtin_bit_cast(bf16x8, bw);
#pragma unroll
                    for (int tt = 0; tt < 4; ++tt) {
                        const u32x2 lo = *(const LAS u32x2*)(lds + GL_Q + (16 * tt + l15) * 272 + (32 * kk + 4 * q4) * 2);
                        const u32x2 hi = *(const LAS u32x2*)(lds + GL_Q + (16 * tt + l15) * 272 + (32 * kk + 16 + 4 * q4) * 2);
                        const bf16x8 A = __builtin_bit_cast(bf16x8, (u32x4){lo.x, lo.y, hi.x, hi.y});
                        o[tt] = __builtin_amdgcn_mfma_f32_16x16x32_bf16(A, Bs, o[tt], 0, 0, 0);
                    }
                }
#pragma unroll
                for (int tt = 0; tt < 4; ++tt)
#pragma unroll
                    for (int r = 0; r < 4; ++r) *(LAS unsigned short*)(lds + GL_O + (16 * tt + 4 * q4 + r) * 272 + (16 * wave + l15) * 2) = (unsigned short)f2bf(o[tt][r]);
            }
#pragma unroll
            for (int dt = 0; dt < 8; ++dt) {
#pragma unroll
                for (int kk = 0; kk < 2; ++kk) { const bf16x8 A = *(const LAS bf16x8*)(lds + GL_KT + (16 * dt + l15) * 144 + (32 * kk + 8 * q4) * 2);
                    S[dt] = __builtin_amdgcn_mfma_f32_16x16x32_bf16(A, vB[kk], S[dt], 0, 0, 0); }
                const f32x4 Dv = *(const LAS f32x4*)(lds + GL_D + (16 * dt + 4 * q4) * 4);
                S[dt] = S[dt] * Dv;
            }
        }
        __syncthreads();
        if (lat) {
#pragma unroll
            for (int j = 0; j < 2; ++j) { const int c = tid + 512 * j, row = c >> 4, c16 = c & 15;
                const u32x4 v = *(const LAS u32x4*)(lds + GL_O + row * 272 + c16 * 16);
                *(u32x4*)(OX + (size_t)(r0 + row) * 1024 + h * 256 + slice * 128 + c16 * 8) = v; }
        }
    }
    __syncthreads();
}

__device__ void phase3(const Params& p, unsigned char* lds, int bid, int nb) {
    for (int it = bid; it < 256; it += nb) gla_chain(p, lds, it);
    {
        const bool xm = (nb & 7) == 0;
        const int wv = __builtin_amdgcn_readfirstlane(threadIdx.x >> 6), tid = threadIdx.x;
        const int s0 = xm ? (bid >> 3) : bid, ds = xm ? (nb >> 3) : nb, smax = xm ? 32 : 256;
        const bf16_t* KN = (const bf16_t*)(p.ws + WS_KN); const bf16_t* VTW = (const bf16_t*)(p.ws + WS_VN);
        const float* RPB = p.in[I_RPB];
        for (int sl = s0; sl < smax; sl += ds) {
            const int slab = xm ? ((((bid & 7) + 8 * (sl >> 4)) << 4) | (sl & 15)) : sl;
            const int b = slab >> 4, h = (slab >> 1) & 7, half = slab & 1;
            __syncthreads();
            for (int i = tid; i < 465; i += NT) ((float*)(lds + NL_RPB))[i] = RPB[h * 465 + i];
            _Pragma("nounroll") for (int it = 0; it < 8; ++it) {
                const int r0 = 16 * half + 2 * it, rsb = min(max(r0 - 4, 0), 24), nrows = min(9, 32 - rsb);
                __syncthreads();
                int t2 = tid; asm volatile("" : "+v"(t2));
#pragma unroll
                for (int q = 0; q < 9; ++q) { const int c = t2 + NT * q, slot = c >> 9, tok = (c >> 3) & 63, ch = c & 7;
                    if (slot < nrows) { const u32x4 kv = *(const u32x4*)(KN + ((size_t)b * SEQ + (rsb + slot) * GW + tok) * 512 + h * 64 + ch * 8);
                        *(u32x4*)(lds + NL_KW + (slot * 64 + tok) * 128 + ((ch ^ na_swz(tok)) * 16)) = kv;
                        const u32x4 vv = *(const u32x4*)(VTW + ((size_t)(b * 8 + h) * 64 + tok) * 2048 + (rsb + slot) * GW + ch * 8);
                        *(u32x4*)(lds + NL_VW + tok * 1168 + (slot * 64 + ch * 8) * 2) = vv; } }
                __syncthreads();
                const int idx = it * 8 + wv; na_item(p, lds, b, 16 * half + (idx >> 2), idx & 3, h, rsb);
            }
        }
    }
    __syncthreads();
}

__device__ void phase4r(const Params& p, int bid, int nb) {
    const int lane = threadIdx.x & 63;
    const int gw = bid * 8 + (threadIdx.x >> 6), ngw = nb * 8;
    const bf16_t* OF = (const bf16_t*)p.out; const bf16_t* OB = (const bf16_t*)((const unsigned char*)p.out + (size_t)64 * MiB); bf16_t* GG = (bf16_t*)(p.ws + WS_GG);
    const float* gng = p.in[I_GNG];
    for (int row = gw; row < TL; row += ngw) {
        f32x4 v[4]; float s = 0.f;
        {
            const u32x4* fp = (const u32x4*)(OF + (size_t)row * 1024 + 16 * lane); const u32x4* bp = (const u32x4*)(OB + (size_t)row * 1024 + 16 * lane);
            const u32x4 f0 = __builtin_nontemporal_load(fp), f1 = __builtin_nontemporal_load(fp + 1), b0 = __builtin_nontemporal_load(bp), b1 = __builtin_nontemporal_load(bp + 1);
            v[0] = (f32x4){bflo(f0.x) + bflo(b0.x), bfhi(f0.x) + bfhi(b0.x), bflo(f0.y) + bflo(b0.y), bfhi(f0.y) + bfhi(b0.y)};
            v[1] = (f32x4){bflo(f0.z) + bflo(b0.z), bfhi(f0.z) + bfhi(b0.z), bflo(f0.w) + bflo(b0.w), bfhi(f0.w) + bfhi(b0.w)};
            v[2] = (f32x4){bflo(f1.x) + bflo(b1.x), bfhi(f1.x) + bfhi(b1.x), bflo(f1.y) + bflo(b1.y), bfhi(f1.y) + bfhi(b1.y)};
            v[3] = (f32x4){bflo(f1.z) + bflo(b1.z), bfhi(f1.z) + bfhi(b1.z), bflo(f1.w) + bflo(b1.w), bfhi(f1.w) + bfhi(b1.w)};
#pragma unroll
            for (int j = 0; j < 4; ++j) s += v[j][0] * v[j][0] + v[j][1] * v[j][1] + v[j][2] * v[j][2] + v[j][3] * v[j][3];
        }
        s += __shfl_xor(s, 1); s += __shfl_xor(s, 2); s += __shfl_xor(s, 4); s += __shfl_xor(s, 8);
        const float rstd = rsqrtf(s * (1.f / 256.f) + EPS);
        u32x4* gp = (u32x4*)(GG + (size_t)row * 1024 + 16 * lane);
        const u32x4 g0 = gp[0], g1 = gp[1];
        const unsigned gu[8] = {g0.x, g0.y, g0.z, g0.w, g1.x, g1.y, g1.z, g1.w};
        unsigned ou[8];
#pragma unroll
        for (int j = 0; j < 8; ++j) {
            const int c = (16 * lane + 2 * j) & 255;
            const float a0 = v[j >> 1][(2 * j) & 3] * rstd * gng[c] * siluf_(bflo(gu[j]));
            const float a1 = v[j >> 1][(2 * j + 1) & 3] * rstd * gng[c + 1] * siluf_(bfhi(gu[j]));
            ou[j] = pk2(a0, a1);
        }
        gp[0] = (u32x4){ou[0], ou[1], ou[2], ou[3]}; gp[1] = (u32x4){ou[4], ou[5], ou[6], ou[7]};
    }
}

struct SchedSq {
    __device__ __forceinline__ void a_ready(const Unit&) const {}
    __device__ __forceinline__ void done(const Unit&) const {}
    const bf16_t* A0; const bf16_t* B0; int K0; const bf16_t* A1; const bf16_t* B1; int K1; int passes; int G, c;
    __device__ bool next(int i, Unit& u) const {
        const int s = i % passes;
        if ((G & 7) == 0) {
            const int t = (i / passes) * (G >> 3) + (c >> 3); if (t >= 64) return false;
            u.pm = 16 * (c & 7) + (t >> 2); u.pn = t & 3;
        } else { const int L = (i / passes) * G + c; if (L >= 512) return false; u.pm = L >> 2; u.pn = L & 3; }
        u.aux = s; u.rbase = 0; u.nvalid = 0;
        if (s == 0) { u.a = A0 + (size_t)u.pm * 256 * K0; u.b = B0 + (size_t)u.pn * 256 * K0; }
        else { u.a = A1 + (size_t)u.pm * 256 * K1; u.b = B1 + (size_t)u.pn * 256 * K1; }
        return true;
    }
};
struct EpiMerge {
    static constexpr bool PERM = false, AFTER_DRAIN = false;
    unsigned char* ws; int pass;
    __device__ __forceinline__ void operator()(const f32x4 (&acc)[2][2][4][2], const Unit& u, int wr, int wc, int fr, int fq) const {
        bf16_t* M8 = (bf16_t*)(ws + WS_M8); const bf16_t* M9 = (const bf16_t*)(ws + WS_M9);
        const int row0 = u.pm * 256 + wr * 64 + fr, col0 = u.pn * 256 + wc * 32 + 4 * fq;
        u32x2 g8[2][2][2], g9[2][2][2];
#define EM_LOAD(k_, buf_) do { _Pragma("unroll") for (int bj = 0; bj < 2; ++bj) _Pragma("unroll") for (int n = 0; n < 2; ++n) { \
            const size_t off = (size_t)(row0 + ((k_) >> 2) * 128 + ((k_) & 3) * 16) * 1024 + col0 + bj * 128 + n * 16; \
            g8[buf_][bj][n] = *(const u32x2*)(M8 + off); if (pass != 0) g9[buf_][bj][n] = *(const u32x2*)(M9 + off); } } while (0)
#define EM_STORE(k_, buf_) do { _Pragma("unroll") for (int bj = 0; bj < 2; ++bj) _Pragma("unroll") for (int n = 0; n < 2; ++n) { \
            const int ai = (k_) >> 2, m = (k_) & 3; \
            const size_t off = (size_t)(row0 + ai * 128 + m * 16) * 1024 + col0 + bj * 128 + n * 16; \
            const f32x4 v = acc[ai][bj][m][n]; const u32x2 g = g8[buf_][bj][n]; u32x2 w; \
            if (pass == 0) { w.x = pk2(v[0] * sigmoidf_(bflo(g.x)), v[1] * sigmoidf_(bfhi(g.x))); w.y = pk2(v[2] * sigmoidf_(bflo(g.y)), v[3] * sigmoidf_(bfhi(g.y))); } \
            else { const u32x2 q9 = g9[buf_][bj][n]; \
                w.x = pk2(bflo(g.x) + v[0] * sigmoidf_(bflo(q9.x)), bfhi(g.x) + v[1] * sigmoidf_(bfhi(q9.x))); \
                w.y = pk2(bflo(g.y) + v[2] * sigmoidf_(bflo(q9.y)), bfhi(g.y) + v[3] * sigmoidf_(bfhi(q9.y))); } \
            *(u32x2*)(M8 + off) = w; } } while (0)
        EM_LOAD(0, 0); EM_LOAD(1, 1);
        EM_STORE(0, 0); EM_LOAD(2, 0);
        EM_STORE(1, 1); EM_LOAD(3, 1);
        EM_STORE(2, 0); EM_LOAD(4, 0);
        EM_STORE(3, 1); EM_LOAD(5, 1);
        EM_STORE(4, 0); EM_LOAD(6, 0);
        EM_STORE(5, 1); EM_LOAD(7, 1);
        EM_STORE(6, 0);
        EM_STORE(7, 1);
#undef EM_LOAD
#undef EM_STORE
    }
};
struct EpiOut {
    static constexpr bool PERM = false, AFTER_DRAIN = false;
    const float* x; const float* MOD; bf16_t* HMID; float* ROWSS;
    __device__ __forceinline__ void operator()(const f32x4 (&acc)[2][2][4][2], const Unit& u, int wr, int wc, int fr, int fq) const {
        const int row0 = u.pm * 256 + wr * 64 + fr, col0 = u.pn * 256 + wc * 32 + 4 * fq;
        const int b = (u.pm * 256) >> 11;
        float ss[2][4];
#pragma unroll
        for (int ai = 0; ai < 2; ++ai)
#pragma unroll
            for (int m = 0; m < 4; ++m) ss[ai][m] = 0.f;
#pragma unroll
        for (int bj = 0; bj < 2; ++bj)
#pragma unroll
            for (int n = 0; n < 2; ++n) {
                const int c = col0 + bj * 128 + n * 16;
                const f32x4 g1 = *(const f32x4*)(MOD + b * 6144 + 2048 + c);
                f32x4 xin[2][4];
#pragma unroll
                for (int ai = 0; ai < 2; ++ai)
#pragma unroll
                    for (int m = 0; m < 4; ++m) xin[ai][m] = __builtin_nontemporal_load((const f32x4*)(x + (size_t)(row0 + ai * 128 + m * 16) * 1024 + c));
#pragma unroll
                for (int ai = 0; ai < 2; ++ai)
#pragma unroll
                    for (int m = 0; m < 4; ++m) { const size_t off = (size_t)(row0 + ai * 128 + m * 16) * 1024 + c;
                        const f32x4 hv = xin[ai][m] + g1 * acc[ai][bj][m][n];
                        { u32x2 hw; hw.x = pk2(hv[0], hv[1]); hw.y = pk2(hv[2], hv[3]); *(u32x2*)(HMID + off) = hw; }
                        ss[ai][m] += (hv[0] * hv[0] + hv[1] * hv[1]) + (hv[2] * hv[2] + hv[3] * hv[3]); }
            }
#pragma unroll
        for (int ai = 0; ai < 2; ++ai)
#pragma unroll
            for (int m = 0; m < 4; ++m) { float v = ss[ai][m]; v += __shfl_xor(v, 16); v += __shfl_xor(v, 32);
                if (fq == 0) ROWSS[(size_t)(row0 + ai * 128 + m * 16) * 16 + u.pn * 4 + wc] = v; }
    }
};

constexpr int P5_WG = 131072;
__device__ void phase5(const Params& p, unsigned char* ldsg, int bid, int nb) {
    LAS unsigned char* lds = (LAS unsigned char*)ldsg;
    const int tid = threadIdx.x, lane = tid & 63, wave = tid >> 6, l15 = lane & 15, q4 = lane >> 4;
    const float* MOD = (const float*)(p.ws + WS_MOD); const bf16_t* HMID = (const bf16_t*)(p.ws + WS_HMID); const float* ROWSS = (const float*)(p.ws + WS_ROWSS);
    bf16_t* FL = (bf16_t*)(p.ws + WS_FL);
    const float* G = p.in[I_NFG]; const float* WGR = p.in[I_WGRP]; const float* WEX = p.in[I_WEXP]; const float* BGR = p.in[I_BGRP]; const float* BEX = p.in[I_BEXP];
    int* cnt = (int*)(p.ws + WS_CTL) + CW_CNT;
    if (bid == 0 && tid < 128) *(u32x4*)(FL + (size_t)TL * DM + tid * 8) = (u32x4){0u, 0u, 0u, 0u};
    for (int c = tid; c < 8192; c += NT) {
        const int k = c >> 3, o4 = c & 7;
        const f32x4 w = *(const f32x4*)(WEX + (size_t)k * 32 + 4 * o4);
#pragma unroll
        for (int i = 0; i < 4; ++i) *(LAS float*)(lds + ((((k >> 2) * 32 + 4 * o4 + i) * 4 + (k & 3)) * 4)) = w[i];
    }
    for (int c = tid; c < 1024; c += NT) *(LAS f32x4*)(lds + P5_WG + c * 16) = *(const f32x4*)(WGR + (size_t)c * 4);
    __syncthreads();
    for (int tile0 = bid * 8; tile0 < TL / 16; tile0 += nb * 8) {
        const int tile = tile0 + wave;
        const int tok = tile * 16 + l15, b = (tile * 16) >> 11;
        float rstd;
        { const f32x4 r4 = *(const f32x4*)(ROWSS + (size_t)tok * 16 + 4 * q4); float v = (r4[0] + r4[1]) + (r4[2] + r4[3]); v += __shfl_xor(v, 16); v += __shfl_xor(v, 32);
          rstd = rsqrtf(v * (1.f / DM) + EPS); }
        f32x4 acc0 = (f32x4){0.f, 0.f, 0.f, 0.f}, acc1 = (f32x4){0.f, 0.f, 0.f, 0.f};
        float lg[4] = {0.f, 0.f, 0.f, 0.f};
        const bf16_t* hrow = HMID + (size_t)tok * DM + 4 * q4; const float* modb = MOD + b * 6144 + 4 * q4; const float* gq = G + 4 * q4;
        bf16_t* flrow = FL + (size_t)tok * DM + 4 * q4;
        f32x4 hv[2][2], gv[2][2], sh[2][2], sc[2][2];
#define P5_LOAD(gn_, buf_) do { _Pragma("unroll") for (int uu = 0; uu < 2; ++uu) { const int c = 16 * (2 * (gn_) + uu); \
            { const u32x2 hw = *(const u32x2*)(hrow + c); hv[buf_][uu] = (f32x4){bflo(hw.x), bfhi(hw.x), bflo(hw.y), bfhi(hw.y)}; } gv[buf_][uu] = *(const f32x4*)(gq + c); sh[buf_][uu] = *(const f32x4*)(modb + 3072 + c); sc[buf_][uu] = *(const f32x4*)(modb + 4096 + c); } } while (0)
        P5_LOAD(0, 0);
#define P5_COMP(gn_, bf_) do { u32x2 wst[2]; \
            _Pragma("unroll") for (int uu = 0; uu < 2; ++uu) { const int u = 2 * (gn_) + uu; f32x4 f; \
                _Pragma("unroll") for (int i = 0; i < 4; ++i) f[i] = (hv[bf_][uu][i] * rstd) * gv[bf_][uu][i] * (1.f + sc[bf_][uu][i]) + sh[bf_][uu][i]; \
                wst[uu].x = pk2(f[0], f[1]); wst[uu].y = pk2(f[2], f[3]); \
                const f32x4 w0 = *(const LAS f32x4*)(lds + ((4 * u + q4) * 32 + l15) * 16), w1 = *(const LAS f32x4*)(lds + ((4 * u + q4) * 32 + 16 + l15) * 16); \
                _Pragma("unroll") for (int e = 0; e < 4; ++e) { \
                    acc0 = __builtin_amdgcn_mfma_f32_16x16x4f32(f[e], w0[e], acc0, 0, 0, 0); \
                    acc1 = __builtin_amdgcn_mfma_f32_16x16x4f32(f[e], w1[e], acc1, 0, 0, 0); \
                    const f32x4 wg = *(const LAS f32x4*)(lds + P5_WG + (16 * u + 4 * q4 + e) * 16); \
                    lg[0] += f[e] * wg[0]; lg[1] += f[e] * wg[1]; lg[2] += f[e] * wg[2]; lg[3] += f[e] * wg[3]; } } \
            _Pragma("unroll") for (int uu = 0; uu < 2; ++uu) *(u32x2*)(flrow + 16 * (2 * (gn_) + uu)) = wst[uu]; } while (0)
#pragma unroll 1
        for (int g2 = 0; g2 < 16; ++g2) {
            P5_LOAD(2 * g2 + 1, 1);
            P5_COMP(2 * g2, 0);
            if (g2 < 15) P5_LOAD(2 * g2 + 2, 0);
            P5_COMP(2 * g2 + 1, 1);
        }
#undef P5_COMP
#undef P5_LOAD
#pragma unroll
        for (int e = 0; e < 4; ++e) { float v = lg[e]; v += __shfl_xor(v, 16); v += __shfl_xor(v, 32); lg[e] = v + BGR[e]; }
        __syncthreads();
        LAS float* sl = (LAS float*)(lds + wave * (16 * 33 * 4));
        LAS int* bcnt = (LAS int*)(lds + 32768);
        if (tid < 32) bcnt[tid] = 0;
#pragma unroll
        for (int r = 0; r < 4; ++r) { sl[(4 * q4 + r) * 33 + l15] = acc0[r]; sl[(4 * q4 + r) * 33 + 16 + l15] = acc1[r]; }
        __syncthreads();
        int x1 = 0, x2 = 0, lr1 = 0, lr2 = 0; float w1 = 0.f, w2 = 0.f;
        if (lane < 16) {
            int grp = 0; float gm = lg[0];
#pragma unroll
            for (int e = 1; e < 4; ++e) if (lg[e] > gm) { gm = lg[e]; grp = e; }
            float gs = 0.f;
#pragma unroll
            for (int e = 0; e < 4; ++e) gs += __expf(lg[e] - gm);
            const float pgrp = 1.f / gs;
            float l8[8];
#pragma unroll
            for (int e = 0; e < 8; ++e) l8[e] = sl[lane * 33 + grp * 8 + e] + BEX[grp * 8 + e];
            int i1 = 0; float m1 = l8[0];
#pragma unroll
            for (int e = 1; e < 8; ++e) if (l8[e] > m1) { m1 = l8[e]; i1 = e; }
            int i2 = -1; float m2 = -3.0e38f;
#pragma unroll
            for (int e = 0; e < 8; ++e) if (e != i1 && l8[e] > m2) { m2 = l8[e]; i2 = e; }
            const float e2 = __expf(m2 - m1);
            w1 = pgrp / (1.f + e2); w2 = pgrp * e2 / (1.f + e2);
            x1 = grp * 8 + i1; x2 = grp * 8 + i2;
            lr1 = __hip_atomic_fetch_add(bcnt + x1, 1, __ATOMIC_RELAXED, __HIP_MEMORY_SCOPE_WORKGROUP);
            lr2 = __hip_atomic_fetch_add(bcnt + x2, 1, __ATOMIC_RELAXED, __HIP_MEMORY_SCOPE_WORKGROUP);
        }
        __syncthreads();
        if (tid < 32) bcnt[32 + tid] = atomicAdd(&cnt[tid * 64], bcnt[tid]);
        __syncthreads();
        if (lane < 16) {
            int* ERT = (int*)(p.ws + WS_ERT); float* ERW = (float*)(p.ws + WS_ERW);
            const int i1 = x1 * ECAP + bcnt[32 + x1] + lr1, i2 = x2 * ECAP + bcnt[32 + x2] + lr2;
            ERT[i1] = tok * 2; ERW[i1] = w1; ERT[i2] = tok * 2 + 1; ERW[i2] = w2;
        }
        asm volatile("s_waitcnt lgkmcnt(0)" ::: "memory");
        if (tile0 + nb * 8 < TL / 16) {
            __syncthreads();
            for (int c = tid; c < 8192; c += NT) {
                const int k = c >> 3, o4 = c & 7;
                const f32x4 w = *(const f32x4*)(WEX + (size_t)k * 32 + 4 * o4);
#pragma unroll
                for (int i = 0; i < 4; ++i) *(LAS float*)(lds + ((((k >> 2) * 32 + 4 * o4 + i) * 4 + (k & 3)) * 4)) = w[i];
            }
            __syncthreads();
        }
    }
    __syncthreads();
}

__device__ void phase5b(const Params& p, float* lds, int bid, int nb) {
    const int lane = threadIdx.x & 63;
    const int gw = bid * 8 + (threadIdx.x >> 6), ngw = nb * 8;
    int* sstart = (int*)lds;
    if (threadIdx.x == 0) { const int* cnt = (const int*)(p.ws + WS_CTL) + CW_CNT; int a = 0; for (int e = 0; e < 32; ++e) { sstart[e] = a; a += ((cnt[e * 64] + 255) >> 8) << 8; } sstart[32] = a; }
    __syncthreads();
    const int* ROUTE = (const int*)(p.ws + WS_ROUTE);
    int* rowtok = (int*)(p.ws + WS_ROWTOK); float* roww = (float*)(p.ws + WS_ROWW);
    const bf16_t* FL = (const bf16_t*)(p.ws + WS_FL); bf16_t* XG = (bf16_t*)(p.ws + WS_XG);
    const int l15 = lane & 15, g4 = lane >> 4;
    for (int it4 = gw; it4 < TL * 2 / 4; it4 += ngw) {
        const int it = it4 * 4 + g4;
        const int tok = it >> 1, k = it & 1;
        const int* R = ROUTE + (size_t)tok * 8;
        const int e = R[k], rk = R[2 + k]; const float w = ((const float*)R)[4 + k];
        const int pos = sstart[e] + rk;
        if (l15 == 0) { rowtok[pos] = it; roww[pos] = w; }
        const u32x4* src = (const u32x4*)(FL + (size_t)tok * DM); u32x4* dst = (u32x4*)(XG + (size_t)pos * DM);
        u32x4 v[8];
#pragma unroll
        for (int q = 0; q < 8; ++q) v[q] = src[l15 + 16 * q];
#pragma unroll
        for (int q = 0; q < 8; ++q) dst[l15 + 16 * q] = v[q];
    }
    const int* cnt = (const int*)(p.ws + WS_CTL) + CW_CNT;
    for (int e = 0; e < 32; ++e) {
        const int c = cnt[e * 64], padn = (((c + 255) >> 8) << 8) - c;
        for (int r = gw; r < padn; r += ngw) { u32x4* dst = (u32x4*)(XG + (size_t)(sstart[e] + c + r) * DM); dst[lane] = (u32x4){0, 0, 0, 0}; dst[lane + 64] = (u32x4){0, 0, 0, 0}; }
    }
    __syncthreads();
}

struct SchedMoe {
    __device__ __forceinline__ void a_ready(const Unit&) const {}
    __device__ __forceinline__ void done(const Unit&) const {}
    const bf16_t* A; const bf16_t* B; int K; size_t bexp; const int* tstart;
    int G, c; bool gather;
    __device__ bool next(int i, Unit& u) const {
        const int ntile = __builtin_amdgcn_readfirstlane(tstart[32]);
        if ((G & 7) == 0) {
            const int t = i * (G >> 3) + (c >> 3);
            u.pm = 8 * (t >> 2) + (c & 7); u.pn = t & 3;
            if (u.pm >= ntile) return false;
        } else { const int L = i * G + c; if (L >= ntile * 4) return false; u.pm = L >> 2; u.pn = L & 3; }
        const int e = __builtin_amdgcn_readfirstlane(tstart[40 + u.pm]);
        const int j = u.pm - __builtin_amdgcn_readfirstlane(tstart[e]), ce = __builtin_amdgcn_readfirstlane(tstart[400 + e]);
        u.aux = e; u.rbase = e * ECAP + 256 * j; u.nvalid = min(256, ce - 256 * j);
        u.a = gather ? A : A + (size_t)u.pm * 256 * K; u.b = B + (size_t)e * bexp + (size_t)u.pn * 256 * K;
        return true;
    }
};
struct EpiGU {
    static constexpr bool PERM = false, AFTER_DRAIN = false;
    bf16_t* H;
    __device__ __forceinline__ void operator()(const f32x4 (&acc)[2][2][4][2], const Unit& u, int wr, int wc, int fr, int fq) const {
        const int row0 = u.pm * 256 + wr * 64 + fr, col0 = u.pn * 128 + wc * 32 + 4 * fq;
#pragma unroll
        for (int ai = 0; ai < 2; ++ai)
#pragma unroll
            for (int m = 0; m < 4; ++m)
#pragma unroll
                for (int n = 0; n < 2; ++n) {
                    const f32x4 g = acc[ai][0][m][n], up = acc[ai][1][m][n];
                    u32x2 w; w.x = pk2(siluf_(g[0]) * up[0], siluf_(g[1]) * up[1]); w.y = pk2(siluf_(g[2]) * up[2], siluf_(g[3]) * up[3]);
                    *(u32x2*)(H + (size_t)(row0 + ai * 128 + m * 16) * 512 + col0 + n * 16) = w;
                }
    }
};
struct EpiDown {
    static constexpr bool PERM = false, AFTER_DRAIN = false;
    bf16_t* YS; const int* rowtok; const float* roww;
    __device__ __forceinline__ void operator()(const f32x4 (&acc)[2][2][4][2], const Unit& u, int wr, int wc, int fr, int fq) const {
        const int row0 = u.pm * 256 + wr * 64 + fr, col0 = u.pn * 256 + wc * 32 + 4 * fq;
        int tsv[2][4]; float wv[2][4];
#pragma unroll
        for (int ai = 0; ai < 2; ++ai)
#pragma unroll
            for (int m = 0; m < 4; ++m) { const int rl = wr * 64 + fr + ai * 128 + m * 16; const bool ok = rl < u.nvalid; tsv[ai][m] = ok ? rowtok[u.rbase + rl] : -1; wv[ai][m] = ok ? roww[u.rbase + rl] : 0.f; }
#pragma unroll
        for (int ai = 0; ai < 2; ++ai)
#pragma unroll
            for (int m = 0; m < 4; ++m) {
                const int ts = tsv[ai][m]; const float w = wv[ai][m];
                if (ts >= 0) {
                    bf16_t* rp = YS + ((size_t)(ts & 1) * TL + (ts >> 1)) * 1024 + col0;
#pragma unroll
                    for (int bj = 0; bj < 2; ++bj)
#pragma unroll
                        for (int n = 0; n < 2; ++n) { const f32x4 v = acc[ai][bj][m][n] * w; u32x2 o; o.x = pk2(v[0], v[1]); o.y = pk2(v[2], v[3]); *(u32x2*)(rp + bj * 128 + n * 16) = o; }
                }
            }
    }
};
__device__ void moe_tiles(const Params& p, int* tstart) {
    if (threadIdx.x == 0) { const int* cnt = (const int*)(p.ws + WS_CTL) + CW_CNT; int a = 0;
        for (int e = 0; e < 32; ++e) { tstart[e] = a; const int n = (cnt[e * 64] + 255) >> 8; for (int j = 0; j < n; ++j) tstart[40 + a + j] = e; a += n; }
        tstart[32] = a; for (int e = 0; e < 32; ++e) tstart[400 + e] = cnt[e * 64]; }
    __syncthreads();
}

__device__ void phase7(const Params& p, int bid, int nb) {
    const int lane = threadIdx.x & 63;
    const int gw = bid * 8 + (threadIdx.x >> 6), ngw = nb * 8;
    const float* MOD = (const float*)(p.ws + WS_MOD); const bf16_t* HMID = (const bf16_t*)(p.ws + WS_HMID);
    const bf16_t* YS = (const bf16_t*)(p.ws + WS_YS);
    const float* G = p.in[I_FNG];
    for (int row = gw; row < TL; row += ngw) {
        const int b = row >> 11;
        f32x4 v[4]; float s = 0.f;
#pragma unroll
        for (int j = 0; j < 4; ++j) {
            const int c = 4 * lane + 256 * j;
            const u32x2 hw = __builtin_nontemporal_load((const u32x2*)(HMID + (size_t)row * DM + c)); const f32x4 hm = (f32x4){bflo(hw.x), bfhi(hw.x), bflo(hw.y), bfhi(hw.y)};
            const f32x4 g2 = *(const f32x4*)(MOD + b * 6144 + 5120 + c);
            const u32x2 y0 = __builtin_nontemporal_load((const u32x2*)(YS + (size_t)row * DM + c)), y1 = __builtin_nontemporal_load((const u32x2*)(YS + ((size_t)TL + row) * DM + c));
            f32x4 y; y[0] = bflo(y0.x) + bflo(y1.x); y[1] = bfhi(y0.x) + bfhi(y1.x); y[2] = bflo(y0.y) + bflo(y1.y); y[3] = bfhi(y0.y) + bfhi(y1.y);
            v[j] = hm + g2 * y;
            s += v[j][0] * v[j][0] + v[j][1] * v[j][1] + v[j][2] * v[j][2] + v[j][3] * v[j][3];
        }
        const float rstd = rsqrtf(wave_sum(s) * (1.f / DM) + EPS);
#pragma unroll
        for (int j = 0; j < 4; ++j) { const int c = 4 * lane + 256 * j; const f32x4 g = *(const f32x4*)(G + c);
            __builtin_nontemporal_store((v[j] * rstd) * g, (f32x4*)(p.out + (size_t)row * DM + c)); }
    }
}


#ifndef LAS
#define LAS __attribute__((address_space(3)))
#endif
#define XB_TMO      128
#define XB_XCNT(j)  (256  + 64 * (j))
#define XB_XSUB(j)  (1280 + 64 * (j))
#define XB_XGEN(j)  (2304 + 64 * (j))
#define XB_TOP      3328
#define XB_TOPGEN   3392
#define XCD_BAR_WORDS 3456
#define XB_SPIN_CAP (1u << 18)

__device__ __forceinline__ unsigned xb_ld(unsigned* p)              { return __hip_atomic_load(p, __ATOMIC_RELAXED, __HIP_MEMORY_SCOPE_AGENT); }
__device__ __forceinline__ unsigned xb_add(unsigned* p, unsigned v) { return __hip_atomic_fetch_add(p, v, __ATOMIC_RELAXED, __HIP_MEMORY_SCOPE_AGENT); }
__device__ __forceinline__ unsigned xb_xcc_id() { return (unsigned)__builtin_amdgcn_s_getreg((3 << 11) | 20) & 0xFu; }
#define XB_SPIN(cond, bar) do { unsigned _sp = 0; while (cond) { __builtin_amdgcn_s_sleep(1); \
    if ((++_sp & 255u) == 0u) { if (xb_ld(&(bar)[XB_TMO])) break; if (_sp > XB_SPIN_CAP) { atomicAdd(&(bar)[XB_TMO], 1u); break; } } } } while (0)

struct XcdBarrier {
    unsigned* bar; unsigned x;
    volatile LAS unsigned* st;
};

__device__ __forceinline__ XcdBarrier xcd_barrier_post(unsigned* bar, volatile LAS unsigned* st) {
    XcdBarrier b; b.bar = bar; b.x = xb_xcc_id(); b.st = st;
    if (threadIdx.x == 0) (void)xb_add(&bar[XB_XCNT(b.x)], 1u);
    return b;
}
__device__ __forceinline__ void xcd_barrier_complete(unsigned* bar, unsigned x, unsigned& nloc, unsigned& nx) {
    const unsigned G = gridDim.x * gridDim.y * gridDim.z;
    unsigned sum, cnt, mine, sp = 0u;
    for (;;) {
        sum = 0u; cnt = 0u; mine = 0u;
#pragma unroll
        for (unsigned j = 0; j < 16; ++j) { const unsigned c = xb_ld(&bar[XB_XCNT(j)]); sum += c; cnt += (c > 0u) ? 1u : 0u; mine = (j == x) ? c : mine; }
        if (sum == G) break;
        __builtin_amdgcn_s_sleep(1);
        if ((++sp & 255u) == 0u) { if (xb_ld(&bar[XB_TMO])) break; if (sp > XB_SPIN_CAP) { atomicAdd(&bar[XB_TMO], 1u); break; } }
    }
    nloc = mine > 0u ? mine : 1u; nx = cnt > 0u ? cnt : 1u;
}

__device__ __forceinline__ void xcd_barrier(const XcdBarrier& b) {
    asm volatile("s_waitcnt vmcnt(0)" ::: "memory");
    __syncthreads();
    if (threadIdx.x == 0) {
        unsigned* bar = b.bar;
        __builtin_amdgcn_s_waitcnt(0);
        unsigned nloc = b.st[0], nx = b.st[1];
        if (nloc == 0u) { xcd_barrier_complete(bar, b.x, nloc, nx); b.st[0] = nloc; b.st[1] = nx; }
        const unsigned old = xb_add(&bar[XB_XSUB(b.x)], 1u);
        const unsigned gen = old / nloc;
        if (old + 1u == (gen + 1u) * nloc) {
            __builtin_amdgcn_fence(__ATOMIC_RELEASE, "agent");
            asm volatile("s_waitcnt vmcnt(0)" ::: "memory");
            const unsigned og = xb_add(&bar[XB_TOP], 1u);
            const unsigned tg = og / nx;
            if (og + 1u == (tg + 1u) * nx) xb_add(&bar[XB_TOPGEN], 1u);
            else XB_SPIN(xb_ld(&bar[XB_TOPGEN]) == tg, bar);
            __builtin_amdgcn_fence(__ATOMIC_ACQUIRE, "agent");
            xb_add(&bar[XB_XGEN(b.x)], 1u);
            asm volatile("s_waitcnt vmcnt(0)" ::: "memory");
        } else {
            XB_SPIN(xb_ld(&bar[XB_XGEN(b.x)]) == gen, bar);
            __builtin_amdgcn_fence(__ATOMIC_ACQUIRE, "agent");
            asm volatile("s_waitcnt vmcnt(0)" ::: "memory");
        }
    }
    __syncthreads();
}


template <int PH>
__device__ __forceinline__ void run_phase(const Params& p, unsigned char* lds, int bid, int nb) {
    if constexpr (PH == 0) phase0(p, (float*)lds, bid, nb);
    if constexpr (PH == 1) phase1(p, bid, nb);
    if constexpr (PH == 2) { SchedIn S{(const bf16_t*)p.out, (const bf16_t*)(p.ws + WS_WIN), nb, bid}; EpiIn E{p.ws}; pg8::gemm_phase<decltype(E), decltype(S), true, true>((PG8_LAS unsigned char*)lds, 1024, S, E); }
    if constexpr (PH == 3) phase3(p, lds, bid, nb);
    if constexpr (PH == 4) phase4r(p, bid, nb);
    if constexpr (PH == 5) {
        SchedSq S{(const bf16_t*)(p.ws + WS_ONA), (const bf16_t*)(p.ws + WS_WNAO), 512, (const bf16_t*)(p.ws + WS_GG), (const bf16_t*)(p.ws + WS_WGLAO), 1024, 1, nb, bid};
        { EpiMerge E{p.ws, 0}; pg8::gemm_phase<decltype(E), decltype(S), true, true>((PG8_LAS unsigned char*)lds, 512, S, E); }
        { SchedSq S1{(const bf16_t*)(p.ws + WS_GG), (const bf16_t*)(p.ws + WS_WGLAO), 1024, nullptr, nullptr, 0, 1, nb, bid}; EpiMerge E{p.ws, 1}; pg8::gemm_phase<decltype(E), decltype(S1), true, true>((PG8_LAS unsigned char*)lds, 1024, S1, E); }
    }
    if constexpr (PH == 6) { SchedSq S{(const bf16_t*)(p.ws + WS_M8), (const bf16_t*)(p.ws + WS_WOUT), 1024, nullptr, nullptr, 0, 1, nb, bid};
        EpiOut E{p.in[I_X], (const float*)(p.ws + WS_MOD), (bf16_t*)(p.ws + WS_HMID), (float*)(p.ws + WS_ROWSS)}; pg8::gemm_phase<decltype(E), decltype(S), true, true>((PG8_LAS unsigned char*)lds, 1024, S, E); }
    if constexpr (PH == 7) { phase5(p, lds, bid, nb); prep_experts(p, (float*)lds, bid * 8 + (threadIdx.x >> 6), nb * 8); }
    if constexpr (PH == 9) { int* tstart = (int*)(lds + pg8::STAGE_BYTES); moe_tiles(p, tstart);
        SchedMoe S{(const bf16_t*)(p.ws + WS_FL), (const bf16_t*)((unsigned char*)p.out + OUT_WGU), 1024, (size_t)1024 * 1024, tstart, nb, bid, true};
        EpiGU E{(bf16_t*)(p.ws + WS_H)}; const pg8::NoGather GI{(const int*)(p.ws + WS_ERT), TL};
        pg8::gemm_phase<decltype(E), decltype(S), true, true, true>((PG8_LAS unsigned char*)lds, 1024, S, E, GI); }
    if constexpr (PH == 10) { int* tstart = (int*)(lds + pg8::STAGE_BYTES); moe_tiles(p, tstart);
        SchedMoe S{(const bf16_t*)(p.ws + WS_H), (const bf16_t*)((unsigned char*)p.out + OUT_WD), 512, (size_t)1024 * 512, tstart, nb, bid, false};
        EpiDown E{(bf16_t*)(p.ws + WS_YS), (const int*)(p.ws + WS_ERT), (const float*)(p.ws + WS_ERW)}; pg8::gemm_phase<decltype(E), decltype(S), true, true>((PG8_LAS unsigned char*)lds, 512, S, E); }
    if constexpr (PH == 11) phase7(p, bid, nb);
}
constexpr int LDS_BYTES = 155648;

template <int PH>
__global__ void __launch_bounds__(NT, 2) k_phase(Params p) {
    extern __shared__ __attribute__((aligned(16))) unsigned char lds[];
    run_phase<PH>(p, lds, blockIdx.x, gridDim.x);
}


constexpr int LDS_MISC = 155648 - 256;
__global__ void __launch_bounds__(NT, 2) k_mega(Params p) {
    extern __shared__ __attribute__((aligned(16))) unsigned char lds[];
    const int bid = blockIdx.x, nb = gridDim.x;
    volatile LAS unsigned* misc = (volatile LAS unsigned*)((LAS unsigned char*)lds + LDS_MISC);
    if (threadIdx.x < 64) misc[threadIdx.x] = 0u;
    __syncthreads();
    const XcdBarrier bar = xcd_barrier_post((unsigned*)(p.ws + WS_BAR), misc);
#define PHS(N) run_phase<N>(p, lds, bid, nb); if (PROBE_DUP == N) { xcd_barrier(bar); run_phase<N>(p, lds, bid, nb); } xcd_barrier(bar);
    PHS(0) PHS(1) PHS(2) PHS(3) PHS(4) PHS(5) PHS(6) PHS(7) PHS(9) PHS(10)
    run_phase<11>(p, lds, bid, nb);
}

template <int PH> static void launch_phase(const Params& p, int grid, hipStream_t stream) {
    static bool attr = false;
    if (!attr) { (void)hipFuncSetAttribute((const void*)k_phase<PH>, hipFuncAttributeMaxDynamicSharedMemorySize, LDS_BYTES); attr = true; }
    hipLaunchKernelGGL(k_phase<PH>, dim3(grid), dim3(NT), LDS_BYTES, stream, p);
}

extern "C" void kernel_launch(void* const* d_in, const int* in_sizes, int n_in, void* d_out, int out_size, void* d_ws, size_t ws_size, hipStream_t stream) {
    if (n_in != 24 || ws_size < WS_END) { fprintf(stderr, "kernel_launch: unexpected n_in %d / ws %zu\n", n_in, ws_size); return; }
    Params p{};
    for (int i = 0; i < 24; ++i) p.in[i] = (const float*)d_in[i];
    p.out = (float*)d_out; p.ws = (unsigned char*)d_ws;
#if MEGA
    static int grid = 0;
    if (grid == 0) {
        int dev = 0, cus = 0, per_cu = 0;
        (void)hipGetDevice(&dev);
        (void)hipDeviceGetAttribute(&cus, hipDeviceAttributeMultiprocessorCount, dev);
        (void)hipFuncSetAttribute((const void*)k_mega, hipFuncAttributeMaxDynamicSharedMemorySize, LDS_BYTES);
        if (hipOccupancyMaxActiveBlocksPerMultiprocessor(&per_cu, (const void*)k_mega, NT, LDS_BYTES) != hipSuccess || per_cu < 1) { fprintf(stderr, "occupancy query failed (%d)\n", per_cu); per_cu = 1; }
        if (per_cu > 1) per_cu = 1;
        grid = cus * per_cu;
    }
    (void)hipMemsetAsync((unsigned char*)d_ws + WS_BAR, 0, 16384, stream);
    hipLaunchKernelGGL(k_mega, dim3(grid), dim3(NT), LDS_BYTES, stream, p);
    const hipError_t e = hipPeekAtLastError();
    if (e != hipSuccess) fprintf(stderr, "launch failed: %s (grid %d)\n", hipGetErrorString(e), grid);
#else
    const int G = 256;
    launch_phase<0>(p, G, stream); launch_phase<1>(p, G, stream); launch_phase<2>(p, G, stream); launch_phase<3>(p, G, stream);
    launch_phase<4>(p, G, stream); launch_phase<5>(p, G, stream); launch_phase<6>(p, G, stream); launch_phase<7>(p, G, stream);
    launch_phase<8>(p, G, stream); launch_phase<9>(p, G, stream); launch_phase<10>(p, G, stream); launch_phase<11>(p, G, stream);
#endif
}
```
